# Optimizing an MI355X kernel written in HIP

```python
import math
import jax, jax.numpy as jnp
from jax import lax
import numpy as np

D_MODEL = 2048
BATCH = 4
SEQ = 4096
DEPTH = 2

GRID_W = 64
CTX_LEN = 256
MIX_WIDTH = D_MODEL
A_WIDTH = MIX_WIDTH // 4
A_HEADS = 4
A_HEAD_DIM = A_WIDTH // A_HEADS
CHUNK = 128
B_WIDTH = MIX_WIDTH // 4
CONV_WIDTH = 31
C_WIDTH = MIX_WIDTH - A_WIDTH - B_WIDTH
HEAD_DIM = 128
N_HEADS = C_WIDTH // HEAD_DIM
N_KV_HEADS = N_HEADS // 4
KV_GROUP = N_HEADS // N_KV_HEADS
KV_WIDTH = N_KV_HEADS * HEAD_DIM
Q_BLOCK = 128
ROPE_AXIS_DIM = HEAD_DIM // 2
ROPE_FREQS = ROPE_AXIS_DIM // 2
ROPE_THETA = 10000.0
ATTN_SCALE = HEAD_DIM ** -0.5
D_FF = 4 * D_MODEL
N_MOD = 6
LN_EPS = 1e-6
RMS_EPS = 1e-6
DEEPNORM_ALPHA = (2 * DEPTH) ** 0.25
DEEPNORM_BETA = (8 * DEPTH) ** -0.25
A_U_OFF = 0
A_V_OFF = A_U_OFF + A_WIDTH
B_VAL_OFF = A_V_OFF + A_WIDTH
B_GATE_OFF = B_VAL_OFF + B_WIDTH
Q_OFF = B_GATE_OFF + B_WIDTH
K_OFF = Q_OFF + C_WIDTH
V_OFF = K_OFF + KV_WIDTH
IN_COLS = V_OFF + KV_WIDTH

kernel_name = "hymba_style_gmlp_conformer_gqa_dit_block"


def layer_norm(x, gain=None, bias=None):
    xf = x.astype(jnp.float32)
    mu = jnp.mean(xf, axis=-1, keepdims=True)
    var = jnp.mean(jnp.square(xf - mu), axis=-1, keepdims=True)
    y = (xf - mu) * lax.rsqrt(var + LN_EPS)
    if gain is not None:
        y = y * gain.astype(jnp.float32) + bias.astype(jnp.float32)
    return y.astype(x.dtype)


def rms_norm(x, gain):
    xf = x.astype(jnp.float32)
    y = xf * lax.rsqrt(jnp.mean(jnp.square(xf), axis=-1, keepdims=True) + RMS_EPS)
    return (y * gain.astype(jnp.float32)).astype(x.dtype)


def modulate(x, shift, scale):
    return layer_norm(x) * (1 + scale) + shift


def rope_tables(rows):
    n_tok = rows * GRID_W
    row = jnp.broadcast_to(jnp.arange(rows, dtype=jnp.float32)[:, None], (rows, GRID_W)).reshape(n_tok)
    col = jnp.broadcast_to(jnp.arange(GRID_W, dtype=jnp.float32)[None, :], (rows, GRID_W)).reshape(n_tok)
    freqs = ROPE_THETA ** (-jnp.arange(ROPE_FREQS, dtype=jnp.float32) / ROPE_FREQS)
    ang = jnp.stack([row[:, None] * freqs, col[:, None] * freqs], axis=1)
    return jnp.cos(ang), jnp.sin(ang)


def apply_axial_rope(t, cos, sin):
    tf = t.astype(jnp.float32).reshape(*t.shape[:-1], 2, 2, ROPE_FREQS)
    x1, x2 = tf[..., 0, :], tf[..., 1, :]
    c = cos[None, :, None]
    s = sin[None, :, None]
    out = jnp.stack([x1 * c - x2 * s, x1 * s + x2 * c], axis=-2)
    return out.reshape(t.shape).astype(t.dtype)


def chunk_mlp(p_u, p_v, ln_g, ln_b, w_s, b_s):
    u = jax.nn.gelu(p_u)
    v = layer_norm(jax.nn.gelu(p_v), ln_g, ln_b)
    bsz, n_tok, _ = v.shape
    v = v.reshape(bsz, n_tok // CHUNK, CHUNK, A_HEADS, A_HEAD_DIM)
    mixed = jnp.einsum('hpq,bnqhd->bnphd', w_s, v) + b_s.T[:, :, None]
    return u * mixed.reshape(bsz, n_tok, A_WIDTH)


def conv_module(p_val, p_gate, w_dw, b_dw, ln_g, ln_b):
    z = p_val * jax.nn.sigmoid(p_gate)
    half = CONV_WIDTH // 2
    z = lax.conv_general_dilated(
        z, w_dw[:, None, :].astype(z.dtype), window_strides=(1,), padding=[(half, half)],
        dimension_numbers=('NWC', 'WIO', 'NWC'), feature_group_count=B_WIDTH) + b_dw
    return jax.nn.silu(layer_norm(z, ln_g, ln_b))


def split_kv(p_kv, k_gain):
    bsz, n_tok, _ = p_kv.shape
    k = rms_norm(p_kv[..., :KV_WIDTH].reshape(bsz, n_tok, N_KV_HEADS, HEAD_DIM), k_gain)
    v = p_kv[..., KV_WIDTH:].reshape(bsz, n_tok, N_KV_HEADS, HEAD_DIM)
    return k, v


def attend(q_blk, k, v):
    s = jnp.einsum('bqkgd,bskd->bkgqs', q_blk, k, preferred_element_type=jnp.float32) * ATTN_SCALE
    p = jax.nn.softmax(s, axis=-1).astype(v.dtype)
    return jnp.einsum('bkgqs,bskd->bqkgd', p, v)


def mix_tokens(p, k_ctx, v_ctx, a_ln_g, a_ln_b, a_ws, a_bs, b_dw, b_dw_bias, b_ln_g, b_ln_b,
               q_gain, k_gain, w_out, rope):
    bsz, n_tok, _ = p.shape
    out_a = chunk_mlp(p[..., A_U_OFF:A_V_OFF], p[..., A_V_OFF:B_VAL_OFF], a_ln_g, a_ln_b, a_ws, a_bs)
    out_b = conv_module(p[..., B_VAL_OFF:B_GATE_OFF], p[..., B_GATE_OFF:Q_OFF], b_dw, b_dw_bias, b_ln_g, b_ln_b)
    q = rms_norm(p[..., Q_OFF:K_OFF].reshape(bsz, n_tok, N_HEADS, HEAD_DIM), q_gain)
    if rope is None:
        q = q.reshape(bsz, n_tok, N_KV_HEADS, KV_GROUP, HEAD_DIM)
        out_c = attend(q, k_ctx, v_ctx).reshape(bsz, n_tok, C_WIDTH)
    else:
        cos, sin = rope
        q = apply_axial_rope(q, cos, sin)
        k_lat, v_lat = split_kv(p[..., K_OFF:], k_gain)
        k_lat = apply_axial_rope(k_lat, cos, sin)
        k_all = jnp.concatenate([k_ctx, k_lat], axis=1)
        v_all = jnp.concatenate([v_ctx, v_lat], axis=1)
        n_blk = n_tok // Q_BLOCK
        q_blocks = q.reshape(bsz, n_blk, Q_BLOCK, N_KV_HEADS, KV_GROUP, HEAD_DIM).transpose(1, 0, 2, 3, 4, 5)
        o = lax.map(lambda qb: attend(qb, k_all, v_all), q_blocks)
        out_c = o.transpose(1, 0, 2, 3, 4, 5).reshape(bsz, n_tok, C_WIDTH)
    return jnp.concatenate([out_a, out_b, out_c], axis=-1) @ w_out


def sq_relu_mlp(h, w_ff1, w_ff2):
    return jnp.square(jax.nn.relu(h @ w_ff1)) @ w_ff2


def setup_inputs(seed: int = 0) -> dict:
    key = jax.random.key(seed)
    ks = jax.random.split(key, 24)
    nrm = jax.random.normal
    f32 = jnp.float32
    D = D_MODEL
    return {
        "x": nrm(ks[0], (BATCH, SEQ, D), f32),
        "c": nrm(ks[1], (BATCH, D), f32),
        "ctx": nrm(ks[2], (BATCH, CTX_LEN, D), f32),
        "c_ctx": nrm(ks[3], (D,), f32),
        "w_mod": nrm(ks[4], (DEPTH, D, N_MOD * D), f32) * (0.5 * D ** -0.5),
        "b_mod": nrm(ks[5], (DEPTH, N_MOD * D), f32) * 0.01,
        "w_in": nrm(ks[6], (DEPTH, D, IN_COLS), f32) * D ** -0.5,
        "a_ln_g": 1.0 + 0.05 * nrm(ks[7], (DEPTH, A_WIDTH), f32),
        "a_ln_b": 0.02 * nrm(ks[8], (DEPTH, A_WIDTH), f32),
        "a_ws": nrm(ks[9], (DEPTH, A_HEADS, CHUNK, CHUNK), f32) * CHUNK ** -0.5,
        "a_bs": 1.0 + 0.05 * nrm(ks[10], (DEPTH, A_HEADS, CHUNK), f32),
        "b_dw": nrm(ks[11], (DEPTH, CONV_WIDTH, B_WIDTH), f32) * CONV_WIDTH ** -0.5,
        "b_dw_bias": 0.02 * nrm(ks[12], (DEPTH, B_WIDTH), f32),
        "b_ln_g": 1.0 + 0.05 * nrm(ks[13], (DEPTH, B_WIDTH), f32),
        "b_ln_b": 0.02 * nrm(ks[14], (DEPTH, B_WIDTH), f32),
        "q_gain": 1.0 + 0.05 * nrm(ks[15], (DEPTH, HEAD_DIM), f32),
        "k_gain": 1.0 + 0.05 * nrm(ks[16], (DEPTH, HEAD_DIM), f32),
        "w_out": nrm(ks[17], (DEPTH, MIX_WIDTH, D), f32) * (MIX_WIDTH ** -0.5 * DEEPNORM_BETA),
        "ln1_g": 1.0 + 0.05 * nrm(ks[18], (DEPTH, D), f32),
        "ln1_b": 0.02 * nrm(ks[19], (DEPTH, D), f32),
        "w_ff1": nrm(ks[20], (DEPTH, D, D_FF), f32) * D ** -0.5,
        "w_ff2": nrm(ks[21], (DEPTH, D_FF, D), f32) * (D_FF ** -0.5 * DEEPNORM_BETA),
        "ln2_g": 1.0 + 0.05 * nrm(ks[22], (DEPTH, D), f32),
        "ln2_b": 0.02 * nrm(ks[23], (DEPTH, D), f32),
    }


def reference(x, c, ctx, c_ctx, w_mod, b_mod, w_in, a_ln_g, a_ln_b, a_ws, a_bs, b_dw, b_dw_bias,
              b_ln_g, b_ln_b, q_gain, k_gain, w_out, ln1_g, ln1_b, w_ff1, w_ff2, ln2_g, ln2_b):
    bsz, n_tok, d = x.shape
    rows = n_tok // GRID_W
    rope = rope_tables(rows)
    cond_lat = jax.nn.silu(c)
    cond_ctx = jax.nn.silu(c_ctx)
    for l in range(DEPTH):
        last = l == DEPTH - 1
        m_lat = (cond_lat @ w_mod[l] + b_mod[l]).reshape(bsz, N_MOD, 1, d)
        m_ctx = (cond_ctx @ w_mod[l] + b_mod[l]).reshape(N_MOD, d)
        h = modulate(x, m_lat[:, 0], m_lat[:, 1])
        hc = modulate(ctx, m_ctx[0], m_ctx[1])
        if last:
            k_ctx, v_ctx = split_kv(hc @ w_in[l][:, K_OFF:], k_gain[l])
        else:
            pc = hc @ w_in[l]
            k_ctx, v_ctx = split_kv(pc[..., K_OFF:], k_gain[l])
        mix_params = (a_ln_g[l], a_ln_b[l], a_ws[l], a_bs[l], b_dw[l], b_dw_bias[l], b_ln_g[l], b_ln_b[l],
                      q_gain[l], k_gain[l], w_out[l])
        y = mix_tokens(h @ w_in[l], k_ctx, v_ctx, *mix_params, rope)
        x = layer_norm(DEEPNORM_ALPHA * x + m_lat[:, 2] * y, ln1_g[l], ln1_b[l])
        if not last:
            yc = mix_tokens(pc, k_ctx, v_ctx, *mix_params, None)
            ctx = layer_norm(DEEPNORM_ALPHA * ctx + m_ctx[2] * yc, ln1_g[l], ln1_b[l])
        f = sq_relu_mlp(modulate(x, m_lat[:, 3], m_lat[:, 4]), w_ff1[l], w_ff2[l])
        x = layer_norm(DEEPNORM_ALPHA * x + m_lat[:, 5] * f, ln2_g[l], ln2_b[l])
        if not last:
            fc = sq_relu_mlp(modulate(ctx, m_ctx[3], m_ctx[4]), w_ff1[l], w_ff2[l])
            ctx = layer_norm(DEEPNORM_ALPHA * ctx + m_ctx[5] * fc, ln2_g[l], ln2_b[l])
    return x
```

```cpp
#include <hip/hip_runtime.h>
#include <hip/hip_cooperative_groups.h>
#include <hip/hip_bf16.h>
#include <cstdio>
#include <cstdint>
namespace cg = cooperative_groups;
namespace pg8 {
#define PG8_LAS __attribute__((address_space(3)))
typedef unsigned short bf16_t;
typedef short bf16x8 __attribute__((ext_vector_type(8)));
typedef float f32x4 __attribute__((ext_vector_type(4)));
typedef unsigned u32x4 __attribute__((ext_vector_type(4)));
constexpr int BM = 256, BK = 64, HALF = 128, HTB = HALF * BK * 2  , STAGE_BYTES = 8 * HTB, NXCD = 8, WGM = 8;

__host__ __device__ __forceinline__ int lds_byte(int r, int c) { const int st = (r >> 4) * 2 + (c >> 5), rr = r & 15, cc = c & 31, ob = rr * 64 + cc * 2; return st * 1024 + (ob ^ (((ob >> 9) & 1) << 5)); }
__host__ __device__ __forceinline__ void stage_rc(int b, int& R, int& C) { const int st = b / 1024, sb = b % 1024, swz = sb ^ (((sb >> 9) & 1) << 5); R = (st >> 1) * 16 + swz / 64; C = (st & 1) * 32 + (swz % 64) / 2; }
__host__ __device__ __forceinline__ int perm32(int rho) { const int n = rho >> 4, i = rho & 15; return 8 * (i >> 2) + 4 * n + (i & 3); }

struct Unit { int pm, pn, ko; };
struct Gemm { const bf16_t* A; const bf16_t* Bt; int M, N, K, nt; };

struct StaticOrder {
    int nM, nN, nwg, G, c;
    __host__ __device__ void init(int M, int N, int G_, int c_) { nM = M / BM; nN = N / BM; nwg = nM * nN; G = G_; c = c_; }
    __host__ __device__ bool next(int i, Unit& u) const {
        const long L = (long)i * G + c; if (L >= nwg) return false;
        int wgid = (int)L; { const int q = nwg / NXCD, r = nwg % NXCD, xcd = wgid % NXCD, off = wgid / NXCD; wgid = (xcd < r ? xcd * (q + 1) : r * (q + 1) + (xcd - r) * q) + off; }
        const int nig = WGM * nN, gid = wgid / nig, fm = gid * WGM, gsz = (nM - fm) < WGM ? (nM - fm) : WGM;
        u.pm = fm + ((wgid % nig) % gsz); u.pn = (wgid % nig) / gsz; u.ko = 0; return true;
    }
    __device__ __forceinline__ void a_ready(const Unit&) const {}
    __device__ __forceinline__ void done(const Unit&) const {}
};

__device__ __forceinline__ unsigned cvt_pk_bf16(float lo, float hi) { unsigned r; asm volatile("v_cvt_pk_bf16_f32 %0, %1, %2" : "=v"(r) : "v"(lo), "v"(hi)); return r; }
typedef float f32x2 __attribute__((ext_vector_type(2)));
#ifndef WT_STORES
#define WT_STORES 0
#endif
__device__ __forceinline__ void st16_wt(void* p, u32x4 v) {
#if WT_STORES
    asm volatile("global_store_dwordx4 %0, %1, off sc1\n\ts_nop 1" :: "v"(p), "v"(v) : "memory");
#else
    *(u32x4*)p = v;
#endif
}
template <int ACT  > struct EpiBf16 {
    static constexpr bool PERM = true, AFTER_DRAIN = false;
    bf16_t* O; int ldc;
    __device__ __forceinline__ void operator()(const f32x4 (&acc)[2][2][4][2], const Unit& u, int wr, int wc, int fr, int fq) const {
        const int row0 = u.pm * BM + wr * 64 + fr; const int col0 = u.pn * BM + wc * 32 + 8 * fq;
#pragma unroll
        for (int ai = 0; ai < 2; ++ai)
#pragma unroll
            for (int m = 0; m < 4; ++m) { bf16_t* rowp = O + (size_t)(row0 + ai * HALF + m * 16) * ldc + col0;
#pragma unroll
                for (int bj = 0; bj < 2; ++bj) { f32x4 v0 = acc[ai][bj][m][0], v1 = acc[ai][bj][m][1];
                    if (ACT == 2) {
#pragma unroll
                        for (int e = 0; e < 4; ++e) { float a = fmaxf(v0[e], 0.f), b = fmaxf(v1[e], 0.f); v0[e] = a * a; v1[e] = b * b; } }
                    u32x4 w; w.x = cvt_pk_bf16(v0[0], v0[1]); w.y = cvt_pk_bf16(v0[2], v0[3]); w.z = cvt_pk_bf16(v1[0], v1[1]); w.w = cvt_pk_bf16(v1[2], v1[3]);
                    st16_wt(rowp + bj * HALF, w); } }
    }
};
template <bool NORM> struct EpiResGate {
    static constexpr bool PERM = false, AFTER_DRAIN = false;
    const float* res_lat; const float* res_ctx; float* out; const float* gate; float alpha; const float* stat; const float* lg; const float* lb;
    __device__ __forceinline__ void operator()(const f32x4 (&acc)[2][2][4][2], const Unit& u, int wr, int wc, int fr, int fq) const {
        typedef float f32x2v __attribute__((ext_vector_type(2)));
        const int mrow = u.pm < 64 ? (u.pm >> 4) : 4;
        const float* g = gate + (size_t)mrow * 12288;
        const int col0 = u.pn * BM + wc * 32 + 4 * fq;
        f32x4 gv[2][2], gg[2][2], bb[2][2];
#pragma unroll
        for (int bj = 0; bj < 2; ++bj)
#pragma unroll
            for (int n = 0; n < 2; ++n) { gv[bj][n] = *(const f32x4*)(g + col0 + bj * HALF + n * 16);
                if (NORM) { gg[bj][n] = *(const f32x4*)(lg + col0 + bj * HALF + n * 16); bb[bj][n] = *(const f32x4*)(lb + col0 + bj * HALF + n * 16); } }
#pragma unroll
        for (int ai = 0; ai < 2; ++ai)
#pragma unroll
            for (int m = 0; m < 4; ++m) { const int row = u.pm * BM + ai * HALF + wr * 64 + m * 16 + fr;
                const float* rp = (row < 16384) ? res_lat + (size_t)row * 2048 : res_ctx + (size_t)(row - 16384) * 2048;
                float* op = out + (size_t)row * 2048;
                f32x2v st = {0.f, 1.f}; if (NORM) st = *(const f32x2v*)(stat + 2 * (size_t)row);
#pragma unroll
                for (int bj = 0; bj < 2; ++bj)
#pragma unroll
                    for (int n = 0; n < 2; ++n) { const int c = col0 + bj * HALF + n * 16; f32x4 r = *(const f32x4*)(rp + c);
                        if (NORM) r = (r - st.x) * st.y * gg[bj][n] + bb[bj][n];
                        const f32x4 o = r * alpha + gv[bj][n] * acc[ai][bj][m][n]; st16_wt(op + c, __builtin_bit_cast(u32x4, o)); } }
    }
};
struct OrderX {
    StaticOrder base; int xm0, xnm, xn0, xnn;
    __device__ void init(int M, int N, int G_, int c_, int xm0_, int xnm_, int xn0_, int xnn_) { base.init(M, N, G_, c_); xm0 = xm0_; xnm = xnm_; xn0 = xn0_; xnn = xnn_; }
    __device__ bool next(int i, Unit& u) const {
        long L = (long)i * base.G + base.c; if (L < base.nwg) return base.next(i, u);
        L -= base.nwg; if (L >= (long)xnm * xnn) return false;
        u.pm = xm0 + (int)(L % xnm); u.pn = xn0 + (int)(L / xnm); u.ko = 0; return true;
    }
    __device__ __forceinline__ void a_ready(const Unit&) const {}
    __device__ __forceinline__ void done(const Unit&) const {}
};
struct OrderSplit {
    int G, c, nsub, kbytes;
    __device__ void init(int G_, int c_, int ns, int nt) { G = G_; c = c_; nsub = 32 * ns; kbytes = nt * 128; }
    __device__ bool next(int i, Unit& u) const { const long L = (long)i * G + c; if (L >= nsub) return false; const int idx = (int)L; u.pm = 64 + (idx & 3); u.pn = (idx >> 2) & 7; u.ko = (idx >> 5) * kbytes; return true; }
    __device__ __forceinline__ void a_ready(const Unit&) const {}
    __device__ __forceinline__ void done(const Unit&) const {}
};
struct EpiPart {
    static constexpr bool PERM = false, AFTER_DRAIN = false;
    float* part; int kbytes;
    __device__ __forceinline__ void operator()(const f32x4 (&acc)[2][2][4][2], const Unit& u, int wr, int wc, int fr, int fq) const {
        const int ks = u.ko / kbytes; const int col0 = u.pn * BM + wc * 32 + 4 * fq;
        float* base = part + ((size_t)ks * 1024 + (size_t)(u.pm - 64) * BM) * 2048;
#pragma unroll
        for (int ai = 0; ai < 2; ++ai)
#pragma unroll
            for (int m = 0; m < 4; ++m) { float* op = base + (size_t)(ai * HALF + wr * 64 + m * 16 + fr) * 2048;
#pragma unroll
                for (int bj = 0; bj < 2; ++bj)
#pragma unroll
                    for (int n = 0; n < 2; ++n) st16_wt(op + col0 + bj * HALF + n * 16, __builtin_bit_cast(u32x4, acc[ai][bj][m][n])); }
    }
};
template <class Epi, class Sched, bool ALIGN_EPI = false, bool SP2 = false>
__device__ __forceinline__ void gemm_phase(PG8_LAS unsigned char* lds, const Gemm g, const Sched& S, const Epi& E) {
    const int tid = threadIdx.x, wid = __builtin_amdgcn_readfirstlane(tid >> 6), lane = tid & 63, wr = wid >> 2, wc = wid & 3, fr = lane & 15, fq = lane >> 4;
    const int K = g.K, nt = g.nt;
    unsigned voffA[2], voffB[2];
#pragma unroll
    for (int i = 0; i < 2; ++i) { int R, C; stage_rc(tid * 16 + i * 8192, R, C); const int Rb = Epi::PERM ? ((R & ~31) + perm32(R & 31)) : R;
        voffA[i] = (unsigned)(R * K + C) * 2u; voffB[i] = (unsigned)(Rb * K + C) * 2u; }
    const size_t kstep = (size_t)(BK * 2);
    const size_t hstep = (size_t)HALF * K * 2;
    const size_t tstep = 2 * hstep;
    const unsigned ldsw = (unsigned)wid * 1024u;
    const int aoff = lds_byte(wr * 64 + fr, fq * 8), boff = lds_byte(wc * 32 + fr, fq * 8);
#define PG8_SA(b, h) (((b) * 2 + (h)) * HTB)
#define PG8_SB(b, h) ((4 + (b) * 2 + (h)) * HTB)
#define PG8_STAGE(bufoff, gbase, voff) do { _Pragma("unroll") for (int _i = 0; _i < 2; ++_i) \
        __builtin_amdgcn_global_load_lds((const unsigned*)((const char*)(gbase) + (voff)[_i]), (PG8_LAS unsigned*)(lds + (bufoff) + ldsw + _i * 8192), 16, 0, 0); } while (0)
#define PG8_LDA(dst, b, h) do { _Pragma("unroll") for (int m = 0; m < 4; ++m) _Pragma("unroll") for (int k = 0; k < 2; ++k) dst[m][k] = *(const PG8_LAS bf16x8*)(lds + PG8_SA(b, h) + aoff + m * 2048 + k * 1024); } while (0)
#define PG8_LDB(dst, b, h) do { _Pragma("unroll") for (int n = 0; n < 2; ++n) _Pragma("unroll") for (int k = 0; k < 2; ++k) dst[n][k] = *(const PG8_LAS bf16x8*)(lds + PG8_SB(b, h) + boff + n * 2048 + k * 1024); } while (0)
#define PG8_MMA(ai, bj, At, Bt) do { __builtin_amdgcn_s_setprio(1); _Pragma("unroll") for (int m = 0; m < 4; ++m) _Pragma("unroll") for (int n = 0; n < 2; ++n) _Pragma("unroll") for (int k = 0; k < 2; ++k) \
        acc[ai][bj][m][n] = __builtin_amdgcn_mfma_f32_16x16x32_bf16(Bt[n][k], At[m][k], acc[ai][bj][m][n], 0, 0, 0); __builtin_amdgcn_s_setprio(0); } while (0)
#define PG8_WAIT_V(n) asm volatile("s_waitcnt vmcnt(" #n ")" ::: "memory")
#define PG8_WAIT_L(n) asm volatile("s_waitcnt lgkmcnt(" #n ")" ::: "memory")
#define PG8_BAR __builtin_amdgcn_s_barrier()
#define PG8_SCHED __builtin_amdgcn_sched_barrier(0)
    Unit cur, nxt; int ui = 0;
    if (!S.next(0, cur)) return;
    f32x4 acc[2][2][4][2];
#pragma unroll
    for (int a = 0; a < 2; ++a)
#pragma unroll
        for (int b = 0; b < 2; ++b)
#pragma unroll
            for (int m = 0; m < 4; ++m)
#pragma unroll
                for (int n = 0; n < 2; ++n) acc[a][b][m][n] = (f32x4){0.f, 0.f, 0.f, 0.f};
    bf16x8 At[4][2], B0[2][2], B1[2][2];
    const char* cA = (const char*)g.A + (size_t)cur.pm * tstep + cur.ko; const char* cB = (const char*)g.Bt + (size_t)cur.pn * tstep + cur.ko;
    S.a_ready(cur);
    if constexpr (SP2) {
        PG8_STAGE(PG8_SB(0, 0), cB, voffB); PG8_STAGE(PG8_SB(0, 1), cB + hstep, voffB); PG8_STAGE(PG8_SA(0, 0), cA, voffA); PG8_STAGE(PG8_SA(0, 1), cA + hstep, voffA);
        if (wr == 1) PG8_BAR;
        PG8_WAIT_V(2); PG8_BAR;
        PG8_STAGE(PG8_SB(1, 0), cB + kstep, voffB); PG8_STAGE(PG8_SA(1, 0), cA + kstep, voffA); PG8_STAGE(PG8_SB(1, 1), cB + hstep + kstep, voffB);
        PG8_WAIT_V(6); PG8_BAR;
    } else {
        PG8_STAGE(PG8_SB(0, 0), cB, voffB); PG8_STAGE(PG8_SA(0, 0), cA, voffA); PG8_STAGE(PG8_SB(0, 1), cB + hstep, voffB); PG8_STAGE(PG8_SA(0, 1), cA + hstep, voffA);
        if (wr == 1) PG8_BAR;
        PG8_WAIT_V(4); PG8_BAR;
        PG8_STAGE(PG8_SB(1, 0), cB + kstep, voffB); PG8_STAGE(PG8_SA(1, 0), cA + kstep, voffA); PG8_STAGE(PG8_SB(1, 1), cB + hstep + kstep, voffB);
        PG8_WAIT_V(6); PG8_BAR;
    }
    for (;;) {
        const bool has_next = S.next(ui + 1, nxt);
        const char* nA = has_next ? (const char*)g.A + (size_t)nxt.pm * tstep + nxt.ko : cA; const char* nB = has_next ? (const char*)g.Bt + (size_t)nxt.pn * tstep + nxt.ko : cB;
        for (int t = 0; t < nt; t += 2) {
            const bool last = (t == nt - 2);
            const char* a1 = cA + (size_t)(t + 1) * kstep;
            const char* a2 = last ? nA : cA + (size_t)(t + 2) * kstep; const char* b2 = last ? nB : cB + (size_t)(t + 2) * kstep;
            const char* a3 = a2 + kstep; const char* b3 = b2 + kstep;
            if (last && has_next) S.a_ready(nxt);
            if constexpr (SP2) {
            PG8_LDB(B0, 0, 0); PG8_LDB(B1, 0, 1); PG8_SCHED; PG8_LDA(At, 0, 0); PG8_STAGE(PG8_SA(1, 1), a1 + hstep, voffA);
            PG8_WAIT_V(8); PG8_WAIT_L(0); PG8_BAR; PG8_MMA(0, 0, At, B0); PG8_MMA(0, 1, At, B1); PG8_BAR; PG8_SCHED;
            PG8_LDA(At, 0, 1); PG8_STAGE(PG8_SB(0, 0), b2, voffB); PG8_STAGE(PG8_SB(0, 1), b2 + hstep, voffB); PG8_STAGE(PG8_SA(0, 0), a2, voffA);
            PG8_WAIT_V(8); PG8_WAIT_L(0); PG8_BAR; PG8_MMA(1, 0, At, B0); PG8_MMA(1, 1, At, B1); PG8_BAR; PG8_SCHED;
            PG8_LDB(B0, 1, 0); PG8_LDB(B1, 1, 1); PG8_SCHED; PG8_LDA(At, 1, 0); PG8_STAGE(PG8_SA(0, 1), a2 + hstep, voffA);
            PG8_WAIT_V(8); PG8_WAIT_L(0); PG8_BAR; PG8_MMA(0, 0, At, B0); PG8_MMA(0, 1, At, B1); PG8_BAR; PG8_SCHED;
            PG8_LDA(At, 1, 1); PG8_STAGE(PG8_SB(1, 0), b3, voffB); PG8_STAGE(PG8_SB(1, 1), b3 + hstep, voffB); PG8_STAGE(PG8_SA(1, 0), a3, voffA);
            PG8_WAIT_V(8); PG8_WAIT_L(0); PG8_BAR; PG8_MMA(1, 0, At, B0); PG8_MMA(1, 1, At, B1); PG8_BAR; PG8_SCHED;
            } else {
            PG8_LDB(B0, 0, 0); PG8_SCHED; PG8_LDA(At, 0, 0); PG8_STAGE(PG8_SA(1, 1), a1 + hstep, voffA);
            PG8_WAIT_L(8); PG8_BAR; PG8_WAIT_L(0); PG8_MMA(0, 0, At, B0); PG8_BAR; PG8_SCHED;
            PG8_LDB(B1, 0, 1); PG8_STAGE(PG8_SB(0, 0), b2, voffB);
            PG8_BAR; PG8_WAIT_L(0); PG8_MMA(0, 1, At, B1); PG8_BAR;
            PG8_LDA(At, 0, 1); PG8_STAGE(PG8_SA(0, 0), a2, voffA);
            PG8_BAR; PG8_WAIT_L(0); PG8_MMA(1, 0, At, B0); PG8_BAR; PG8_SCHED;
            PG8_STAGE(PG8_SB(0, 1), b2 + hstep, voffB);
            PG8_WAIT_V(6); PG8_BAR; PG8_MMA(1, 1, At, B1); PG8_BAR;
            PG8_LDB(B0, 1, 0); PG8_SCHED; PG8_LDA(At, 1, 0); PG8_STAGE(PG8_SA(0, 1), a2 + hstep, voffA);
            PG8_WAIT_L(8); PG8_BAR; PG8_WAIT_L(0); PG8_MMA(0, 0, At, B0); PG8_BAR; PG8_SCHED;
            PG8_LDB(B1, 1, 1); PG8_STAGE(PG8_SB(1, 0), b3, voffB);
            PG8_BAR; PG8_WAIT_L(0); PG8_MMA(0, 1, At, B1); PG8_BAR;
            PG8_LDA(At, 1, 1); PG8_STAGE(PG8_SA(1, 0), a3, voffA);
            PG8_BAR; PG8_WAIT_L(0); PG8_MMA(1, 0, At, B0); PG8_BAR; PG8_SCHED;
            PG8_STAGE(PG8_SB(1, 1), b3 + hstep, voffB);
            PG8_WAIT_V(6); PG8_BAR; PG8_MMA(1, 1, At, B1); PG8_BAR;
            }
        }
        if constexpr (ALIGN_EPI) { if (wr == 0) PG8_BAR; }
        if constexpr (!Epi::AFTER_DRAIN) { E(acc, cur, wr, wc, fr, fq); S.done(cur); }
        if (!has_next) break;
#pragma unroll
        for (int a = 0; a < 2; ++a)
#pragma unroll
            for (int b = 0; b < 2; ++b)
#pragma unroll
                for (int m = 0; m < 4; ++m)
#pragma unroll
                    for (int n = 0; n < 2; ++n) acc[a][b][m][n] = (f32x4){0.f, 0.f, 0.f, 0.f};
        cur = nxt; cA = nA; cB = nB; ++ui;
        if constexpr (ALIGN_EPI) { if (wr == 1) PG8_BAR; }
    }
    PG8_WAIT_V(0);
    if constexpr (!ALIGN_EPI) { if (wr == 0) PG8_BAR; }
    PG8_BAR;
    if constexpr (Epi::AFTER_DRAIN) { E.fused(acc, cur, wr, wc, fr, fq, lds, wid, lane); S.done(cur); }
#undef PG8_SA
#undef PG8_SB
#undef PG8_STAGE
#undef PG8_LDA
#undef PG8_LDB
#undef PG8_MMA
#undef PG8_WAIT_V
#undef PG8_WAIT_L
#undef PG8_BAR
#undef PG8_SCHED
}
}
namespace attn {
using bf16 = __hip_bfloat16;
constexpr int   D = 128, NW = 8, QBLK = 32, KVBLK = 64;
constexpr float SCALE = 0.088388347648318440f;
#ifndef ATTN_THR
#define ATTN_THR 8.f
#endif
constexpr float THR = ATTN_THR;
constexpr int SDEPTH = 2;
constexpr int LDQ = 1024, LDK = 128, LDO = 2048;
constexpr size_t SHM_V = KVBLK * D * 2, SHM_K = KVBLK * D * 2, SHM_ATTN = 2 * SHM_V + 2 * SHM_K + NW * 64 * 4;
__device__ __forceinline__ unsigned short f2bf16(float f) { unsigned u = __builtin_bit_cast(unsigned, f); return (unsigned short)((u + 0x7fffu + ((u >> 16) & 1u)) >> 16); }
using bf16x8 = __attribute__((ext_vector_type(8))) short;
using s16x4  = __attribute__((ext_vector_type(4))) short;
using f32x16 = __attribute__((ext_vector_type(16))) float;
using f32x8  = __attribute__((ext_vector_type(8))) float;
using u32x4  = __attribute__((ext_vector_type(4))) unsigned;
#define KSWZ(row, colB) ((row) * 256 + ((colB) ^ (((row) & 7) << 4)))
#define SBAR() __builtin_amdgcn_sched_barrier(0)
__device__ __forceinline__ int crow(int r, int hi) { return (r & 3) + 8 * (r >> 2) + 4 * hi; }
__device__ __forceinline__ unsigned cvtpk(float lo, float hi) {
  unsigned r; asm volatile("v_cvt_pk_bf16_f32 %0, %1, %2" : "=v"(r) : "v"(lo), "v"(hi)); return r;
}
template <typename TIn> struct Stage;
template <> struct Stage<bf16>  { using T = bf16x8;
  __device__ static __forceinline__ T ld8(const bf16* p) { return *reinterpret_cast<const bf16x8*>(p); }
  __device__ static __forceinline__ bf16x8 tobf(T x) { return x; } };
template <> struct Stage<float> { using T = f32x8;
  __device__ static __forceinline__ T ld8(const float* p) { return *reinterpret_cast<const f32x8*>(p); }
  __device__ static __forceinline__ bf16x8 tobf(T x) {
    u32x4 w = {cvtpk(x[0], x[1]), cvtpk(x[2], x[3]), cvtpk(x[4], x[5]), cvtpk(x[6], x[7])}; return *reinterpret_cast<bf16x8*>(&w); } };

__device__ __forceinline__ void partialSM(f32x16& p0, f32x16& p1, float& m_reg, float& mn, float& alpha) {
  constexpr float C = SCALE * 1.4426950408889634f;
  float pmax = p0[0]; for (int r = 1; r < 16; ++r) pmax = fmaxf(pmax, p0[r]); for (int r = 0; r < 16; ++r) pmax = fmaxf(pmax, p1[r]);
  { auto rr = __builtin_amdgcn_permlane32_swap(__float_as_uint(pmax), __float_as_uint(pmax), false, false);
    pmax = fmaxf(__uint_as_float(rr[0]), __uint_as_float(rr[1])); }
  if (__builtin_expect(__all(pmax - m_reg <= THR / SCALE), 1)) { mn = m_reg; alpha = 1.f; }
  else { mn = fmaxf(m_reg, pmax); alpha = __builtin_amdgcn_exp2f((m_reg - mn) * C); m_reg = mn; }
  float mnC = -mn * C;
  for (int r = 0; r < 16; ++r) p0[r] = fmaf(p0[r], C, mnC); for (int r = 0; r < 16; ++r) p1[r] = fmaf(p1[r], C, mnC);
  for (int r = 0; r < 16; ++r) p0[r] = __builtin_amdgcn_exp2f(p0[r]);
}
__device__ __forceinline__ void finishSM(f32x16& p0, f32x16& p1, float alpha, float& l_reg, bf16x8& pa0, bf16x8& pa1, bf16x8& pa2, bf16x8& pa3) {
  for (int r = 0; r < 16; ++r) p1[r] = __builtin_amdgcn_exp2f(p1[r]);
  float ps = 0; for (int r = 0; r < 16; ++r) ps += p0[r]; for (int r = 0; r < 16; ++r) ps += p1[r];
  { auto rr = __builtin_amdgcn_permlane32_swap(__float_as_uint(ps), __float_as_uint(ps), false, false);
    ps = __uint_as_float(rr[0]) + __uint_as_float(rr[1]); }
  l_reg = l_reg * alpha + ps;
#define PK4(P, BASE, OUT) do { unsigned a0 = cvtpk(P[BASE + 0], P[BASE + 1]), a1 = cvtpk(P[BASE + 2], P[BASE + 3]);   \
    unsigned b0 = cvtpk(P[BASE + 4], P[BASE + 5]), b1 = cvtpk(P[BASE + 6], P[BASE + 7]);                              \
    auto r0 = __builtin_amdgcn_permlane32_swap(a0, b0, false, false); auto r1 = __builtin_amdgcn_permlane32_swap(a1, b1, false, false); \
    u32x4 w = {r0[0], r1[0], r0[1], r1[1]}; OUT = *reinterpret_cast<bf16x8*>(&w); } while (0)
  PK4(p0, 0, pa0); PK4(p0, 8, pa1); PK4(p1, 0, pa2); PK4(p1, 8, pa3);
#undef PK4
}
__device__ __forceinline__ void qkt(f32x16& p0, f32x16& p1, const bf16* Ks, const bf16x8* qr, int r32, int hi) {
  p0 = f32x16{}; p1 = f32x16{};
  for (int d0 = 0; d0 < 8; ++d0) { int cb = (d0 * 16 + hi * 8) * 2;
    bf16x8 b0 = *reinterpret_cast<const bf16x8*>((const char*)Ks + KSWZ(r32, cb));
    bf16x8 b1 = *reinterpret_cast<const bf16x8*>((const char*)Ks + KSWZ(32 + r32, cb));
    p0 = __builtin_amdgcn_mfma_f32_32x32x16_bf16(b0, qr[d0], p0, 0, 0, 0);
    p1 = __builtin_amdgcn_mfma_f32_32x32x16_bf16(b1, qr[d0], p1, 0, 0, 0); }
}
__device__ __forceinline__ int v_st(int k, int c) { const int kk = (k & ~0xC) | ((k & 4) << 1) | ((k & 8) >> 1); return ((kk >> 3) * 4 + (c >> 5)) * 512 + ((kk & 7) * 32 + (c & 31)) * 2; }
__device__ __forceinline__ int v_rd_base(int lane) { return ((lane & 3) << 3) | (((lane >> 2) & 3) << 6) | (((lane >> 4) & 1) << 5) | (((lane >> 5) & 1) << 8); }
constexpr int v_rd_off(int d0, int ks, int half) { return d0 * 512 + ks * 4096 + half * 2048; }
template <int OFF> __device__ __forceinline__ s16x4 tr_read(int vb) {
  s16x4 r; asm volatile("ds_read_b64_tr_b16 %0, %1 offset:%2" : "=&v"(r) : "v"(vb), "i"(OFF) : "memory"); return r;
}
template <int D0> __device__ __forceinline__ void pv_one(f32x16& od, int vb, bf16x8 pa0, bf16x8 pa1, bf16x8 pa2, bf16x8 pa3) {
  const s16x4 l0 = tr_read<v_rd_off(D0, 0, 0)>(vb), h0 = tr_read<v_rd_off(D0, 0, 1)>(vb), l1 = tr_read<v_rd_off(D0, 1, 0)>(vb), h1 = tr_read<v_rd_off(D0, 1, 1)>(vb);
  const s16x4 l2 = tr_read<v_rd_off(D0, 2, 0)>(vb), h2 = tr_read<v_rd_off(D0, 2, 1)>(vb), l3 = tr_read<v_rd_off(D0, 3, 0)>(vb), h3 = tr_read<v_rd_off(D0, 3, 1)>(vb);
  asm volatile("s_waitcnt lgkmcnt(0)" ::: "memory"); SBAR();
#define PK(L, H) (bf16x8){L[0], L[1], L[2], L[3], H[0], H[1], H[2], H[3]}
  od = __builtin_amdgcn_mfma_f32_32x32x16_bf16(pa0, PK(l0, h0), od, 0, 0, 0);
  od = __builtin_amdgcn_mfma_f32_32x32x16_bf16(pa1, PK(l1, h1), od, 0, 0, 0);
  od = __builtin_amdgcn_mfma_f32_32x32x16_bf16(pa2, PK(l2, h2), od, 0, 0, 0);
  od = __builtin_amdgcn_mfma_f32_32x32x16_bf16(pa3, PK(l3, h3), od, 0, 0, 0);
#undef PK
}
__device__ __forceinline__ void pv_d0(f32x16* o, int vb, bf16x8 pa0, bf16x8 pa1, bf16x8 pa2, bf16x8 pa3) {
  pv_one<0>(o[0], vb, pa0, pa1, pa2, pa3); pv_one<1>(o[1], vb, pa0, pa1, pa2, pa3); pv_one<2>(o[2], vb, pa0, pa1, pa2, pa3); pv_one<3>(o[3], vb, pa0, pa1, pa2, pa3);
}
template <typename TQ>
__device__ __forceinline__ void attn_dense_body(const TQ* __restrict__ Qb, const bf16* __restrict__ Kh, const bf16* __restrict__ Vh,
                                                unsigned short* __restrict__ Ob, int seq, char* lds) {
  using St = Stage<bf16>; using SQ = Stage<TQ>;
  const int tid = threadIdx.x, wid = tid >> 6, lane = tid & 63, r32 = lane & 31, hi = lane >> 5;
  bf16* V_lds = (bf16*)lds; bf16* K_lds = (bf16*)(lds + 2 * SHM_V);
  float* ws = (float*)(lds + 2 * SHM_V + 2 * SHM_K) + wid * 64; float* li_l = ws; float* al_l = ws + 32;
  float m_reg = -1e30f, l_reg = 0; f32x16 o[4] = {}; bf16x8 qr[8];
  const TQ* Qw = Qb + (long)(wid * QBLK + r32) * LDQ + hi * 8;
#pragma unroll
  for (int d0 = 0; d0 < 8; ++d0) qr[d0] = SQ::tobf(SQ::ld8(Qw + d0 * 16));
  const int sr = tid >> 4, sc = (tid & 15) * 8, vst0 = v_st(sr, sc), vst1 = v_st(32 + sr, sc);
  const int vb0 = (int)(uintptr_t)V_lds + v_rd_base(lane);
  struct { typename St::T vs0, vs1, ks0, ks1; } sr_[SDEPTH];
#define SLOAD(i, k0) do { sr_[i].vs0 = St::ld8(&Vh[(long)((k0) + sr) * LDK + sc]); sr_[i].vs1 = St::ld8(&Vh[(long)((k0) + 32 + sr) * LDK + sc]); \
    sr_[i].ks0 = St::ld8(&Kh[(long)((k0) + sr) * LDK + sc]); sr_[i].ks1 = St::ld8(&Kh[(long)((k0) + 32 + sr) * LDK + sc]); } while (0)
#define SWRITE(b, i) do { *(bf16x8*)((char*)V_lds + (b) * SHM_V + vst0) = St::tobf(sr_[i].vs0);          \
    *(bf16x8*)((char*)V_lds + (b) * SHM_V + vst1) = St::tobf(sr_[i].vs1); int kc = sc * 2;               \
    *(bf16x8*)((char*)K_lds + (b) * SHM_K + KSWZ(sr, kc)) = St::tobf(sr_[i].ks0);                       \
    *(bf16x8*)((char*)K_lds + (b) * SHM_K + KSWZ(32 + sr, kc)) = St::tobf(sr_[i].ks1); } while (0)
#define SWAIT() do { if constexpr (SDEPTH == 2) asm volatile("s_waitcnt vmcnt(4)" ::: "memory"); else asm volatile("s_waitcnt vmcnt(0)" ::: "memory"); } while (0)
#define RESC(a) do { if (__any((a) < 1.f)) { if (hi == 0) al_l[r32] = (a); asm volatile("s_waitcnt lgkmcnt(0)" ::: "memory"); \
    for (int d = 0; d < 4; ++d) for (int r = 0; r < 16; ++r) o[d][r] *= al_l[crow(r, hi)]; } } while (0)
  f32x16 pA0, pA1, pB0, pB1; float mnA, mnB, alA, alB; bf16x8 pa0, pa1, pa2, pa3; const int NT = seq / KVBLK;
  constexpr int SE = 0, SO = SDEPTH - 1;
  SLOAD(SE, 0); asm volatile("s_waitcnt vmcnt(0)" ::: "memory"); SWRITE(0, SE); __syncthreads();
  qkt(pA0, pA1, K_lds, qr, r32, hi); partialSM(pA0, pA1, m_reg, mnA, alA);
  SLOAD(SO, KVBLK); if constexpr (SDEPTH == 2) { if (2 < NT) SLOAD(SE, 2 * KVBLK); }
  SWAIT(); SWRITE(1, SO); __syncthreads();
  for (int j = 1; j + 1 < NT; j += 2) {
    SBAR(); qkt(pB0, pB1, (bf16*)((char*)K_lds + SHM_K), qr, r32, hi);
    finishSM(pA0, pA1, alA, l_reg, pa0, pa1, pa2, pa3); SBAR();
    SLOAD(SO, (j + SDEPTH) * KVBLK); SBAR();
    pv_d0(o, vb0, pa0, pa1, pa2, pa3); partialSM(pB0, pB1, m_reg, mnB, alB);
    __syncthreads(); SWAIT(); SWRITE(0, SE);
    RESC(alB); __syncthreads();
    SBAR(); qkt(pA0, pA1, K_lds, qr, r32, hi);
    finishSM(pB0, pB1, alB, l_reg, pa0, pa1, pa2, pa3); SBAR();
    if (SDEPTH == 1 || j + 3 < NT) SLOAD(SE, (j + 1 + SDEPTH) * KVBLK); SBAR();
    pv_d0(o, vb0 + (int)SHM_V, pa0, pa1, pa2, pa3); partialSM(pA0, pA1, m_reg, mnA, alA);
    __syncthreads(); SWAIT(); SWRITE(1, SO);
    RESC(alA); __syncthreads();
  }
  SBAR(); qkt(pB0, pB1, (bf16*)((char*)K_lds + SHM_K), qr, r32, hi);
  finishSM(pA0, pA1, alA, l_reg, pa0, pa1, pa2, pa3); SBAR();
  pv_d0(o, vb0, pa0, pa1, pa2, pa3); partialSM(pB0, pB1, m_reg, mnB, alB);
  __syncthreads(); RESC(alB);
  finishSM(pB0, pB1, alB, l_reg, pa0, pa1, pa2, pa3); SBAR();
  pv_d0(o, vb0 + (int)SHM_V, pa0, pa1, pa2, pa3);
  if (hi == 0) li_l[r32] = l_reg; asm volatile("s_waitcnt lgkmcnt(0)" ::: "memory");
  float rli[16];
#pragma unroll
  for (int r = 0; r < 16; ++r) rli[r] = __builtin_amdgcn_rcpf(li_l[crow(r, hi)]);
  unsigned short* Ow = Ob + (long)(wid * QBLK) * LDO;
#pragma unroll
  for (int r = 0; r < 16; ++r) { int orow = crow(r, hi);
    for (int d0 = 0; d0 < 4; ++d0) Ow[(long)orow * LDO + d0 * 32 + r32] = f2bf16(o[d0][r] * rli[r]); }
#undef SLOAD
#undef SWRITE
#undef SWAIT
#undef RESC
}
}
#define GAS __attribute__((address_space(1)))
#define LAS __attribute__((address_space(3)))
typedef unsigned short bf16r;
typedef float f32x4 __attribute__((ext_vector_type(4)));
typedef unsigned u32x4 __attribute__((ext_vector_type(4)));
typedef unsigned u32x2 __attribute__((ext_vector_type(2)));
typedef short bf16x8 __attribute__((ext_vector_type(8)));

constexpr int DM = 2048, NB = 4, SEQ = 4096, CTX = 256, NLAT = NB * SEQ, NCTX = NB * CTX, NROW = NLAT + NCTX;
constexpr int INC = 3584, DFF = 8192, NMODC = 6 * DM, KVLEN = CTX + SEQ;
constexpr int NLAYER = 2;
constexpr float LN_EPS = 1e-6f, RMS_EPS = 1e-6f, DN_ALPHA = 1.4142135623730951f;
constexpr size_t MiB = 1u << 20;
constexpr size_t WS_ROPE = 0, WS_BAR = 768 * 1024, WS_BAR_BYTES = 16384, WS_STAT = 576 * 1024, WS_MOD = 64 * 1024, WS_WIN = 1 * MiB, WS_WOUT = 29 * MiB, WS_WFF1 = 45 * MiB, WS_WFF2 = 109 * MiB;
constexpr size_t WS_X = 173 * MiB, WS_H = 309 * MiB, WS_S = 377 * MiB;
constexpr size_t WS_P = WS_S, WS_Q = 496 * MiB, WS_K = 530 * MiB, WS_V = 539 * MiB, WS_MIX = 548 * MiB, WS_ACT = WS_S, WS_PART = 649 * MiB, WS_END = 713 * MiB;
static_assert(WS_WIN + 2ull * INC * DM * 2 <= WS_WOUT && WS_WOUT + 2ull * DM * DM * 2 <= WS_WFF1 && WS_WFF1 + 2ull * DFF * DM * 2 <= WS_WFF2 && WS_WFF2 + 2ull * DFF * DM * 2 <= WS_X, "ws weights");
static_assert(WS_X + (size_t)NROW * DM * 4 <= WS_H && WS_H + (size_t)NROW * DM * 2 <= WS_S && WS_P + (size_t)NROW * INC * 2 <= WS_Q && WS_Q + (size_t)NROW * 1024 * 2 <= WS_K, "ws act 1");
static_assert(WS_K + (size_t)NB * 2 * KVLEN * 128 * 2 <= WS_V && WS_V + (size_t)NB * 2 * KVLEN * 128 * 2 <= WS_MIX && WS_MIX + (size_t)NROW * DM * 2 <= WS_PART && WS_ACT + (size_t)NROW * DFF * 2 <= WS_PART && WS_PART + 8ull * NCTX * DM * 4 <= WS_END, "ws act 2");
static_assert(WS_MOD + 2ull * 5 * NMODC * 4 <= WS_STAT && WS_STAT + (size_t)NROW * 8 <= WS_BAR && WS_BAR + WS_BAR_BYTES <= WS_WIN, "ws mod");
constexpr int LDS_BYTES = 147456;

__device__ __forceinline__ unsigned f2bf(float f) { unsigned u = __builtin_bit_cast(unsigned, f); return (u + 0x7fffu + ((u >> 16) & 1u)) >> 16; }
__device__ __forceinline__ unsigned pk2(float lo, float hi) { return f2bf(lo) | (f2bf(hi) << 16); }
__device__ __forceinline__ float bflo(unsigned w) { return __builtin_bit_cast(float, w << 16); }
__device__ __forceinline__ float bfhi(unsigned w) { return __builtin_bit_cast(float, w & 0xffff0000u); }
__device__ __forceinline__ void unpack8(const u32x4 w, float (&x)[8]) { x[0] = bflo(w.x); x[1] = bfhi(w.x); x[2] = bflo(w.y); x[3] = bfhi(w.y); x[4] = bflo(w.z); x[5] = bfhi(w.z); x[6] = bflo(w.w); x[7] = bfhi(w.w); }
__device__ __forceinline__ u32x4 pack8(const float (&x)[8]) { u32x4 w; w.x = pk2(x[0], x[1]); w.y = pk2(x[2], x[3]); w.z = pk2(x[4], x[5]); w.w = pk2(x[6], x[7]); return w; }
__device__ __forceinline__ float wave_sum(float v) {
#pragma unroll
    for (int o = 1; o < 64; o <<= 1) v += __shfl_xor(v, o);
    return v;
}
__device__ __forceinline__ float gelu_tanh(float x) {
    const float u = 0.7978845608028654f * (x + 0.044715f * x * x * x);
    const float e = __expf(2.f * u);
    const float t = 1.f - 2.f * __builtin_amdgcn_rcpf(e + 1.f);
    return 0.5f * x * (1.f + t);
}
__device__ __forceinline__ float sigmoidf_(float x) { return __builtin_amdgcn_rcpf(1.f + __expf(-x)); }
#define LDS_WAIT() asm volatile("s_waitcnt lgkmcnt(0)" ::: "memory")

static __device__ const double ROPE_FREQ[32] = {1.0, 0.7498942093324559, 0.5623413251903491, 0.4216965034285822, 0.31622776601683794, 0.23713737056616552, 0.1778279410038923, 0.1333521432163324, 0.1, 0.07498942093324558, 0.05623413251903491, 0.042169650342858224, 0.03162277660168379, 0.023713737056616554, 0.01778279410038923, 0.01333521432163324, 0.01, 0.007498942093324558, 0.005623413251903491, 0.004216965034285823, 0.0031622776601683794, 0.0023713737056616554, 0.0017782794100389228, 0.001333521432163324, 0.001, 0.0007498942093324559, 0.0005623413251903491, 0.00042169650342858224, 0.00031622776601683794, 0.00023713737056616554, 0.00017782794100389227, 0.0001333521432163324};

__device__ __forceinline__ void p0_rope(float* rope, int gtid, int gthreads) {
    for (int idx = gtid; idx < 64 * 32; idx += gthreads) {
        const int p = idx >> 5, f = idx & 31;
        const double ang = (double)p * ROPE_FREQ[f];
        const double k = __builtin_rint(ang * 0.15915494309189535);
        const double r = ang - k * 6.283185307179586;
        const double r2 = r * r; double tc = 1.0, ts = 1.0, cc = 1.0, ss = 1.0;
#pragma unroll
        for (int n = 1; n <= 14; ++n) { tc *= -r2 * (1.0 / (double)((2 * n - 1) * (2 * n))); cc += tc; ts *= -r2 * (1.0 / (double)((2 * n) * (2 * n + 1))); ss += ts; }
        rope[2 * idx] = (float)cc; rope[2 * idx + 1] = (float)(r * ss);
    }
}
__device__ __forceinline__ void p0_mod(LAS unsigned char* lds, const float* c, const float* c_ctx, const float* w_mod, const float* b_mod, float* MOD, int bid, int G, int tid) {
    constexpr int NITEM = NLAYER * (NMODC / 128);
    if (bid >= NITEM) return;
    LAS float* condS = (LAS float*)lds;
    LAS float* red = (LAS float*)(lds + 5 * 2048 * 4);
    for (int i = tid; i < 5 * 2048; i += 512) { const int r = i >> 11, k = i & 2047; const float cv = (r < 4) ? c[r * 2048 + k] : c_ctx[k]; condS[i] = cv / (1.f + __expf(-cv)); }
    __syncthreads();
    const int kr = tid >> 5, cl = tid & 31;
    for (int item = bid; item < NITEM; item += G) {
        const int l = item / (NMODC / 128), n0 = (item % (NMODC / 128)) * 128;
        const float* wp = w_mod + ((size_t)l * 2048 + kr) * NMODC + n0 + 4 * cl;
        float acc[5][4];
#pragma unroll
        for (int r = 0; r < 5; ++r)
#pragma unroll
            for (int j = 0; j < 4; ++j) acc[r][j] = 0.f;
#pragma unroll 4
        for (int ks = 0; ks < 128; ++ks) {
            const f32x4 w = *(const f32x4*)(wp + (size_t)ks * 16 * NMODC); const int k = ks * 16 + kr;
#pragma unroll
            for (int r = 0; r < 5; ++r) { const float s = condS[r * 2048 + k];
#pragma unroll
                for (int j = 0; j < 4; ++j) acc[r][j] += s * w[j]; }
        }
#pragma unroll
        for (int r = 0; r < 5; ++r)
#pragma unroll
            for (int j = 0; j < 4; ++j) red[(kr * 32 + cl) * 20 + r * 4 + j] = acc[r][j];
        __syncthreads();
        for (int o = tid; o < 5 * 128; o += 512) { const int r = o >> 7, col = o & 127; float s = 0.f;
#pragma unroll
            for (int k2 = 0; k2 < 16; ++k2) s += red[(k2 * 32 + (col >> 2)) * 20 + r * 4 + (col & 3)];
            MOD[((size_t)l * 5 + r) * NMODC + n0 + col] = s + b_mod[(size_t)l * NMODC + n0 + col]; }
        __syncthreads();
    }
}
__device__ __forceinline__ void p0_transpose_item(const float* W, int K, int N, bf16r* WT, LAS float* scr, int item, int lane) {
    const int nblk = N / 64, kb = item / nblk, nb = item % nblk, k0 = 64 * kb, n0 = 64 * nb;
    const int r4 = lane >> 4, c4 = (lane & 15) * 4;
    f32x4 v[16];
#pragma unroll
    for (int i = 0; i < 16; ++i) v[i] = *(const f32x4*)(W + (size_t)(k0 + 4 * i + r4) * N + n0 + c4);
#pragma unroll
    for (int i = 0; i < 16; ++i) { LAS float* d = scr + (4 * i + r4) * 65 + c4; d[0] = v[i].x; d[1] = v[i].y; d[2] = v[i].z; d[3] = v[i].w; }
    LDS_WAIT(); asm volatile("" ::: "memory");
    const int c = lane & 7;
#pragma unroll
    for (int j = 0; j < 8; ++j) { const int n = (lane >> 3) + 8 * j; const LAS float* s = scr + (8 * c) * 65 + n;
        u32x4 o; o.x = pk2(s[0 * 65], s[1 * 65]); o.y = pk2(s[2 * 65], s[3 * 65]); o.z = pk2(s[4 * 65], s[5 * 65]); o.w = pk2(s[6 * 65], s[7 * 65]);
        *(u32x4*)(WT + (size_t)(n0 + n) * K + k0 + 8 * c) = o; }
    LDS_WAIT(); asm volatile("" ::: "memory");
}

__device__ __forceinline__ void row_stats(const f32x4 (&v)[8], float& mean, float& rstd) {
    float s = 0.f;
#pragma unroll
    for (int j = 0; j < 8; ++j) s += (v[j].x + v[j].y) + (v[j].z + v[j].w);
    mean = wave_sum(s) * (1.f / DM); float q = 0.f;
#pragma unroll
    for (int j = 0; j < 8; ++j) { const f32x4 d = v[j] - mean; q += (d.x * d.x + d.y * d.y) + (d.z * d.z + d.w * d.w); }
    rstd = 1.f / sqrtf(wave_sum(q) * (1.f / DM) + LN_EPS);
}
__device__ __forceinline__ void row_pass(const float* src_lat, const float* src_ctx, int nrows, const float* lng, const float* lnb, float* dst_lat, float* dst_ctx, float* stat,
                                         const float* modl  , int shift_off, int scale_off, bf16r* H, int gw, int NGW, int lane) {
    f32x4 v[8], vn[8];
    if (gw < nrows) { const float* sp = gw < NLAT ? src_lat + (size_t)gw * DM : src_ctx + (size_t)(gw - NLAT) * DM;
#pragma unroll
        for (int j = 0; j < 8; ++j) v[j] = *((const f32x4*)sp + 64 * j + lane); }
    for (int row = gw; row < nrows; row += NGW) {
        const bool lat = row < NLAT;
        const int rown = row + NGW;
        if (rown < nrows) { const float* sp = rown < NLAT ? src_lat + (size_t)rown * DM : src_ctx + (size_t)(rown - NLAT) * DM;
#pragma unroll
            for (int j = 0; j < 8; ++j) vn[j] = *((const f32x4*)sp + 64 * j + lane); }
        float mean, rstd;
        if (lng) {
            row_stats(v, mean, rstd);
            if (stat && lane == 0) { stat[2 * (size_t)row] = mean; stat[2 * (size_t)row + 1] = rstd; }
            float* dp = lat ? (dst_lat ? dst_lat + (size_t)row * DM : nullptr) : (dst_ctx ? dst_ctx + (size_t)(row - NLAT) * DM : nullptr);
#pragma unroll
            for (int j = 0; j < 8; ++j) { const f32x4 g = *((const f32x4*)lng + 64 * j + lane), b = *((const f32x4*)lnb + 64 * j + lane);
                v[j] = (v[j] - mean) * rstd * g + b; if (dp) *((f32x4*)dp + 64 * j + lane) = v[j]; }
        }
        if (modl) {
            row_stats(v, mean, rstd);
            const float* mr = modl + (size_t)(lat ? (row >> 12) : 4) * NMODC;
            bf16r* hp = H + (size_t)row * DM;
#pragma unroll
            for (int j = 0; j < 8; ++j) { const f32x4 sh = *((const f32x4*)(mr + shift_off) + 64 * j + lane), sc = *((const f32x4*)(mr + scale_off) + 64 * j + lane);
                const f32x4 o = (v[j] - mean) * rstd * (sc + 1.f) + sh; u32x2 w; w.x = pk2(o.x, o.y); w.y = pk2(o.z, o.w);
                *((u32x2*)hp + 64 * j + lane) = w; }
        }
#pragma unroll
        for (int j = 0; j < 8; ++j) v[j] = vn[j];
    }
}
__device__ __forceinline__ void row_pass_ctx(const float* src, const float* bstat, const float* bg, const float* bb, const float* part, const float* gate  , float* xdst,
                                             const float* lng, const float* lnb, float* stat, const float* modl, int shift_off, int scale_off, bf16r* H, int gw, int NGW, int lane) {
    for (int r = gw; r < NCTX; r += NGW) {
        const int row = NLAT + r;
        f32x4 v[8];
        float bm = 0.f, brs = 1.f; if (bstat) { bm = bstat[2 * (size_t)row]; brs = bstat[2 * (size_t)row + 1]; }
#pragma unroll
        for (int j = 0; j < 8; ++j) { f32x4 x = *((const f32x4*)(src + (size_t)r * DM) + 64 * j + lane);
            if (bstat) x = (x - bm) * brs * *((const f32x4*)bg + 64 * j + lane) + *((const f32x4*)bb + 64 * j + lane);
            f32x4 s = *((const f32x4*)(part + (size_t)r * DM) + 64 * j + lane);
#pragma unroll
            for (int k = 1; k < 8; ++k) s += *((const f32x4*)(part + ((size_t)k * NCTX + r) * DM) + 64 * j + lane);
            v[j] = x * DN_ALPHA + *((const f32x4*)gate + 64 * j + lane) * s;
            if (xdst) *((f32x4*)(xdst + (size_t)r * DM) + 64 * j + lane) = v[j]; }
        float mean, rstd;
        row_stats(v, mean, rstd);
        if (lane == 0) { stat[2 * (size_t)row] = mean; stat[2 * (size_t)row + 1] = rstd; }
#pragma unroll
        for (int j = 0; j < 8; ++j) v[j] = (v[j] - mean) * rstd * *((const f32x4*)lng + 64 * j + lane) + *((const f32x4*)lnb + 64 * j + lane);
        row_stats(v, mean, rstd);
        const float* mr = modl + (size_t)4 * NMODC;
        bf16r* hp = H + (size_t)row * DM;
#pragma unroll
        for (int j = 0; j < 8; ++j) { const f32x4 sh = *((const f32x4*)(mr + shift_off) + 64 * j + lane), sc = *((const f32x4*)(mr + scale_off) + 64 * j + lane);
            const f32x4 o = (v[j] - mean) * rstd * (sc + 1.f) + sh; u32x2 w; w.x = pk2(o.x, o.y); w.y = pk2(o.z, o.w);
            *((u32x2*)hp + 64 * j + lane) = w; }
    }
}

__device__ __forceinline__ void rms_rope_apply(const u32x4 w1, const u32x4 w2, const float (&g1)[8], const float (&g2)[8], const f32x4 (&rp)[4], bool rope_on, u32x4& o1w, u32x4& o2w) {
    float x1[8], x2[8]; unpack8(w1, x1); unpack8(w2, x2);
    float ss = 0.f;
#pragma unroll
    for (int j = 0; j < 8; ++j) ss += x1[j] * x1[j] + x2[j] * x2[j];
    ss += __shfl_xor(ss, 1); ss += __shfl_xor(ss, 2); ss += __shfl_xor(ss, 4);
    const float rn = 1.f / sqrtf(ss * (1.f / 128.f) + RMS_EPS);
    float o1[8], o2[8];
#pragma unroll
    for (int j = 0; j < 8; ++j) { const float y1 = x1[j] * rn * g1[j], y2 = x2[j] * rn * g2[j];
        float c = 1.f, s = 0.f; if (rope_on) { c = rp[j >> 1][(j & 1) * 2]; s = rp[j >> 1][(j & 1) * 2 + 1]; }
        o1[j] = y1 * c - y2 * s; o2[j] = y1 * s + y2 * c; }
    o1w = pack8(o1); o2w = pack8(o2);
}
__device__ __forceinline__ void prep_qkv(const bf16r* __restrict__ P, bf16r* __restrict__ Qb, bf16r* __restrict__ Kb, bf16r* __restrict__ Vb, const float* __restrict__ qg, const float* __restrict__ kg,
                                         const float* __restrict__ rope, int nrows, bool ctx_q, int gw, int NGW, int lane) {
    const int i = lane & 7, a = i >> 2, f0 = (i & 3) * 8, head = lane >> 3, kvh = (lane & 15) >> 3, vj = lane & 31;
    float gq1[8], gq2[8], gk1[8], gk2[8];
#pragma unroll
    for (int j = 0; j < 8; ++j) { gq1[j] = qg[a * 64 + f0 + j]; gq2[j] = qg[a * 64 + 32 + f0 + j]; gk1[j] = kg[a * 64 + f0 + j]; gk2[j] = kg[a * 64 + 32 + f0 + j]; }
    for (int row0 = gw * 2; row0 < nrows; row0 += NGW * 2) {
        u32x4 q1[2], q2[2], k1[2], k2[2], vv[2]; f32x4 rp[2][4];
#pragma unroll
        for (int r = 0; r < 2; ++r) { const int row = row0 + r; const bf16r* prow = P + (size_t)row * INC;
            const bool lat = row < NLAT; const int t = lat ? (row & 4095) : ((row - NLAT) & 255);
            const bf16r* qs = prow + 2048 + head * 128 + a * 64 + f0; const bf16r* ks = prow + 3072 + kvh * 128 + a * 64 + f0;
            q1[r] = *(const u32x4*)qs; q2[r] = *(const u32x4*)(qs + 32); k1[r] = *(const u32x4*)ks; k2[r] = *(const u32x4*)(ks + 32); vv[r] = *(const u32x4*)(prow + 3328 + vj * 8);
            const int pos = (a == 0) ? (t >> 6) : (t & 63); const float* rpp = rope + (size_t)(pos * 32 + f0) * 2;
#pragma unroll
            for (int jj = 0; jj < 4; ++jj) rp[r][jj] = *(const f32x4*)(rpp + 4 * jj); }
#pragma unroll
        for (int r = 0; r < 2; ++r) { const int row = row0 + r;
            const bool lat = row < NLAT; const int b = lat ? (row >> 12) : ((row - NLAT) >> 8), t = lat ? (row & 4095) : ((row - NLAT) & 255);
            const int posk = lat ? CTX + t : t;
            u32x4 o1, o2;
            rms_rope_apply(q1[r], q2[r], gq1, gq2, rp[r], lat, o1, o2);
            if (lat || ctx_q) { bf16r* dst = Qb + (size_t)row * 1024 + head * 128 + a * 64 + f0; *(u32x4*)dst = o1; *(u32x4*)(dst + 32) = o2; }
            rms_rope_apply(k1[r], k2[r], gk1, gk2, rp[r], lat, o1, o2);
            if (lane < 16) { bf16r* dst = Kb + ((size_t)(b * 2 + kvh) * KVLEN + posk) * 128 + a * 64 + f0; *(u32x4*)dst = o1; *(u32x4*)(dst + 32) = o2; }
            if (lane < 32) *(u32x4*)(Vb + ((size_t)(b * 2 + (vj >> 4)) * KVLEN + posk) * 128 + (vj & 15) * 8) = vv[r]; }
    }
}

__device__ __forceinline__ void gmlp_ldw(const float* __restrict__ Wh, int wave, int lane, f32x4 (&w)[8]) {
    const float* p = Wh + (size_t)(16 * wave + (lane & 15)) * 128 + 8 * (lane >> 4);
#pragma unroll
    for (int ks = 0; ks < 4; ++ks) { w[2 * ks] = *(const f32x4*)(p + ks * 32); w[2 * ks + 1] = *(const f32x4*)(p + ks * 32 + 4); }
}
__device__ __forceinline__ void gmlp_item(LAS unsigned char* lds, const bf16r* __restrict__ P, bf16r* __restrict__ MIX, const float* __restrict__ lng, const float* __restrict__ lnb,
                                          const float* __restrict__ Ws  , const float* __restrict__ bs  , int ch, int tid, int wave, int lane) {
    constexpr int LDT = 136;
    LAS bf16r* vT = (LAS bf16r*)lds;
    const int r0 = ch * 128;
    f32x4 wreg[8]; gmlp_ldw(Ws, wave, lane, wreg);
    { float gl[8], bl[8];
#pragma unroll
      for (int j = 0; j < 8; ++j) { gl[j] = lng[lane * 8 + j]; bl[j] = lnb[lane * 8 + j]; }
#pragma unroll
      for (int hb = 0; hb < 2; ++hb) {
        u32x4 raw[8];
#pragma unroll
        for (int i = 0; i < 8; ++i) raw[i] = *(const u32x4*)(P + (size_t)(r0 + wave + 8 * (hb * 8 + i)) * INC + 512 + lane * 8);
#pragma unroll
        for (int i = 0; i < 8; ++i) { const int q = wave + 8 * (hb * 8 + i);
            float x[8]; unpack8(raw[i], x);
            float s = 0.f;
#pragma unroll
            for (int j = 0; j < 8; ++j) { x[j] = gelu_tanh(x[j]); s += x[j]; }
            const float mean = wave_sum(s) * (1.f / 512.f); float qq = 0.f;
#pragma unroll
            for (int j = 0; j < 8; ++j) { const float d = x[j] - mean; qq += d * d; }
            const float rstd = __builtin_amdgcn_rsqf(wave_sum(qq) * (1.f / 512.f) + LN_EPS);
#pragma unroll
            for (int j = 0; j < 8; ++j) { const float v = (x[j] - mean) * rstd * gl[j] + bl[j]; vT[(lane * 8 + j) * LDT + (((q >> 3) ^ (lane & 15)) << 3) + (q & 7)] = (bf16r)f2bf(v); } }
      } }
    __syncthreads();
    const int p = 16 * wave + (lane & 15); const size_t row = (size_t)(r0 + p);
#pragma unroll 1
    for (int h = 0; h < 4; ++h) {
        bf16x8 bfr[4];
#pragma unroll
        for (int ks = 0; ks < 4; ++ks) { u32x4 t; t.x = pk2(wreg[2 * ks].x, wreg[2 * ks].y); t.y = pk2(wreg[2 * ks].z, wreg[2 * ks].w); t.z = pk2(wreg[2 * ks + 1].x, wreg[2 * ks + 1].y); t.w = pk2(wreg[2 * ks + 1].z, wreg[2 * ks + 1].w);
            bfr[ks] = __builtin_bit_cast(bf16x8, t); }
        if (h < 3) gmlp_ldw(Ws + (size_t)(h + 1) * 128 * 128, wave, lane, wreg);
        const float bsv = bs[h * 128 + p];
        u32x2 uw[8];
#pragma unroll
        for (int dt = 0; dt < 8; ++dt) uw[dt] = *(const u32x2*)(P + row * INC + h * 128 + 16 * dt + 4 * (lane >> 4));
#pragma unroll
        for (int dt = 0; dt < 8; ++dt) {
            pg8::f32x4 acc = {0.f, 0.f, 0.f, 0.f};
#pragma unroll
            for (int ks = 0; ks < 4; ++ks) { const int c = h * 128 + 16 * dt + (lane & 15); const bf16x8 af = *(const LAS bf16x8*)(vT + c * LDT + (((ks * 4 + (lane >> 4)) ^ ((c >> 3) & 15)) << 3));
                acc = __builtin_amdgcn_mfma_f32_16x16x32_bf16(af, bfr[ks], acc, 0, 0, 0); }
            const float u0 = gelu_tanh(bflo(uw[dt].x)), u1 = gelu_tanh(bfhi(uw[dt].x)), u2 = gelu_tanh(bflo(uw[dt].y)), u3 = gelu_tanh(bfhi(uw[dt].y));
            u32x2 o; o.x = pk2(u0 * (acc[0] + bsv), u1 * (acc[1] + bsv)); o.y = pk2(u2 * (acc[2] + bsv), u3 * (acc[3] + bsv));
            *(u32x2*)(MIX + row * DM + h * 128 + 16 * dt + 4 * (lane >> 4)) = o;
        }
    }
    __syncthreads();
}

__device__ __forceinline__ void conv_item(LAS unsigned char* lds, const bf16r* __restrict__ P, bf16r* __restrict__ MIX, const float* __restrict__ wdw  , const float* __restrict__ bdw,
                                          const float* __restrict__ lng, const float* __restrict__ lnb, int item, int tid, int wave, int lane) {
    LAS float* z = (LAS float*)lds;
    const int row0 = item * 32;
    const int seq0 = row0 < NLAT ? (row0 & ~4095) : (NLAT + ((row0 - NLAT) & ~255)), seq1 = seq0 + (row0 < NLAT ? SEQ : CTX);
    float acc[32]; float w[31];
    { const float bv = bdw[tid];
#pragma unroll
      for (int t = 0; t < 32; ++t) acc[t] = bv;
#pragma unroll
      for (int j = 0; j < 31; ++j) w[j] = wdw[j * 512 + tid]; }
    { u32x4 ra[8], rb[8];
#pragma unroll
      for (int i = 0; i < 8; ++i) { const int rr = wave + 8 * i; int g = row0 - 15 + rr; const bool ok = rr < 62 && g >= seq0 && g < seq1; if (!ok) g = row0;
          ra[i] = *(const u32x4*)(P + (size_t)g * INC + 1024 + lane * 8); rb[i] = *(const u32x4*)(P + (size_t)g * INC + 1536 + lane * 8); }
#pragma unroll
      for (int i = 0; i < 8; ++i) { const int rr = wave + 8 * i; const int g = row0 - 15 + rr; const bool ok = g >= seq0 && g < seq1;
          if (rr < 62) { float a[8], b[8], zv[8]; unpack8(ra[i], a); unpack8(rb[i], b);
#pragma unroll
              for (int j = 0; j < 8; ++j) zv[j] = ok ? a[j] * sigmoidf_(b[j]) : 0.f;
              *(LAS f32x4*)(z + rr * 512 + lane * 8) = (f32x4){zv[0], zv[1], zv[2], zv[3]}; *(LAS f32x4*)(z + rr * 512 + lane * 8 + 4) = (f32x4){zv[4], zv[5], zv[6], zv[7]}; } } }
    __syncthreads();
#pragma unroll
    for (int rr = 0; rr < 62; ++rr) { const float zv = z[rr * 512 + tid];
#pragma unroll
        for (int t = 0; t < 32; ++t) { if (rr - t >= 0 && rr - t <= 30) acc[t] += w[rr - t] * zv; } }
    __syncthreads();
#pragma unroll
    for (int t = 0; t < 32; ++t) z[t * 512 + tid] = acc[t];
    __syncthreads();
    float gl[8], bl[8];
#pragma unroll
    for (int j = 0; j < 8; ++j) { gl[j] = lng[lane * 8 + j]; bl[j] = lnb[lane * 8 + j]; }
#pragma unroll
    for (int i = 0; i < 4; ++i) { const int t = wave * 4 + i;
        const f32x4 y0 = *(const LAS f32x4*)(z + t * 512 + lane * 8), y1 = *(const LAS f32x4*)(z + t * 512 + lane * 8 + 4);
        float x[8] = {y0.x, y0.y, y0.z, y0.w, y1.x, y1.y, y1.z, y1.w};
        float s = 0.f;
#pragma unroll
        for (int j = 0; j < 8; ++j) s += x[j];
        const float mean = wave_sum(s) * (1.f / 512.f); float qq = 0.f;
#pragma unroll
        for (int j = 0; j < 8; ++j) { const float d = x[j] - mean; qq += d * d; }
        const float rstd = __builtin_amdgcn_rsqf(wave_sum(qq) * (1.f / 512.f) + LN_EPS);
        float o[8];
#pragma unroll
        for (int j = 0; j < 8; ++j) { const float v = (x[j] - mean) * rstd * gl[j] + bl[j]; o[j] = v * sigmoidf_(v); }
        *(u32x4*)(MIX + (size_t)(row0 + t) * DM + 512 + lane * 8) = pack8(o);
    }
    __syncthreads();
}

#define XB_TMO      128
#define XB_XCNT(j)  (256  + 64 * (j))
#define XB_XSUB(j)  (1280 + 64 * (j))
#define XB_XGEN(j)  (2304 + 64 * (j))
#define XB_TOP      3328
#define XB_TOPGEN   3392
#define XCD_BAR_WORDS 3456
#define XB_SPIN_CAP (1u << 18)

__device__ __forceinline__ unsigned xb_ld(unsigned* p)              { return __hip_atomic_load(p, __ATOMIC_RELAXED, __HIP_MEMORY_SCOPE_AGENT); }
__device__ __forceinline__ unsigned xb_add(unsigned* p, unsigned v) { return __hip_atomic_fetch_add(p, v, __ATOMIC_RELAXED, __HIP_MEMORY_SCOPE_AGENT); }
__device__ __forceinline__ unsigned xb_xcc_id() { return (unsigned)__builtin_amdgcn_s_getreg((3 << 11) | 20) & 0xFu; }
#define XB_SPIN(cond, bar) do { unsigned _sp = 0; while (cond) { __builtin_amdgcn_s_sleep(1); \
    if ((++_sp & 255u) == 0u) { if (xb_ld(&(bar)[XB_TMO])) break; if (_sp > XB_SPIN_CAP) { atomicAdd(&(bar)[XB_TMO], 1u); break; } } } } while (0)

struct XcdBarrier {
    unsigned* bar; unsigned x;
    volatile LAS unsigned* st;
};

__device__ __forceinline__ XcdBarrier xcd_barrier_post(unsigned* bar, volatile LAS unsigned* st) {
    XcdBarrier b; b.bar = bar; b.x = xb_xcc_id(); b.st = st;
    if (threadIdx.x == 0) (void)xb_add(&bar[XB_XCNT(b.x)], 1u);
    return b;
}
__device__ __forceinline__ void xcd_barrier_complete(unsigned* bar, unsigned x, unsigned& nloc, unsigned& nx) {
    const unsigned G = gridDim.x * gridDim.y * gridDim.z;
    unsigned sum, cnt, mine, sp = 0u;
    for (;;) {
        sum = 0u; cnt = 0u; mine = 0u;
#pragma unroll
        for (unsigned j = 0; j < 16; ++j) { const unsigned c = xb_ld(&bar[XB_XCNT(j)]); sum += c; cnt += (c > 0u) ? 1u : 0u; mine = (j == x) ? c : mine; }
        if (sum == G) break;
        __builtin_amdgcn_s_sleep(1);
        if ((++sp & 255u) == 0u) { if (xb_ld(&bar[XB_TMO])) break; if (sp > XB_SPIN_CAP) { atomicAdd(&bar[XB_TMO], 1u); break; } }
    }
    nloc = mine > 0u ? mine : 1u; nx = cnt > 0u ? cnt : 1u;
}

__device__ __forceinline__ void xcd_barrier(const XcdBarrier& b) {
    asm volatile("s_waitcnt vmcnt(0)" ::: "memory");
    __syncthreads();
    if (threadIdx.x == 0) {
        unsigned* bar = b.bar;
        __builtin_amdgcn_s_waitcnt(0);
        unsigned nloc = b.st[0], nx = b.st[1];
        if (nloc == 0u) { xcd_barrier_complete(bar, b.x, nloc, nx); b.st[0] = nloc; b.st[1] = nx; }
        const unsigned old = xb_add(&bar[XB_XSUB(b.x)], 1u);
        const unsigned gen = old / nloc;
        if (old + 1u == (gen + 1u) * nloc) {
            __builtin_amdgcn_fence(__ATOMIC_RELEASE, "agent");
            asm volatile("s_waitcnt vmcnt(0)" ::: "memory");
            const unsigned og = xb_add(&bar[XB_TOP], 1u);
            const unsigned tg = og / nx;
            if (og + 1u == (tg + 1u) * nx) xb_add(&bar[XB_TOPGEN], 1u);
            else XB_SPIN(xb_ld(&bar[XB_TOPGEN]) == tg, bar);
            __builtin_amdgcn_fence(__ATOMIC_ACQUIRE, "agent");
            xb_add(&bar[XB_XGEN(b.x)], 1u);
            asm volatile("s_waitcnt vmcnt(0)" ::: "memory");
        } else {
            XB_SPIN(xb_ld(&bar[XB_XGEN(b.x)]) == gen, bar);
            __builtin_amdgcn_fence(__ATOMIC_ACQUIRE, "agent");
            asm volatile("s_waitcnt vmcnt(0)" ::: "memory");
        }
    }
    __syncthreads();
}

#ifndef REP_P0
#define REP_P0 0
#endif
#ifndef REP_RP
#define REP_RP 0
#endif
#ifndef REP_ATTN
#define REP_ATTN 0
#endif
#ifndef REP_PREP
#define REP_PREP 0
#endif
#ifndef REP_QKV
#define REP_QKV 0
#endif
#ifndef REP_GMLP
#define REP_GMLP 0
#endif
#ifndef REP_CONV
#define REP_CONV 0
#endif
#ifndef REP_G1
#define REP_G1 0
#endif
#ifndef REP_G3
#define REP_G3 0
#endif
#ifndef REP_G4
#define REP_G4 0
#endif
#ifndef REP_G2
#define REP_G2 0
#endif
#define REPEAT(n) for (int rep_ = 0; rep_ < 1 + (n); ++rep_)
struct Args { const float* in[24]; float* out; unsigned char* ws; int ph_lo, ph_hi; };
constexpr int N_PHASES = 2 + 8 * NLAYER;
struct Ctx {
    LAS unsigned char* lds; unsigned char* lds_raw; int tid, lane, wave, G, bx, vcu, gw, NGW, lo, hi;
    const float *x_in, *ctx_in, *a_ln_g, *a_ln_b, *a_ws, *a_bs, *b_dw, *b_dwb, *b_ln_g, *b_ln_b, *q_gain, *k_gain, *ln1_g, *ln1_b, *ln2_g, *ln2_b;
    float *rope, *MOD, *X, *out, *STAT, *PART; bf16r *Wt_in, *Wt_out, *Wt_ff1, *Wt_ff2, *H, *P, *Qb, *Kb, *Vb, *MIX, *ACT;
};
#define RUN (pid >= C.lo && pid < C.hi)
#define SEAM() do { if (pid >= C.lo && pid + 1 < C.hi) xcd_barrier(bar); ++pid; } while (0)

template <int l> __device__ __forceinline__ void layer_body(const Ctx& C, int& pid, const XcdBarrier& bar) {
    constexpr bool last = (l == NLAYER - 1);
    constexpr int Mrows = last ? NLAT : NROW;
    const float* modl = C.MOD + (size_t)l * 5 * NMODC;
    float* Xc = C.X + (size_t)NLAT * DM;
    if (RUN) {
#if !defined(DIS_GEMM) && !defined(DIS_G1)
        pg8::Gemm g{C.H, C.Wt_in + (size_t)l * INC * DM, Mrows, INC, DM, DM / 64}; pg8::OrderX S; S.init(Mrows, INC, C.G, C.bx, 64, last ? 4 : 0, 12, 2);
        pg8::EpiBf16<0> E{C.P, INC};
        REPEAT(REP_G1) pg8::gemm_phase<pg8::EpiBf16<0>, pg8::OrderX, true, true>(C.lds, g, S, E);
#endif
    }
    SEAM();
    if (RUN) {
        REPEAT(REP_PREP) {
#ifndef DIS_PREP
        REPEAT(REP_QKV) prep_qkv(C.P, C.Qb, C.Kb, C.Vb, C.q_gain + l * 128, C.k_gain + l * 128, C.rope, NROW, !last, C.gw, C.NGW, C.lane);
#endif
#ifndef DIS_GMLP
        constexpr int nch = Mrows / 128;
        REPEAT(REP_GMLP) for (int it = C.vcu; it < nch; it += C.G) gmlp_item(C.lds, C.P, C.MIX, C.a_ln_g + l * 512, C.a_ln_b + l * 512, C.a_ws + (size_t)l * 4 * 128 * 128, C.a_bs + l * 512, it, C.tid, C.wave, C.lane);
#endif
#ifndef DIS_CONV
        REPEAT(REP_CONV) for (int it = C.G - 1 - C.vcu; it < Mrows / 32; it += C.G) conv_item(C.lds, C.P, C.MIX, C.b_dw + (size_t)l * 31 * 512, C.b_dwb + l * 512, C.b_ln_g + l * 512, C.b_ln_b + l * 512, it, C.tid, C.wave, C.lane);
#endif
        }
    }
    SEAM();
    if (RUN) {
        constexpr int nunits = 512 + (last ? 0 : 32);
        REPEAT(REP_ATTN) for (int u = C.vcu; u < nunits; u += C.G) {
            int b, h, row0, seq;
            if (u < 512) { b = u >> 7; h = (u >> 4) & 7; row0 = b * SEQ + (u & 15) * 256; seq = KVLEN; }
            else { const int u2 = u - 512; b = u2 >> 3; h = u2 & 7; row0 = NLAT + b * CTX; seq = CTX; }
            const size_t kvoff = (size_t)(b * 2 + (h >> 2)) * KVLEN * 128;
#ifndef DIS_ATTN
            attn::attn_dense_body<attn::bf16>((const attn::bf16*)(C.Qb + (size_t)row0 * 1024 + h * 128), (const attn::bf16*)(C.Kb + kvoff), (const attn::bf16*)(C.Vb + kvoff),
                                              C.MIX + (size_t)row0 * DM + 1024 + h * 128, seq, (char*)C.lds_raw);
#endif
            __syncthreads();
        }
    }
    SEAM();
    if (RUN) {
#if !defined(DIS_GEMM) && !defined(DIS_G2)
        pg8::Gemm g{C.MIX, C.Wt_out + (size_t)l * DM * DM, NLAT, DM, DM, DM / 64}; pg8::OrderX S; S.init(NLAT, DM, C.G, C.bx, 0, 0, 0, 0);
        constexpr int lp = l > 0 ? l - 1 : 0;
        pg8::EpiResGate<(l > 0)> E{l == 0 ? C.x_in : C.X, l == 0 ? C.ctx_in : Xc, C.X, modl + 2 * DM, DN_ALPHA, C.STAT, C.ln2_g + lp * DM, C.ln2_b + lp * DM};
        pg8::gemm_phase<pg8::EpiResGate<(l > 0)>, pg8::OrderX, true, true>(C.lds, g, S, E);
        if (!last) {
            pg8::Gemm g2{C.MIX, C.Wt_out + (size_t)l * DM * DM, NROW, DM, DM, 4}; pg8::OrderSplit S2; S2.init(C.G, C.bx, 8, 4);
            pg8::EpiPart E2{C.PART, 4 * 128};
            pg8::gemm_phase<pg8::EpiPart, pg8::OrderSplit, true, true>(C.lds, g2, S2, E2);
        }
#endif
    }
    SEAM();
    if (RUN) REPEAT(REP_RP) {
        row_pass(C.X, Xc, NLAT, C.ln1_g + l * DM, C.ln1_b + l * DM, nullptr, nullptr, C.STAT, modl, 3 * DM, 4 * DM, C.H, C.gw, C.NGW, C.lane);
        if (!last) row_pass_ctx(C.ctx_in, nullptr, nullptr, nullptr, C.PART, modl + 4 * (size_t)NMODC + 2 * DM, Xc, C.ln1_g + l * DM, C.ln1_b + l * DM, C.STAT, modl, 3 * DM, 4 * DM, C.H, C.gw, C.NGW, C.lane);
    }
    SEAM();
    if (RUN) {
#if !defined(DIS_GEMM) && !defined(DIS_G3)
        pg8::Gemm g{C.H, C.Wt_ff1 + (size_t)l * DFF * DM, Mrows, DFF, DM, DM / 64}; pg8::OrderX S; S.init(Mrows, DFF, C.G, C.bx, 0, 0, 0, 0);
        pg8::EpiBf16<2> E{C.ACT, DFF};
        pg8::gemm_phase<pg8::EpiBf16<2>, pg8::OrderX, true, true>(C.lds, g, S, E);
#endif
    }
    SEAM();
    if (RUN) {
#if !defined(DIS_GEMM) && !defined(DIS_G4)
        pg8::Gemm g{C.ACT, C.Wt_ff2 + (size_t)l * DM * DFF, NLAT, DM, DFF, DFF / 64}; pg8::OrderX S; S.init(NLAT, DM, C.G, C.bx, 0, 0, 0, 0);
        pg8::EpiResGate<true> E{C.X, Xc, C.X, modl + 5 * DM, DN_ALPHA, C.STAT, C.ln1_g + l * DM, C.ln1_b + l * DM};
        pg8::gemm_phase<pg8::EpiResGate<true>, pg8::OrderX, true, true>(C.lds, g, S, E);
        if (!last) {
            pg8::Gemm g2{C.ACT, C.Wt_ff2 + (size_t)l * DM * DFF, NROW, DM, DFF, 16}; pg8::OrderSplit S2; S2.init(C.G, C.bx, 8, 16);
            pg8::EpiPart E2{C.PART, 16 * 128};
            pg8::gemm_phase<pg8::EpiPart, pg8::OrderSplit, true, true>(C.lds, g2, S2, E2);
        }
#endif
    }
    SEAM();
    if (RUN) {
        if (last) { REPEAT(REP_RP) row_pass(C.X, nullptr, NLAT, C.ln2_g + l * DM, C.ln2_b + l * DM, C.out, nullptr, nullptr, nullptr, 0, 0, nullptr, C.gw, C.NGW, C.lane); }
        else {
            REPEAT(REP_RP) row_pass(C.X, Xc, NLAT, C.ln2_g + l * DM, C.ln2_b + l * DM, nullptr, nullptr, C.STAT, modl + 5 * NMODC, 0 * DM, 1 * DM, C.H, C.gw, C.NGW, C.lane);
            row_pass_ctx(Xc, C.STAT, C.ln1_g + l * DM, C.ln1_b + l * DM, C.PART, modl + 4 * (size_t)NMODC + 5 * DM, nullptr, C.ln2_g + l * DM, C.ln2_b + l * DM, C.STAT, modl + 5 * NMODC, 0 * DM, 1 * DM, C.H, C.gw, C.NGW, C.lane);
        }
    }
    SEAM();
}

__global__ void __launch_bounds__(512, 2) fwd_megakernel(Args args) {
    extern __shared__ __attribute__((aligned(16))) unsigned char lds_raw[];
    cg::grid_group grid = cg::this_grid();
    Ctx C;
    C.lds = (LAS unsigned char*)lds_raw; C.lds_raw = lds_raw;
    C.tid = threadIdx.x; C.lane = C.tid & 63; C.wave = __builtin_amdgcn_readfirstlane(C.tid >> 6);
    C.G = gridDim.x; C.bx = blockIdx.x; C.vcu = (C.G % 8 == 0) ? (C.bx % 8) * (C.G / 8) + C.bx / 8 : C.bx;
    C.gw = C.vcu * 8 + C.wave; C.NGW = C.G * 8; C.lo = args.ph_lo; C.hi = args.ph_hi;
    unsigned char* ws = args.ws;
    C.x_in = args.in[0]; C.ctx_in = args.in[2];
    C.a_ln_g = args.in[7]; C.a_ln_b = args.in[8]; C.a_ws = args.in[9]; C.a_bs = args.in[10];
    C.b_dw = args.in[11]; C.b_dwb = args.in[12]; C.b_ln_g = args.in[13]; C.b_ln_b = args.in[14];
    C.q_gain = args.in[15]; C.k_gain = args.in[16]; C.ln1_g = args.in[18]; C.ln1_b = args.in[19]; C.ln2_g = args.in[22]; C.ln2_b = args.in[23];
    C.STAT = (float*)(ws + WS_STAT); C.PART = (float*)(ws + WS_PART); C.rope = (float*)(ws + WS_ROPE); C.MOD = (float*)(ws + WS_MOD); C.X = (float*)(ws + WS_X); C.out = args.out;
    C.Wt_in = (bf16r*)(ws + WS_WIN); C.Wt_out = (bf16r*)(ws + WS_WOUT); C.Wt_ff1 = (bf16r*)(ws + WS_WFF1); C.Wt_ff2 = (bf16r*)(ws + WS_WFF2);
    C.H = (bf16r*)(ws + WS_H); C.P = (bf16r*)(ws + WS_P); C.Qb = (bf16r*)(ws + WS_Q);
    C.Kb = (bf16r*)(ws + WS_K); C.Vb = (bf16r*)(ws + WS_V); C.MIX = (bf16r*)(ws + WS_MIX); C.ACT = (bf16r*)(ws + WS_ACT);
    int pid = 0;
    volatile LAS unsigned* bst = (volatile LAS unsigned*)(C.lds + LDS_BYTES - 64);
    if (C.tid < 2) bst[C.tid] = 0u;
    __syncthreads();
    const XcdBarrier bar = xcd_barrier_post((unsigned*)(ws + WS_BAR), bst);
    if (C.hi < 0) grid.sync();

    if (RUN) REPEAT(REP_P0) {
        const float* c_in = args.in[1]; const float* cctx_in = args.in[3]; const float* w_mod = args.in[4]; const float* b_mod = args.in[5];
        const float* w_in = args.in[6]; const float* w_out = args.in[17]; const float* w_ff1 = args.in[20]; const float* w_ff2 = args.in[21];
        p0_rope(C.rope, C.bx * 512 + C.tid, C.G * 512);
        p0_mod(C.lds, c_in, cctx_in, w_mod, b_mod, C.MOD, C.bx, C.G, C.tid);
        __syncthreads();
        LAS float* scr = (LAS float*)(C.lds + C.wave * 16640);
        constexpr int I_IN = (DM / 64) * (INC / 64), I_OUT = (DM / 64) * (DM / 64), I_F1 = (DM / 64) * (DFF / 64), I_F2 = (DFF / 64) * (DM / 64), I_L = I_IN + I_OUT + I_F1 + I_F2;
        for (int it = C.gw; it < NLAYER * I_L; it += C.NGW) {
            const int l = it / I_L; int r = it % I_L;
            if (r < I_IN) { p0_transpose_item(w_in + (size_t)l * DM * INC, DM, INC, C.Wt_in + (size_t)l * INC * DM, scr, r, C.lane); continue; } r -= I_IN;
            if (r < I_OUT) { p0_transpose_item(w_out + (size_t)l * DM * DM, DM, DM, C.Wt_out + (size_t)l * DM * DM, scr, r, C.lane); continue; } r -= I_OUT;
            if (r < I_F1) { p0_transpose_item(w_ff1 + (size_t)l * DM * DFF, DM, DFF, C.Wt_ff1 + (size_t)l * DFF * DM, scr, r, C.lane); continue; } r -= I_F1;
            p0_transpose_item(w_ff2 + (size_t)l * DFF * DM, DFF, DM, C.Wt_ff2 + (size_t)l * DM * DFF, scr, r, C.lane);
        }
        if (REP_P0) __syncthreads();
    }
    SEAM();
    if (RUN) REPEAT(REP_RP) row_pass(C.x_in, C.ctx_in, NROW, nullptr, nullptr, nullptr, nullptr, nullptr, C.MOD, 0 * DM, 1 * DM, C.H, C.gw, C.NGW, C.lane);
    SEAM();
    layer_body<0>(C, pid, bar);
    layer_body<1>(C, pid, bar);
#ifdef EXTRA_SYNCS
    if (C.hi - C.lo > 1) { for (int i = 0; i < EXTRA_SYNCS; ++i) xcd_barrier(bar); }
#endif
}
#undef RUN
#undef SEAM

#ifndef MK_PER_PHASE
#define MK_PER_PHASE 0
#endif
extern "C" void kernel_launch(void* const* d_in, const int* in_sizes, int n_in, void* d_out, int out_size, void* d_ws, size_t ws_size, hipStream_t stream) {
    static int grid = 0;
    if (grid == 0) {
        if (n_in != 24 || out_size != NLAT * DM || ws_size < WS_END) { fprintf(stderr, "kernel_launch: unexpected shapes (n_in %d out %d ws %zu, need ws >= %zu)\n", n_in, out_size, ws_size, (size_t)WS_END); grid = -1; return; }
        int dev = 0, cus = 0, per_cu = 0;
        (void)hipGetDevice(&dev); (void)hipDeviceGetAttribute(&cus, hipDeviceAttributeMultiprocessorCount, dev);
        if (hipFuncSetAttribute((const void*)fwd_megakernel, hipFuncAttributeMaxDynamicSharedMemorySize, LDS_BYTES) != hipSuccess) { fprintf(stderr, "kernel_launch: hipFuncSetAttribute failed\n"); grid = -1; return; }
        if (hipOccupancyMaxActiveBlocksPerMultiprocessor(&per_cu, (const void*)fwd_megakernel, 512, LDS_BYTES) != hipSuccess || per_cu < 1) { fprintf(stderr, "kernel_launch: occupancy query says %d\n", per_cu); per_cu = 1; }
        (void)hipGetLastError();
        grid = cus;
    }
    if (grid < 0) return;
#ifndef PROBE_TWICE
#define PROBE_TWICE 0
#endif
    for (int rep_launch = 0; rep_launch <= PROBE_TWICE; ++rep_launch) {
    if (hipMemsetAsync((char*)d_ws + WS_BAR, 0, WS_BAR_BYTES, stream) != hipSuccess) { fprintf(stderr, "kernel_launch: memset failed\n"); return; }
    Args a{};
    for (int i = 0; i < 24; ++i) a.in[i] = (const float*)d_in[i];
    a.out = (float*)d_out; a.ws = (unsigned char*)d_ws;
#if MK_PER_PHASE
    for (int p = 0; p < N_PHASES; ++p) { a.ph_lo = p; a.ph_hi = p + 1; hipLaunchKernelGGL(fwd_megakernel, dim3(grid), dim3(512), LDS_BYTES, stream, a); }
#else
    a.ph_lo = 0; a.ph_hi = N_PHASES;
    void* kargs[] = {&a};
    hipError_t e = hipLaunchCooperativeKernel((const void*)fwd_megakernel, dim3(grid), dim3(512), kargs, LDS_BYTES, stream);
    if (e != hipSuccess) fprintf(stderr, "kernel_launch: cooperative launch failed: %s (grid %d)\n", hipGetErrorString(e), grid);
#endif
    }
}
```

```cpp
#include <hip/hip_runtime.h>
#include <hip/hip_cooperative_groups.h>
#include <hip/hip_bf16.h>
#include <cstdio>
#include <cstdint>
namespace cg = cooperative_groups;
namespace pg8 {
#define PG8_LAS __attribute__((address_space(3)))
typedef unsigned short bf16_t;
typedef short bf16x8 __attribute__((ext_vector_type(8)));
typedef float f32x4 __attribute__((ext_vector_type(4)));
typedef unsigned u32x4 __attribute__((ext_vector_type(4)));
constexpr int BM = 256, BK = 64, HALF = 128, HTB = HALF * BK * 2  , STAGE_BYTES = 8 * HTB, NXCD = 8, WGM = 8;

__host__ __device__ __forceinline__ int lds_byte(int r, int c) { const int st = (r >> 4) * 2 + (c >> 5), rr = r & 15, cc = c & 31, ob = rr * 64 + cc * 2; return st * 1024 + (ob ^ (((ob >> 9) & 1) << 5)); }
__host__ __device__ __forceinline__ void stage_rc(int b, int& R, int& C) { const int st = b / 1024, sb = b % 1024, swz = sb ^ (((sb >> 9) & 1) << 5); R = (st >> 1) * 16 + swz / 64; C = (st & 1) * 32 + (swz % 64) / 2; }
__host__ __device__ __forceinline__ int perm32(int rho) { const int n = rho >> 4, i = rho & 15; return 8 * (i >> 2) + 4 * n + (i & 3); }

struct Unit { int pm, pn, ko; };
struct Gemm { const bf16_t* A; const bf16_t* Bt; int M, N, K, nt; };

struct StaticOrder {
    int nM, nN, nwg, G, c;
    __host__ __device__ void init(int M, int N, int G_, int c_) { nM = M / BM; nN = N / BM; nwg = nM * nN; G = G_; c = c_; }
    __host__ __device__ bool next(int i, Unit& u) const {
        const long L = (long)i * G + c; if (L >= nwg) return false;
        int wgid = (int)L; { const int q = nwg / NXCD, r = nwg % NXCD, xcd = wgid % NXCD, off = wgid / NXCD; wgid = (xcd < r ? xcd * (q + 1) : r * (q + 1) + (xcd - r) * q) + off; }
        const int nig = WGM * nN, gid = wgid / nig, fm = gid * WGM, gsz = (nM - fm) < WGM ? (nM - fm) : WGM;
        u.pm = fm + ((wgid % nig) % gsz); u.pn = (wgid % nig) / gsz; u.ko = 0; return true;
    }
    __device__ __forceinline__ void a_ready(const Unit&) const {}
    __device__ __forceinline__ void done(const Unit&) const {}
};

__device__ __forceinline__ unsigned cvt_pk_bf16(float lo, float hi) { unsigned r; asm volatile("v_cvt_pk_bf16_f32 %0, %1, %2" : "=v"(r) : "v"(lo), "v"(hi)); return r; }
typedef float f32x2 __attribute__((ext_vector_type(2)));
#ifndef WT_STORES
#define WT_STORES 0
#endif
__device__ __forceinline__ void st16_wt(void* p, u32x4 v) {
#if WT_STORES
    asm volatile("global_store_dwordx4 %0, %1, off sc1\n\ts_nop 1" :: "v"(p), "v"(v) : "memory");
#else
    *(u32x4*)p = v;
#endif
}
template <int ACT  > struct EpiBf16 {
    static constexpr bool PERM = true, AFTER_DRAIN = false;
    bf16_t* O; int ldc;
    __device__ __forceinline__ void operator()(const f32x4 (&acc)[2][2][4][2], const Unit& u, int wr, int wc, int fr, int fq) const {
        const int row0 = u.pm * BM + wr * 64 + fr; const int col0 = u.pn * BM + wc * 32 + 8 * fq;
#pragma unroll
        for (int ai = 0; ai < 2; ++ai)
#pragma unroll
            for (int m = 0; m < 4; ++m) { bf16_t* rowp = O + (size_t)(row0 + ai * HALF + m * 16) * ldc + col0;
#pragma unroll
                for (int bj = 0; bj < 2; ++bj) { f32x4 v0 = acc[ai][bj][m][0], v1 = acc[ai][bj][m][1];
                    if (ACT == 2) {
#pragma unroll
                        for (int e = 0; e < 4; ++e) { float a = fmaxf(v0[e], 0.f), b = fmaxf(v1[e], 0.f); v0[e] = a * a; v1[e] = b * b; } }
                    u32x4 w; w.x = cvt_pk_bf16(v0[0], v0[1]); w.y = cvt_pk_bf16(v0[2], v0[3]); w.z = cvt_pk_bf16(v1[0], v1[1]); w.w = cvt_pk_bf16(v1[2], v1[3]);
                    st16_wt(rowp + bj * HALF, w); } }
    }
};
template <bool NORM> struct EpiResGate {
    static constexpr bool PERM = false, AFTER_DRAIN = false;
    const float* res_lat; const float* res_ctx; float* out; const float* gate; float alpha; const float* stat; const float* lg; const float* lb;
    __device__ __forceinline__ void operator()(const f32x4 (&acc)[2][2][4][2], const Unit& u, int wr, int wc, int fr, int fq) const {
        typedef float f32x2v __attribute__((ext_vector_type(2)));
        const int mrow = u.pm < 64 ? (u.pm >> 4) : 4;
        const float* g = gate + (size_t)mrow * 12288;
        const int col0 = u.pn * BM + wc * 32 + 4 * fq;
        f32x4 gv[2][2], gg[2][2], bb[2][2];
#pragma unroll
        for (int bj = 0; bj < 2; ++bj)
#pragma unroll
            for (int n = 0; n < 2; ++n) { gv[bj][n] = *(const f32x4*)(g + col0 + bj * HALF + n * 16);
                if (NORM) { gg[bj][n] = *(const f32x4*)(lg + col0 + bj * HALF + n * 16); bb[bj][n] = *(const f32x4*)(lb + col0 + bj * HALF + n * 16); } }
#pragma unroll
        for (int ai = 0; ai < 2; ++ai)
#pragma unroll
            for (int m = 0; m < 4; ++m) { const int row = u.pm * BM + ai * HALF + wr * 64 + m * 16 + fr;
                const float* rp = (row < 16384) ? res_lat + (size_t)row * 2048 : res_ctx + (size_t)(row - 16384) * 2048;
                float* op = out + (size_t)row * 2048;
                f32x2v st = {0.f, 1.f}; if (NORM) st = *(const f32x2v*)(stat + 2 * (size_t)row);
#pragma unroll
                for (int bj = 0; bj < 2; ++bj)
#pragma unroll
                    for (int n = 0; n < 2; ++n) { const int c = col0 + bj * HALF + n * 16; f32x4 r = *(const f32x4*)(rp + c);
                        if (NORM) r = (r - st.x) * st.y * gg[bj][n] + bb[bj][n];
                        const f32x4 o = r * alpha + gv[bj][n] * acc[ai][bj][m][n]; st16_wt(op + c, __builtin_bit_cast(u32x4, o)); } }
    }
};
struct OrderX {
    StaticOrder base; int xm0, xnm, xn0, xnn;
    __device__ void init(int M, int N, int G_, int c_, int xm0_, int xnm_, int xn0_, int xnn_) { base.init(M, N, G_, c_); xm0 = xm0_; xnm = xnm_; xn0 = xn0_; xnn = xnn_; }
    __device__ bool next(int i, Unit& u) const {
        long L = (long)i * base.G + base.c; if (L < base.nwg) return base.next(i, u);
        L -= base.nwg; if (L >= (long)xnm * xnn) return false;
        u.pm = xm0 + (int)(L % xnm); u.pn = xn0 + (int)(L / xnm); u.ko = 0; return true;
    }
    __device__ __forceinline__ void a_ready(const Unit&) const {}
    __device__ __forceinline__ void done(const Unit&) const {}
};
struct OrderSplit {
    int G, c, nsub, kbytes;
    __device__ void init(int G_, int c_, int ns, int nt) { G = G_; c = c_; nsub = 32 * ns; kbytes = nt * 128; }
    __device__ bool next(int i, Unit& u) const { const long L = (long)i * G + c; if (L >= nsub) return false; const int idx = (int)L; u.pm = 64 + (idx & 3); u.pn = (idx >> 2) & 7; u.ko = (idx >> 5) * kbytes; return true; }
    __device__ __forceinline__ void a_ready(const Unit&) const {}
    __device__ __forceinline__ void done(const Unit&) const {}
};
struct EpiPart {
    static constexpr bool PERM = false, AFTER_DRAIN = false;
    float* part; int kbytes;
    __device__ __forceinline__ void operator()(const f32x4 (&acc)[2][2][4][2], const Unit& u, int wr, int wc, int fr, int fq) const {
        const int ks = u.ko / kbytes; const int col0 = u.pn * BM + wc * 32 + 4 * fq;
        float* base = part + ((size_t)ks * 1024 + (size_t)(u.pm - 64) * BM) * 2048;
#pragma unroll
        for (int ai = 0; ai < 2; ++ai)
#pragma unroll
            for (int m = 0; m < 4; ++m) { float* op = base + (size_t)(ai * HALF + wr * 64 + m * 16 + fr) * 2048;
#pragma unroll
                for (int bj = 0; bj < 2; ++bj)
#pragma unroll
                    for (int n = 0; n < 2; ++n) st16_wt(op + col0 + bj * HALF + n * 16, __builtin_bit_cast(u32x4, acc[ai][bj][m][n])); }
    }
};
template <class Epi, class Sched, bool ALIGN_EPI = false, bool SP2 = false>
__device__ __forceinline__ void gemm_phase(PG8_LAS unsigned char* lds, const Gemm g, const Sched& S, const Epi& E) {
    const int tid = threadIdx.x, wid = __builtin_amdgcn_readfirstlane(tid >> 6), lane = tid & 63, wr = wid >> 2, wc = wid & 3, fr = lane & 15, fq = lane >> 4;
    const int K = g.K, nt = g.nt;
    unsigned voffA[2], voffB[2];
#pragma unroll
    for (int i = 0; i < 2; ++i) { int R, C; stage_rc(tid * 16 + i * 8192, R, C); const int Rb = Epi::PERM ? ((R & ~31) + perm32(R & 31)) : R;
        voffA[i] = (unsigned)(R * K + C) * 2u; voffB[i] = (unsigned)(Rb * K + C) * 2u; }
    const size_t kstep = (size_t)(BK * 2);
    const size_t hstep = (size_t)HALF * K * 2;
    const size_t tstep = 2 * hstep;
    const unsigned ldsw = (unsigned)wid * 1024u;
    const int aoff = lds_byte(wr * 64 + fr, fq * 8), boff = lds_byte(wc * 32 + fr, fq * 8);
#define PG8_SA(b, h) (((b) * 2 + (h)) * HTB)
#define PG8_SB(b, h) ((4 + (b) * 2 + (h)) * HTB)
#define PG8_STAGE(bufoff, gbase, voff) do { _Pragma("unroll") for (int _i = 0; _i < 2; ++_i) \
        __builtin_amdgcn_global_load_lds((const unsigned*)((const char*)(gbase) + (voff)[_i]), (PG8_LAS unsigned*)(lds + (bufoff) + ldsw + _i * 8192), 16, 0, 0); } while (0)
#define PG8_LDA(dst, b, h) do { _Pragma("unroll") for (int m = 0; m < 4; ++m) _Pragma("unroll") for (int k = 0; k < 2; ++k) dst[m][k] = *(const PG8_LAS bf16x8*)(lds + PG8_SA(b, h) + aoff + m * 2048 + k * 1024); } while (0)
#define PG8_LDB(dst, b, h) do { _Pragma("unroll") for (int n = 0; n < 2; ++n) _Pragma("unroll") for (int k = 0; k < 2; ++k) dst[n][k] = *(const PG8_LAS bf16x8*)(lds + PG8_SB(b, h) + boff + n * 2048 + k * 1024); } while (0)
#define PG8_MMA(ai, bj, At, Bt) do { __builtin_amdgcn_s_setprio(1); _Pragma("unroll") for (int m = 0; m < 4; ++m) _Pragma("unroll") for (int n = 0; n < 2; ++n) _Pragma("unroll") for (int k = 0; k < 2; ++k) \
        acc[ai][bj][m][n] = __builtin_amdgcn_mfma_f32_16x16x32_bf16(Bt[n][k], At[m][k], acc[ai][bj][m][n], 0, 0, 0); __builtin_amdgcn_s_setprio(0); } while (0)
#define PG8_WAIT_V(n) asm volatile("s_waitcnt vmcnt(" #n ")" ::: "memory")
#define PG8_WAIT_L(n) asm volatile("s_waitcnt lgkmcnt(" #n ")" ::: "memory")
#define PG8_BAR __builtin_amdgcn_s_barrier()
#define PG8_SCHED __builtin_amdgcn_sched_barrier(0)
    Unit cur, nxt; int ui = 0;
    if (!S.next(0, cur)) return;
    f32x4 acc[2][2][4][2];
#pragma unroll
    for (int a = 0; a < 2; ++a)
#pragma unroll
        for (int b = 0; b < 2; ++b)
#pragma unroll
            for (int m = 0; m < 4; ++m)
#pragma unroll
                for (int n = 0; n < 2; ++n) acc[a][b][m][n] = (f32x4){0.f, 0.f, 0.f, 0.f};
    bf16x8 At[4][2], B0[2][2], B1[2][2];
    const char* cA = (const char*)g.A + (size_t)cur.pm * tstep + cur.ko; const char* cB = (const char*)g.Bt + (size_t)cur.pn * tstep + cur.ko;
    S.a_ready(cur);
    if constexpr (SP2) {
        PG8_STAGE(PG8_SB(0, 0), cB, voffB); PG8_STAGE(PG8_SB(0, 1), cB + hstep, voffB); PG8_STAGE(PG8_SA(0, 0), cA, voffA); PG8_STAGE(PG8_SA(0, 1), cA + hstep, voffA);
        if (wr == 1) PG8_BAR;
        PG8_WAIT_V(2); PG8_BAR;
        PG8_STAGE(PG8_SB(1, 0), cB + kstep, voffB); PG8_STAGE(PG8_SA(1, 0), cA + kstep, voffA); PG8_STAGE(PG8_SB(1, 1), cB + hstep + kstep, voffB);
        PG8_WAIT_V(6); PG8_BAR;
    } else {
        PG8_STAGE(PG8_SB(0, 0), cB, voffB); PG8_STAGE(PG8_SA(0, 0), cA, voffA); PG8_STAGE(PG8_SB(0, 1), cB + hstep, voffB); PG8_STAGE(PG8_SA(0, 1), cA + hstep, voffA);
        if (wr == 1) PG8_BAR;
        PG8_WAIT_V(4); PG8_BAR;
        PG8_STAGE(PG8_SB(1, 0), cB + kstep, voffB); PG8_STAGE(PG8_SA(1, 0), cA + kstep, voffA); PG8_STAGE(PG8_SB(1, 1), cB + hstep + kstep, voffB);
        PG8_WAIT_V(6); PG8_BAR;
    }
    for (;;) {
        const bool has_next = S.next(ui + 1, nxt);
        const char* nA = has_next ? (const char*)g.A + (size_t)nxt.pm * tstep + nxt.ko : cA; const char* nB = has_next ? (const char*)g.Bt + (size_t)nxt.pn * tstep + nxt.ko : cB;
        for (int t = 0; t < nt; t += 2) {
            const bool last = (t == nt - 2);
            const char* a1 = cA + (size_t)(t + 1) * kstep;
            const char* a2 = last ? nA : cA + (size_t)(t + 2) * kstep; const char* b2 = last ? nB : cB + (size_t)(t + 2) * kstep;
            const char* a3 = a2 + kstep; const char* b3 = b2 + kstep;
            if (last && has_next) S.a_ready(nxt);
            if constexpr (SP2) {
            PG8_LDB(B0, 0, 0); PG8_LDB(B1, 0, 1); PG8_SCHED; PG8_LDA(At, 0, 0); PG8_STAGE(PG8_SA(1, 1), a1 + hstep, voffA);
            PG8_WAIT_V(8); PG8_WAIT_L(0); PG8_BAR; PG8_MMA(0, 0, At, B0); PG8_MMA(0, 1, At, B1); PG8_BAR; PG8_SCHED;
            PG8_LDA(At, 0, 1); PG8_STAGE(PG8_SB(0, 0), b2, voffB); PG8_STAGE(PG8_SB(0, 1), b2 + hstep, voffB); PG8_STAGE(PG8_SA(0, 0), a2, voffA);
            PG8_WAIT_V(8); PG8_WAIT_L(0); PG8_BAR; PG8_MMA(1, 0, At, B0); PG8_MMA(1, 1, At, B1); PG8_BAR; PG8_SCHED;
            PG8_LDB(B0, 1, 0); PG8_LDB(B1, 1, 1); PG8_SCHED; PG8_LDA(At, 1, 0); PG8_STAGE(PG8_SA(0, 1), a2 + hstep, voffA);
            PG8_WAIT_V(8); PG8_WAIT_L(0); PG8_BAR; PG8_MMA(0, 0, At, B0); PG8_MMA(0, 1, At, B1); PG8_BAR; PG8_SCHED;
            PG8_LDA(At, 1, 1); PG8_STAGE(PG8_SB(1, 0), b3, voffB); PG8_STAGE(PG8_SB(1, 1), b3 + hstep, voffB); PG8_STAGE(PG8_SA(1, 0), a3, voffA);
            PG8_WAIT_V(8); PG8_WAIT_L(0); PG8_BAR; PG8_MMA(1, 0, At, B0); PG8_MMA(1, 1, At, B1); PG8_BAR; PG8_SCHED;
            } else {
            PG8_LDB(B0, 0, 0); PG8_SCHED; PG8_LDA(At, 0, 0); PG8_STAGE(PG8_SA(1, 1), a1 + hstep, voffA);
            PG8_WAIT_L(8); PG8_BAR; PG8_WAIT_L(0); PG8_MMA(0, 0, At, B0); PG8_BAR; PG8_SCHED;
            PG8_LDB(B1, 0, 1); PG8_STAGE(PG8_SB(0, 0), b2, voffB);
            PG8_BAR; PG8_WAIT_L(0); PG8_MMA(0, 1, At, B1); PG8_BAR;
            PG8_LDA(At, 0, 1); PG8_STAGE(PG8_SA(0, 0), a2, voffA);
            PG8_BAR; PG8_WAIT_L(0); PG8_MMA(1, 0, At, B0); PG8_BAR; PG8_SCHED;
            PG8_STAGE(PG8_SB(0, 1), b2 + hstep, voffB);
            PG8_WAIT_V(6); PG8_BAR; PG8_MMA(1, 1, At, B1); PG8_BAR;
            PG8_LDB(B0, 1, 0); PG8_SCHED; PG8_LDA(At, 1, 0); PG8_STAGE(PG8_SA(0, 1), a2 + hstep, voffA);
            PG8_WAIT_L(8); PG8_BAR; PG8_WAIT_L(0); PG8_MMA(0, 0, At, B0); PG8_BAR; PG8_SCHED;
            PG8_LDB(B1, 1, 1); PG8_STAGE(PG8_SB(1, 0), b3, voffB);
            PG8_BAR; PG8_WAIT_L(0); PG8_MMA(0, 1, At, B1); PG8_BAR;
            PG8_LDA(At, 1, 1); PG8_STAGE(PG8_SA(1, 0), a3, voffA);
            PG8_BAR; PG8_WAIT_L(0); PG8_MMA(1, 0, At, B0); PG8_BAR; PG8_SCHED;
            PG8_STAGE(PG8_SB(1, 1), b3 + hstep, voffB);
            PG8_WAIT_V(6); PG8_BAR; PG8_MMA(1, 1, At, B1); PG8_BAR;
            }
        }
        if constexpr (ALIGN_EPI) { if (wr == 0) PG8_BAR; }
        if constexpr (!Epi::AFTER_DRAIN) { E(acc, cur, wr, wc, fr, fq); S.done(cur); }
        if (!has_next) break;
#pragma unroll
        for (int a = 0; a < 2; ++a)
#pragma unroll
            for (int b = 0; b < 2; ++b)
#pragma unroll
                for (int m = 0; m < 4; ++m)
#pragma unroll
                    for (int n = 0; n < 2; ++n) acc[a][b][m][n] = (f32x4){0.f, 0.f, 0.f, 0.f};
        cur = nxt; cA = nA; cB = nB; ++ui;
        if constexpr (ALIGN_EPI) { if (wr == 1) PG8_BAR; }
    }
    PG8_WAIT_V(0);
    if constexpr (!ALIGN_EPI) { if (wr == 0) PG8_BAR; }
    PG8_BAR;
    if constexpr (Epi::AFTER_DRAIN) { E.fused(acc, cur, wr, wc, fr, fq, lds, wid, lane); S.done(cur); }
#undef PG8_SA
#undef PG8_SB
#undef PG8_STAGE
#undef PG8_LDA
#undef PG8_LDB
#undef PG8_MMA
#undef PG8_WAIT_V
#undef PG8_WAIT_L
#undef PG8_BAR
#undef PG8_SCHED
}
}
namespace attn {
using bf16 = __hip_bfloat16;
constexpr int   D = 128, NW = 8, QBLK = 32, KVBLK = 64;
constexpr float SCALE = 0.088388347648318440f;
#ifndef ATTN_THR
#define ATTN_THR 8.f
#endif
constexpr float THR = ATTN_THR;
constexpr int SDEPTH = 2;
constexpr int LDQ = 1024, LDK = 128, LDO = 2048;
constexpr size_t SHM_V = KVBLK * D * 2, SHM_K = KVBLK * D * 2, SHM_ATTN = 2 * SHM_V + 2 * SHM_K + NW * 64 * 4;
__device__ __forceinline__ unsigned short f2bf16(float f) { unsigned u = __builtin_bit_cast(unsigned, f); return (unsigned short)((u + 0x7fffu + ((u >> 16) & 1u)) >> 16); }
using bf16x8 = __attribute__((ext_vector_type(8))) short;
using s16x4  = __attribute__((ext_vector_type(4))) short;
using f32x16 = __attribute__((ext_vector_type(16))) float;
using f32x8  = __attribute__((ext_vector_type(8))) float;
using u32x4  = __attribute__((ext_vector_type(4))) unsigned;
#define KSWZ(row, colB) ((row) * 256 + ((colB) ^ (((row) & 7) << 4)))
#define SBAR() __builtin_amdgcn_sched_barrier(0)
__device__ __forceinline__ int crow(int r, int hi) { return (r & 3) + 8 * (r >> 2) + 4 * hi; }
__device__ __forceinline__ unsigned cvtpk(float lo, float hi) {
  unsigned r; asm volatile("v_cvt_pk_bf16_f32 %0, %1, %2" : "=v"(r) : "v"(lo), "v"(hi)); return r;
}
template <typename TIn> struct Stage;
template <> struct Stage<bf16>  { using T = bf16x8;
  __device__ static __forceinline__ T ld8(const bf16* p) { return *reinterpret_cast<const bf16x8*>(p); }
  __device__ static __forceinline__ bf16x8 tobf(T x) { return x; } };
template <> struct Stage<float> { using T = f32x8;
  __device__ static __forceinline__ T ld8(const float* p) { return *reinterpret_cast<const f32x8*>(p); }
  __device__ static __forceinline__ bf16x8 tobf(T x) {
    u32x4 w = {cvtpk(x[0], x[1]), cvtpk(x[2], x[3]), cvtpk(x[4], x[5]), cvtpk(x[6], x[7])}; return *reinterpret_cast<bf16x8*>(&w); } };

__device__ __forceinline__ void partialSM(f32x16& p0, f32x16& p1, float& m_reg, float& mn, float& alpha) {
  constexpr float C = SCALE * 1.4426950408889634f;
  float pmax = p0[0]; for (int r = 1; r < 16; ++r) pmax = fmaxf(pmax, p0[r]); for (int r = 0; r < 16; ++r) pmax = fmaxf(pmax, p1[r]);
  { auto rr = __builtin_amdgcn_permlane32_swap(__float_as_uint(pmax), __float_as_uint(pmax), false, false);
    pmax = fmaxf(__uint_as_float(rr[0]), __uint_as_float(rr[1])); }
  if (__builtin_expect(__all(pmax - m_reg <= THR / SCALE), 1)) { mn = m_reg; alpha = 1.f; }
  else { mn = fmaxf(m_reg, pmax); alpha = __builtin_amdgcn_exp2f((m_reg - mn) * C); m_reg = mn; }
  float mnC = -mn * C;
  for (int r = 0; r < 16; ++r) p0[r] = fmaf(p0[r], C, mnC); for (int r = 0; r < 16; ++r) p1[r] = fmaf(p1[r], C, mnC);
  for (int r = 0; r < 16; ++r) p0[r] = __builtin_amdgcn_exp2f(p0[r]);
}
__device__ __forceinline__ void finishSM(f32x16& p0, f32x16& p1, float alpha, float& l_reg, bf16x8& pa0, bf16x8& pa1, bf16x8& pa2, bf16x8& pa3) {
  for (int r = 0; r < 16; ++r) p1[r] = __builtin_amdgcn_exp2f(p1[r]);
  float ps = 0; for (int r = 0; r < 16; ++r) ps += p0[r]; for (int r = 0; r < 16; ++r) ps += p1[r];
  { auto rr = __builtin_amdgcn_permlane32_swap(__float_as_uint(ps), __float_as_uint(ps), false, false);
    ps = __uint_as_float(rr[0]) + __uint_as_float(rr[1]); }
  l_reg = l_reg * alpha + ps;
#define PK4(P, BASE, OUT) do { unsigned a0 = cvtpk(P[BASE + 0], P[BASE + 1]), a1 = cvtpk(P[BASE + 2], P[BASE + 3]);   \
    unsigned b0 = cvtpk(P[BASE + 4], P[BASE + 5]), b1 = cvtpk(P[BASE + 6], P[BASE + 7]);                              \
    auto r0 = __builtin_amdgcn_permlane32_swap(a0, b0, false, false); auto r1 = __builtin_amdgcn_permlane32_swap(a1, b1, false, false); \
    u32x4 w = {r0[0], r1[0], r0[1], r1[1]}; OUT = *reinterpret_cast<bf16x8*>(&w); } while (0)
  PK4(p0, 0, pa0); PK4(p0, 8, pa1); PK4(p1, 0, pa2); PK4(p1, 8, pa3);
#undef PK4
}
__device__ __forceinline__ void qkt(f32x16& p0, f32x16& p1, const bf16* Ks, const bf16x8* qr, int r32, int hi) {
  p0 = f32x16{}; p1 = f32x16{};
  for (int d0 = 0; d0 < 8; ++d0) { int cb = (d0 * 16 + hi * 8) * 2;
    bf16x8 b0 = *reinterpret_cast<const bf16x8*>((const char*)Ks + KSWZ(r32, cb));
    bf16x8 b1 = *reinterpret_cast<const bf16x8*>((const char*)Ks + KSWZ(32 + r32, cb));
    p0 = __builtin_amdgcn_mfma_f32_32x32x16_bf16(b0, qr[d0], p0, 0, 0, 0);
    p1 = __builtin_amdgcn_mfma_f32_32x32x16_bf16(b1, qr[d0], p1, 0, 0, 0); }
}
__device__ __forceinline__ int v_st(int k, int c) { const int kk = (k & ~0xC) | ((k & 4) << 1) | ((k & 8) >> 1); return ((kk >> 3) * 4 + (c >> 5)) * 512 + ((kk & 7) * 32 + (c & 31)) * 2; }
__device__ __forceinline__ int v_rd_base(int lane) { return ((lane & 3) << 3) | (((lane >> 2) & 3) << 6) | (((lane >> 4) & 1) << 5) | (((lane >> 5) & 1) << 8); }
constexpr int v_rd_off(int d0, int ks, int half) { return d0 * 512 + ks * 4096 + half * 2048; }
template <int OFF> __device__ __forceinline__ s16x4 tr_read(int vb) {
  s16x4 r; asm volatile("ds_read_b64_tr_b16 %0, %1 offset:%2" : "=&v"(r) : "v"(vb), "i"(OFF) : "memory"); return r;
}
template <int D0> __device__ __forceinline__ void pv_one(f32x16& od, int vb, bf16x8 pa0, bf16x8 pa1, bf16x8 pa2, bf16x8 pa3) {
  const s16x4 l0 = tr_read<v_rd_off(D0, 0, 0)>(vb), h0 = tr_read<v_rd_off(D0, 0, 1)>(vb), l1 = tr_read<v_rd_off(D0, 1, 0)>(vb), h1 = tr_read<v_rd_off(D0, 1, 1)>(vb);
  const s16x4 l2 = tr_read<v_rd_off(D0, 2, 0)>(vb), h2 = tr_read<v_rd_off(D0, 2, 1)>(vb), l3 = tr_read<v_rd_off(D0, 3, 0)>(vb), h3 = tr_read<v_rd_off(D0, 3, 1)>(vb);
  asm volatile("s_waitcnt lgkmcnt(0)" ::: "memory"); SBAR();
#define PK(L, H) (bf16x8){L[0], L[1], L[2], L[3], H[0], H[1], H[2], H[3]}
  od = __builtin_amdgcn_mfma_f32_32x32x16_bf16(pa0, PK(l0, h0), od, 0, 0, 0);
  od = __builtin_amdgcn_mfma_f32_32x32x16_bf16(pa1, PK(l1, h1), od, 0, 0, 0);
  od = __builtin_amdgcn_mfma_f32_32x32x16_bf16(pa2, PK(l2, h2), od, 0, 0, 0);
  od = __builtin_amdgcn_mfma_f32_32x32x16_bf16(pa3, PK(l3, h3), od, 0, 0, 0);
#undef PK
}
__device__ __forceinline__ void pv_d0(f32x16* o, int vb, bf16x8 pa0, bf16x8 pa1, bf16x8 pa2, bf16x8 pa3) {
  pv_one<0>(o[0], vb, pa0, pa1, pa2, pa3); pv_one<1>(o[1], vb, pa0, pa1, pa2, pa3); pv_one<2>(o[2], vb, pa0, pa1, pa2, pa3); pv_one<3>(o[3], vb, pa0, pa1, pa2, pa3);
}
template <typename TQ>
__device__ __forceinline__ void attn_dense_body(const TQ* __restrict__ Qb, const bf16* __restrict__ Kh, const bf16* __restrict__ Vh,
                                                unsigned short* __restrict__ Ob, int seq, char* lds) {
  using St = Stage<bf16>; using SQ = Stage<TQ>;
  const int tid = threadIdx.x, wid = tid >> 6, lane = tid & 63, r32 = lane & 31, hi = lane >> 5;
  bf16* V_lds = (bf16*)lds; bf16* K_lds = (bf16*)(lds + 2 * SHM_V);
  float* ws = (float*)(lds + 2 * SHM_V + 2 * SHM_K) + wid * 64; float* li_l = ws; float* al_l = ws + 32;
  float m_reg = -1e30f, l_reg = 0; f32x16 o[4] = {}; bf16x8 qr[8];
  const TQ* Qw = Qb + (long)(wid * QBLK + r32) * LDQ + hi * 8;
#pragma unroll
  for (int d0 = 0; d0 < 8; ++d0) qr[d0] = SQ::tobf(SQ::ld8(Qw + d0 * 16));
  const int sr = tid >> 4, sc = (tid & 15) * 8, vst0 = v_st(sr, sc), vst1 = v_st(32 + sr, sc);
  const int vb0 = (int)(uintptr_t)V_lds + v_rd_base(lane);
  struct { typename St::T vs0, vs1, ks0, ks1; } sr_[SDEPTH];
#define SLOAD(i, k0) do { sr_[i].vs0 = St::ld8(&Vh[(long)((k0) + sr) * LDK + sc]); sr_[i].vs1 = St::ld8(&Vh[(long)((k0) + 32 + sr) * LDK + sc]); \
    sr_[i].ks0 = St::ld8(&Kh[(long)((k0) + sr) * LDK + sc]); sr_[i].ks1 = St::ld8(&Kh[(long)((k0) + 32 + sr) * LDK + sc]); } while (0)
#define SWRITE(b, i) do { *(bf16x8*)((char*)V_lds + (b) * SHM_V + vst0) = St::tobf(sr_[i].vs0);          \
    *(bf16x8*)((char*)V_lds + (b) * SHM_V + vst1) = St::tobf(sr_[i].vs1); int kc = sc * 2;               \
    *(bf16x8*)((char*)K_lds + (b) * SHM_K + KSWZ(sr, kc)) = St::tobf(sr_[i].ks0);                       \
    *(bf16x8*)((char*)K_lds + (b) * SHM_K + KSWZ(32 + sr, kc)) = St::tobf(sr_[i].ks1); } while (0)
#define SWAIT() do { if constexpr (SDEPTH == 2) asm volatile("s_waitcnt vmcnt(4)" ::: "memory"); else asm volatile("s_waitcnt vmcnt(0)" ::: "memory"); } while (0)
#define RESC(a) do { if (__any((a) < 1.f)) { if (hi == 0) al_l[r32] = (a); asm volatile("s_waitcnt lgkmcnt(0)" ::: "memory"); \
    for (int d = 0; d < 4; ++d) for (int r = 0; r < 16; ++r) o[d][r] *= al_l[crow(r, hi)]; } } while (0)
  f32x16 pA0, pA1, pB0, pB1; float mnA, mnB, alA, alB; bf16x8 pa0, pa1, pa2, pa3; const int NT = seq / KVBLK;
  constexpr int SE = 0, SO = SDEPTH - 1;
  SLOAD(SE, 0); asm volatile("s_waitcnt vmcnt(0)" ::: "memory"); SWRITE(0, SE); __syncthreads();
  qkt(pA0, pA1, K_lds, qr, r32, hi); partialSM(pA0, pA1, m_reg, mnA, alA);
  SLOAD(SO, KVBLK); if constexpr (SDEPTH == 2) { if (2 < NT) SLOAD(SE, 2 * KVBLK); }
  SWAIT(); SWRITE(1, SO); __syncthreads();
  for (int j = 1; j + 1 < NT; j += 2) {
    SBAR(); qkt(pB0, pB1, (bf16*)((char*)K_lds + SHM_K), qr, r32, hi);
    finishSM(pA0, pA1, alA, l_reg, pa0, pa1, pa2, pa3); SBAR();
    SLOAD(SO, (j + SDEPTH) * KVBLK); SBAR();
    pv_d0(o, vb0, pa0, pa1, pa2, pa3); partialSM(pB0, pB1, m_reg, mnB, alB);
    __syncthreads(); SWAIT(); SWRITE(0, SE);
    RESC(alB); __syncthreads();
    SBAR(); qkt(pA0, pA1, K_lds, qr, r32, hi);
    finishSM(pB0, pB1, alB, l_reg, pa0, pa1, pa2, pa3); SBAR();
    if (SDEPTH == 1 || j + 3 < NT) SLOAD(SE, (j + 1 + SDEPTH) * KVBLK); SBAR();
    pv_d0(o, vb0 + (int)SHM_V, pa0, pa1, pa2, pa3); partialSM(pA0, pA1, m_reg, mnA, alA);
    __syncthreads(); SWAIT(); SWRITE(1, SO);
    RESC(alA); __syncthreads();
  }
  SBAR(); qkt(pB0, pB1, (bf16*)((char*)K_lds + SHM_K), qr, r32, hi);
  finishSM(pA0, pA1, alA, l_reg, pa0, pa1, pa2, pa3); SBAR();
  pv_d0(o, vb0, pa0, pa1, pa2, pa3); partialSM(pB0, pB1, m_reg, mnB, alB);
  __syncthreads(); RESC(alB);
  finishSM(pB0, pB1, alB, l_reg, pa0, pa1, pa2, pa3); SBAR();
  pv_d0(o, vb0 + (int)SHM_V, pa0, pa1, pa2, pa3);
  if (hi == 0) li_l[r32] = l_reg; asm volatile("s_waitcnt lgkmcnt(0)" ::: "memory");
  float rli[16];
#pragma unroll
  for (int r = 0; r < 16; ++r) rli[r] = __builtin_amdgcn_rcpf(li_l[crow(r, hi)]);
  unsigned short* Ow = Ob + (long)(wid * QBLK) * LDO;
#pragma unroll
  for (int r = 0; r < 16; ++r) { int orow = crow(r, hi);
    for (int d0 = 0; d0 < 4; ++d0) Ow[(long)orow * LDO + d0 * 32 + r32] = f2bf16(o[d0][r] * rli[r]); }
#undef SLOAD
#undef SWRITE
#undef SWAIT
#undef RESC
}
}
#define GAS __attribute__((address_space(1)))
#define LAS __attribute__((address_space(3)))
typedef unsigned short bf16r;
typedef float f32x4 __attribute__((ext_vector_type(4)));
typedef unsigned u32x4 __attribute__((ext_vector_type(4)));
typedef unsigned u32x2 __attribute__((ext_vector_type(2)));
typedef short bf16x8 __attribute__((ext_vector_type(8)));

constexpr int DM = 2048, NB = 4, SEQ = 4096, CTX = 256, NLAT = NB * SEQ, NCTX = NB * CTX, NROW = NLAT + NCTX;
constexpr int INC = 3584, DFF = 8192, NMODC = 6 * DM, KVLEN = CTX + SEQ;
constexpr int NLAYER = 2;
constexpr float LN_EPS = 1e-6f, RMS_EPS = 1e-6f, DN_ALPHA = 1.4142135623730951f;
constexpr size_t MiB = 1u << 20;
constexpr size_t WS_ROPE = 0, WS_BAR = 768 * 1024, WS_BAR_BYTES = 16384, WS_STAT = 576 * 1024, WS_MOD = 64 * 1024, WS_WIN = 1 * MiB, WS_WOUT = 29 * MiB, WS_WFF1 = 45 * MiB, WS_WFF2 = 109 * MiB;
constexpr size_t WS_X = 173 * MiB, WS_H = 309 * MiB, WS_S = 377 * MiB;
constexpr size_t WS_P = WS_S, WS_Q = 496 * MiB, WS_K = 530 * MiB, WS_V = 539 * MiB, WS_MIX = 548 * MiB, WS_ACT = WS_S, WS_PART = 649 * MiB, WS_END = 713 * MiB;
static_assert(WS_WIN + 2ull * INC * DM * 2 <= WS_WOUT && WS_WOUT + 2ull * DM * DM * 2 <= WS_WFF1 && WS_WFF1 + 2ull * DFF * DM * 2 <= WS_WFF2 && WS_WFF2 + 2ull * DFF * DM * 2 <= WS_X, "ws weights");
static_assert(WS_X + (size_t)NROW * DM * 4 <= WS_H && WS_H + (size_t)NROW * DM * 2 <= WS_S && WS_P + (size_t)NROW * INC * 2 <= WS_Q && WS_Q + (size_t)NROW * 1024 * 2 <= WS_K, "ws act 1");
static_assert(WS_K + (size_t)NB * 2 * KVLEN * 128 * 2 <= WS_V && WS_V + (size_t)NB * 2 * KVLEN * 128 * 2 <= WS_MIX && WS_MIX + (size_t)NROW * DM * 2 <= WS_PART && WS_ACT + (size_t)NROW * DFF * 2 <= WS_PART && WS_PART + 8ull * NCTX * DM * 4 <= WS_END, "ws act 2");
static_assert(WS_MOD + 2ull * 5 * NMODC * 4 <= WS_STAT && WS_STAT + (size_t)NROW * 8 <= WS_BAR && WS_BAR + WS_BAR_BYTES <= WS_WIN, "ws mod");
constexpr int LDS_BYTES = 147456;

__device__ __forceinline__ unsigned f2bf(float f) { unsigned u = __builtin_bit_cast(unsigned, f); return (u + 0x7fffu + ((u >> 16) & 1u)) >> 16; }
__device__ __forceinline__ unsigned pk2(float lo, float hi) { return f2bf(lo) | (f2bf(hi) << 16); }
__device__ __forceinline__ float bflo(unsigned w) { return __builtin_bit_cast(float, w << 16); }
__device__ __forceinline__ float bfhi(unsigned w) { return __builtin_bit_cast(float, w & 0xffff0000u); }
__device__ __forceinline__ void unpack8(const u32x4 w, float (&x)[8]) { x[0] = bflo(w.x); x[1] = bfhi(w.x); x[2] = bflo(w.y); x[3] = bfhi(w.y); x[4] = bflo(w.z); x[5] = bfhi(w.z); x[6] = bflo(w.w); x[7] = bfhi(w.w); }
__device__ __forceinline__ u32x4 pack8(const float (&x)[8]) { u32x4 w; w.x = pk2(x[0], x[1]); w.y = pk2(x[2], x[3]); w.z = pk2(x[4], x[5]); w.w = pk2(x[6], x[7]); return w; }
__device__ __forceinline__ float wave_sum(float v) {
#pragma unroll
    for (int o = 1; o < 64; o <<= 1) v += __shfl_xor(v, o);
    return v;
}
__device__ __forceinline__ float gelu_tanh(float x) {
    const float u = 0.7978845608028654f * (x + 0.044715f * x * x * x);
    const float e = __expf(2.f * u);
    const float t = 1.f - 2.f * __builtin_amdgcn_rcpf(e + 1.f);
    return 0.5f * x * (1.f + t);
}
__device__ __forceinline__ float sigmoidf_(float x) { return __builtin_amdgcn_rcpf(1.f + __expf(-x)); }
#define LDS_WAIT() asm volatile("s_waitcnt lgkmcnt(0)" ::: "memory")

static __device__ const double ROPE_FREQ[32] = {1.0, 0.7498942093324559, 0.5623413251903491, 0.4216965034285822, 0.31622776601683794, 0.23713737056616552, 0.1778279410038923, 0.1333521432163324, 0.1, 0.07498942093324558, 0.05623413251903491, 0.042169650342858224, 0.03162277660168379, 0.023713737056616554, 0.01778279410038923, 0.01333521432163324, 0.01, 0.007498942093324558, 0.005623413251903491, 0.004216965034285823, 0.0031622776601683794, 0.0023713737056616554, 0.0017782794100389228, 0.001333521432163324, 0.001, 0.0007498942093324559, 0.0005623413251903491, 0.00042169650342858224, 0.00031622776601683794, 0.00023713737056616554, 0.00017782794100389227, 0.0001333521432163324};

__device__ __forceinline__ void p0_rope(float* rope, int gtid, int gthreads) {
    for (int idx = gtid; idx < 64 * 32; idx += gthreads) {
        const int p = idx >> 5, f = idx & 31;
        const double ang = (double)p * ROPE_FREQ[f];
        const double k = __builtin_rint(ang * 0.15915494309189535);
        const double r = ang - k * 6.283185307179586;
        const double r2 = r * r; double tc = 1.0, ts = 1.0, cc = 1.0, ss = 1.0;
#pragma unroll
        for (int n = 1; n <= 14; ++n) { tc *= -r2 * (1.0 / (double)((2 * n - 1) * (2 * n))); cc += tc; ts *= -r2 * (1.0 / (double)((2 * n) * (2 * n + 1))); ss += ts; }
        rope[2 * idx] = (float)cc; rope[2 * idx + 1] = (float)(r * ss);
    }
}
__device__ __forceinline__ void p0_mod(LAS unsigned char* lds, const float* c, const float* c_ctx, const float* w_mod, const float* b_mod, float* MOD, int bid, int G, int tid) {
    constexpr int NITEM = NLAYER * (NMODC / 128);
    if (bid >= NITEM) return;
    LAS float* condS = (LAS float*)lds;
    LAS float* red = (LAS float*)(lds + 5 * 2048 * 4);
    for (int i = tid; i < 5 * 2048; i += 512) { const int r = i >> 11, k = i & 2047; const float cv = (r < 4) ? c[r * 2048 + k] : c_ctx[k]; condS[i] = cv / (1.f + __expf(-cv)); }
    __syncthreads();
    const int kr = tid >> 5, cl = tid & 31;
    for (int item = bid; item < NITEM; item += G) {
        const int l = item / (NMODC / 128), n0 = (item % (NMODC / 128)) * 128;
        const float* wp = w_mod + ((size_t)l * 2048 + kr) * NMODC + n0 + 4 * cl;
        float acc[5][4];
#pragma unroll
        for (int r = 0; r < 5; ++r)
#pragma unroll
            for (int j = 0; j < 4; ++j) acc[r][j] = 0.f;
#pragma unroll 4
        for (int ks = 0; ks < 128; ++ks) {
            const f32x4 w = *(const f32x4*)(wp + (size_t)ks * 16 * NMODC); const int k = ks * 16 + kr;
#pragma unroll
            for (int r = 0; r < 5; ++r) { const float s = condS[r * 2048 + k];
#pragma unroll
                for (int j = 0; j < 4; ++j) acc[r][j] += s * w[j]; }
        }
#pragma unroll
        for (int r = 0; r < 5; ++r)
#pragma unroll
            for (int j = 0; j < 4; ++j) red[(kr * 32 + cl) * 20 + r * 4 + j] = acc[r][j];
        __syncthreads();
        for (int o = tid; o < 5 * 128; o += 512) { const int r = o >> 7, col = o & 127; float s = 0.f;
#pragma unroll
            for (int k2 = 0; k2 < 16; ++k2) s += red[(k2 * 32 + (col >> 2)) * 20 + r * 4 + (col & 3)];
            MOD[((size_t)l * 5 + r) * NMODC + n0 + col] = s + b_mod[(size_t)l * NMODC + n0 + col]; }
        __syncthreads();
    }
}
__device__ __forceinline__ void p0_transpose_item(const float* W, int K, int N, bf16r* WT, LAS float* scr, int item, int lane) {
    const int nblk = N / 64, kb = item / nblk, nb = item % nblk, k0 = 64 * kb, n0 = 64 * nb;
    const int r4 = lane >> 4, c4 = (lane & 15) * 4;
    f32x4 v[16];
#pragma unroll
    for (int i = 0; i < 16; ++i) v[i] = *(const f32x4*)(W + (size_t)(k0 + 4 * i + r4) * N + n0 + c4);
#pragma unroll
    for (int i = 0; i < 16; ++i) { LAS float* d = scr + (4 * i + r4) * 65 + c4; d[0] = v[i].x; d[1] = v[i].y; d[2] = v[i].z; d[3] = v[i].w; }
    LDS_WAIT(); asm volatile("" ::: "memory");
    const int c = lane & 7;
#pragma unroll
    for (int j = 0; j < 8; ++j) { const int n = (lane >> 3) + 8 * j; const LAS float* s = scr + (8 * c) * 65 + n;
        u32x4 o; o.x = pk2(s[0 * 65], s[1 * 65]); o.y = pk2(s[2 * 65], s[3 * 65]); o.z = pk2(s[4 * 65], s[5 * 65]); o.w = pk2(s[6 * 65], s[7 * 65]);
        *(u32x4*)(WT + (size_t)(n0 + n) * K + k0 + 8 * c) = o; }
    LDS_WAIT(); asm volatile("" ::: "memory");
}

__device__ __forceinline__ void row_stats(const f32x4 (&v)[8], float& mean, float& rstd) {
    float s = 0.f;
#pragma unroll
    for (int j = 0; j < 8; ++j) s += (v[j].x + v[j].y) + (v[j].z + v[j].w);
    mean = wave_sum(s) * (1.f / DM); float q = 0.f;
#pragma unroll
    for (int j = 0; j < 8; ++j) { const f32x4 d = v[j] - mean; q += (d.x * d.x + d.y * d.y) + (d.z * d.z + d.w * d.w); }
    rstd = 1.f / sqrtf(wave_sum(q) * (1.f / DM) + LN_EPS);
}
__device__ __forceinline__ void row_pass(const float* src_lat, const float* src_ctx, int nrows, const float* lng, const float* lnb, float* dst_lat, float* dst_ctx, float* stat,
                                         const float* modl  , int shift_off, int scale_off, bf16r* H, int gw, int NGW, int lane) {
    f32x4 v[8], vn[8];
    if (gw < nrows) { const float* sp = gw < NLAT ? src_lat + (size_t)gw * DM : src_ctx + (size_t)(gw - NLAT) * DM;
#pragma unroll
        for (int j = 0; j < 8; ++j) v[j] = *((const f32x4*)sp + 64 * j + lane); }
    for (int row = gw; row < nrows; row += NGW) {
        const bool lat = row < NLAT;
        const int rown = row + NGW;
        if (rown < nrows) { const float* sp = rown < NLAT ? src_lat + (size_t)rown * DM : src_ctx + (size_t)(rown - NLAT) * DM;
#pragma unroll
            for (int j = 0; j < 8; ++j) vn[j] = *((const f32x4*)sp + 64 * j + lane); }
        float mean, rstd;
        if (lng) {
            row_stats(v, mean, rstd);
            if (stat && lane == 0) { stat[2 * (size_t)row] = mean; stat[2 * (size_t)row + 1] = rstd; }
            float* dp = lat ? (dst_lat ? dst_lat + (size_t)row * DM : nullptr) : (dst_ctx ? dst_ctx + (size_t)(row - NLAT) * DM : nullptr);
#pragma unroll
            for (int j = 0; j < 8; ++j) { const f32x4 g = *((const f32x4*)lng + 64 * j + lane), b = *((const f32x4*)lnb + 64 * j + lane);
                v[j] = (v[j] - mean) * rstd * g + b; if (dp) *((f32x4*)dp + 64 * j + lane) = v[j]; }
        }
        if (modl) {
            row_stats(v, mean, rstd);
            const float* mr = modl + (size_t)(lat ? (row >> 12) : 4) * NMODC;
            bf16r* hp = H + (size_t)row * DM;
#pragma unroll
            for (int j = 0; j < 8; ++j) { const f32x4 sh = *((const f32x4*)(mr + shift_off) + 64 * j + lane), sc = *((const f32x4*)(mr + scale_off) + 64 * j + lane);
                const f32x4 o = (v[j] - mean) * rstd * (sc + 1.f) + sh; u32x2 w; w.x = pk2(o.x, o.y); w.y = pk2(o.z, o.w);
                *((u32x2*)hp + 64 * j + lane) = w; }
        }
#pragma unroll
        for (int j = 0; j < 8; ++j) v[j] = vn[j];
    }
}
__device__ __forceinline__ void row_pass_ctx(const float* src, const float* bstat, const float* bg, const float* bb, const float* part, const float* gate  , float* xdst,
                                             const float* lng, const float* lnb, float* stat, const float* modl, int shift_off, int scale_off, bf16r* H, int gw, int NGW, int lane) {
    for (int r = gw; r < NCTX; r += NGW) {
        const int row = NLAT + r;
        f32x4 v[8];
        float bm = 0.f, brs = 1.f; if (bstat) { bm = bstat[2 * (size_t)row]; brs = bstat[2 * (size_t)row + 1]; }
#pragma unroll
        for (int j = 0; j < 8; ++j) { f32x4 x = *((const f32x4*)(src + (size_t)r * DM) + 64 * j + lane);
            if (bstat) x = (x - bm) * brs * *((const f32x4*)bg + 64 * j + lane) + *((const f32x4*)bb + 64 * j + lane);
            f32x4 s = *((const f32x4*)(part + (size_t)r * DM) + 64 * j + lane);
#pragma unroll
            for (int k = 1; k < 8; ++k) s += *((const f32x4*)(part + ((size_t)k * NCTX + r) * DM) + 64 * j + lane);
            v[j] = x * DN_ALPHA + *((const f32x4*)gate + 64 * j + lane) * s;
            if (xdst) *((f32x4*)(xdst + (size_t)r * DM) + 64 * j + lane) = v[j]; }
        float mean, rstd;
        row_stats(v, mean, rstd);
        if (lane == 0) { stat[2 * (size_t)row] = mean; stat[2 * (size_t)row + 1] = rstd; }
#pragma unroll
        for (int j = 0; j < 8; ++j) v[j] = (v[j] - mean) * rstd * *((const f32x4*)lng + 64 * j + lane) + *((const f32x4*)lnb + 64 * j + lane);
        row_stats(v, mean, rstd);
        const float* mr = modl + (size_t)4 * NMODC;
        bf16r* hp = H + (size_t)row * DM;
#pragma unroll
        for (int j = 0; j < 8; ++j) { const f32x4 sh = *((const f32x4*)(mr + shift_off) + 64 * j + lane), sc = *((const f32x4*)(mr + scale_off) + 64 * j + lane);
            const f32x4 o = (v[j] - mean) * rstd * (sc + 1.f) + sh; u32x2 w; w.x = pk2(o.x, o.y); w.y = pk2(o.z, o.w);
            *((u32x2*)hp + 64 * j + lane) = w; }
    }
}

__device__ __forceinline__ void rms_rope_apply(const u32x4 w1, const u32x4 w2, const float (&g1)[8], const float (&g2)[8], const f32x4 (&rp)[4], bool rope_on, u32x4& o1w, u32x4& o2w) {
    float x1[8], x2[8]; unpack8(w1, x1); unpack8(w2, x2);
    float ss = 0.f;
#pragma unroll
    for (int j = 0; j < 8; ++j) ss += x1[j] * x1[j] + x2[j] * x2[j];
    ss += __shfl_xor(ss, 1); ss += __shfl_xor(ss, 2); ss += __shfl_xor(ss, 4);
    const float rn = 1.f / sqrtf(ss * (1.f / 128.f) + RMS_EPS);
    float o1[8], o2[8];
#pragma unroll
    for (int j = 0; j < 8; ++j) { const float y1 = x1[j] * rn * g1[j], y2 = x2[j] * rn * g2[j];
        float c = 1.f, s = 0.f; if (rope_on) { c = rp[j >> 1][(j & 1) * 2]; s = rp[j >> 1][(j & 1) * 2 + 1]; }
        o1[j] = y1 * c - y2 * s; o2[j] = y1 * s + y2 * c; }
    o1w = pack8(o1); o2w = pack8(o2);
}
__device__ __forceinline__ void prep_qkv(const bf16r* __restrict__ P, bf16r* __restrict__ Qb, bf16r* __restrict__ Kb, bf16r* __restrict__ Vb, const float* __restrict__ qg, const float* __restrict__ kg,
                                         const float* __restrict__ rope, int nrows, bool ctx_q, int gw, int NGW, int lane) {
    const int i = lane & 7, a = i >> 2, f0 = (i & 3) * 8, head = lane >> 3, kvh = (lane & 15) >> 3, vj = lane & 31;
    float gq1[8], gq2[8], gk1[8], gk2[8];
#pragma unroll
    for (int j = 0; j < 8; ++j) { gq1[j] = qg[a * 64 + f0 + j]; gq2[j] = qg[a * 64 + 32 + f0 + j]; gk1[j] = kg[a * 64 + f0 + j]; gk2[j] = kg[a * 64 + 32 + f0 + j]; }
    for (int row0 = gw * 2; row0 < nrows; row0 += NGW * 2) {
        u32x4 q1[2], q2[2], k1[2], k2[2], vv[2]; f32x4 rp[2][4];
#pragma unroll
        for (int r = 0; r < 2; ++r) { const int row = row0 + r; const bf16r* prow = P + (size_t)row * INC;
            const bool lat = row < NLAT; const int t = lat ? (row & 4095) : ((row - NLAT) & 255);
            const bf16r* qs = prow + 2048 + head * 128 + a * 64 + f0; const bf16r* ks = prow + 3072 + kvh * 128 + a * 64 + f0;
            q1[r] = *(const u32x4*)qs; q2[r] = *(const u32x4*)(qs + 32); k1[r] = *(const u32x4*)ks; k2[r] = *(const u32x4*)(ks + 32); vv[r] = *(const u32x4*)(prow + 3328 + vj * 8);
            const int pos = (a == 0) ? (t >> 6) : (t & 63); const float* rpp = rope + (size_t)(pos * 32 + f0) * 2;
#pragma unroll
            for (int jj = 0; jj < 4; ++jj) rp[r][jj] = *(const f32x4*)(rpp + 4 * jj); }
#pragma unroll
        for (int r = 0; r < 2; ++r) { const int row = row0 + r;
            const bool lat = row < NLAT; const int b = lat ? (row >> 12) : ((row - NLAT) >> 8), t = lat ? (row & 4095) : ((row - NLAT) & 255);
            const int posk = lat ? CTX + t : t;
            u32x4 o1, o2;
            rms_rope_apply(q1[r], q2[r], gq1, gq2, rp[r], lat, o1, o2);
            if (lat || ctx_q) { bf16r* dst = Qb + (size_t)row * 1024 + head * 128 + a * 64 + f0; *(u32x4*)dst = o1; *(u32x4*)(dst + 32) = o2; }
            rms_rope_apply(k1[r], k2[r], gk1, gk2, rp[r], lat, o1, o2);
            if (lane < 16) { bf16r* dst = Kb + ((size_t)(b * 2 + kvh) * KVLEN + posk) * 128 + a * 64 + f0; *(u32x4*)dst = o1; *(u32x4*)(dst + 32) = o2; }
            if (lane < 32) *(u32x4*)(Vb + ((size_t)(b * 2 + (vj >> 4)) * KVLEN + posk) * 128 + (vj & 15) * 8) = vv[r]; }
    }
}

__device__ __forceinline__ void gmlp_ldw(const float* __restrict__ Wh, int wave, int lane, f32x4 (&w)[8]) {
    const float* p = Wh + (size_t)(16 * wave + (lane & 15)) * 128 + 8 * (lane >> 4);
#pragma unroll
    for (int ks = 0; ks < 4; ++ks) { w[2 * ks] = *(const f32x4*)(p + ks * 32); w[2 * ks + 1] = *(const f32x4*)(p + ks * 32 + 4); }
}
__device__ __forceinline__ void gmlp_item(LAS unsigned char* lds, const bf16r* __restrict__ P, bf16r* __restrict__ MIX, const float* __restrict__ lng, const float* __restrict__ lnb,
                                          const float* __restrict__ Ws  , const float* __restrict__ bs  , int ch, int tid, int wave, int lane) {
    constexpr int LDT = 136;
    LAS bf16r* vT = (LAS bf16r*)lds;
    const int r0 = ch * 128;
    f32x4 wreg[8]; gmlp_ldw(Ws, wave, lane, wreg);
    { float gl[8], bl[8];
#pragma unroll
      for (int j = 0; j < 8; ++j) { gl[j] = lng[lane * 8 + j]; bl[j] = lnb[lane * 8 + j]; }
#pragma unroll
      for (int hb = 0; hb < 2; ++hb) {
        u32x4 raw[8];
#pragma unroll
        for (int i = 0; i < 8; ++i) raw[i] = *(const u32x4*)(P + (size_t)(r0 + wave + 8 * (hb * 8 + i)) * INC + 512 + lane * 8);
#pragma unroll
        for (int i = 0; i < 8; ++i) { const int q = wave + 8 * (hb * 8 + i);
            float x[8]; unpack8(raw[i], x);
            float s = 0.f;
#pragma unroll
            for (int j = 0; j < 8; ++j) { x[j] = gelu_tanh(x[j]); s += x[j]; }
            const float mean = wave_sum(s) * (1.f / 512.f); float qq = 0.f;
#pragma unroll
            for (int j = 0; j < 8; ++j) { const float d = x[j] - mean; qq += d * d; }
            const float rstd = __builtin_amdgcn_rsqf(wave_sum(qq) * (1.f / 512.f) + LN_EPS);
#pragma unroll
            for (int j = 0; j < 8; ++j) { const float v = (x[j] - mean) * rstd * gl[j] + bl[j]; vT[(lane * 8 + j) * LDT + (((q >> 3) ^ (lane & 15)) << 3) + (q & 7)] = (bf16r)f2bf(v); } }
      } }
    __syncthreads();
    const int p = 16 * wave + (lane & 15); const size_t row = (size_t)(r0 + p);
#pragma unroll 1
    for (int h = 0; h < 4; ++h) {
        bf16x8 bfr[4];
#pragma unroll
        for (int ks = 0; ks < 4; ++ks) { u32x4 t; t.x = pk2(wreg[2 * ks].x, wreg[2 * ks].y); t.y = pk2(wreg[2 * ks].z, wreg[2 * ks].w); t.z = pk2(wreg[2 * ks + 1].x, wreg[2 * ks + 1].y); t.w = pk2(wreg[2 * ks + 1].z, wreg[2 * ks + 1].w);
            bfr[ks] = __builtin_bit_cast(bf16x8, t); }
        if (h < 3) gmlp_ldw(Ws + (size_t)(h + 1) * 128 * 128, wave, lane, wreg);
        const float bsv = bs[h * 128 + p];
        u32x2 uw[8];
#pragma unroll
        for (int dt = 0; dt < 8; ++dt) uw[dt] = *(const u32x2*)(P + row * INC + h * 128 + 16 * dt + 4 * (lane >> 4));
#pragma unroll
        for (int dt = 0; dt < 8; ++dt) {
            pg8::f32x4 acc = {0.f, 0.f, 0.f, 0.f};
#pragma unroll
            for (int ks = 0; ks < 4; ++ks) { const int c = h * 128 + 16 * dt + (lane & 15); const bf16x8 af = *(const LAS bf16x8*)(vT + c * LDT + (((ks * 4 + (lane >> 4)) ^ ((c >> 3) & 15)) << 3));
                acc = __builtin_amdgcn_mfma_f32_16x16x32_bf16(af, bfr[ks], acc, 0, 0, 0); }
            const float u0 = gelu_tanh(bflo(uw[dt].x)), u1 = gelu_tanh(bfhi(uw[dt].x)), u2 = gelu_tanh(bflo(uw[dt].y)), u3 = gelu_tanh(bfhi(uw[dt].y));
            u32x2 o; o.x = pk2(u0 * (acc[0] + bsv), u1 * (acc[1] + bsv)); o.y = pk2(u2 * (acc[2] + bsv), u3 * (acc[3] + bsv));
            *(u32x2*)(MIX + row * DM + h * 128 + 16 * dt + 4 * (lane >> 4)) = o;
        }
    }
    __syncthreads();
}

__device__ __forceinline__ void conv_item(LAS unsigned char* lds, const bf16r* __restrict__ P, bf16r* __restrict__ MIX, const float* __restrict__ wdw  , const float* __restrict__ bdw,
                                          const float* __restrict__ lng, const float* __restrict__ lnb, int item, int tid, int wave, int lane) {
    LAS float* z = (LAS float*)lds;
    const int row0 = item * 32;
    const int seq0 = row0 < NLAT ? (row0 & ~4095) : (NLAT + ((row0 - NLAT) & ~255)), seq1 = seq0 + (row0 < NLAT ? SEQ : CTX);
    float acc[32]; float w[31];
    { const float bv = bdw[tid];
#pragma unroll
      for (int t = 0; t < 32; ++t) acc[t] = bv;
#pragma unroll
      for (int j = 0; j < 31; ++j) w[j] = wdw[j * 512 + tid]; }
    { u32x4 ra[8], rb[8];
#pragma unroll
      for (int i = 0; i < 8; ++i) { const int rr = wave + 8 * i; int g = row0 - 15 + rr; const bool ok = rr < 62 && g >= seq0 && g < seq1; if (!ok) g = row0;
          ra[i] = *(const u32x4*)(P + (size_t)g * INC + 1024 + lane * 8); rb[i] = *(const u32x4*)(P + (size_t)g * INC + 1536 + lane * 8); }
#pragma unroll
      for (int i = 0; i < 8; ++i) { const int rr = wave + 8 * i; const int g = row0 - 15 + rr; const bool ok = g >= seq0 && g < seq1;
          if (rr < 62) { float a[8], b[8], zv[8]; unpack8(ra[i], a); unpack8(rb[i], b);
#pragma unroll
              for (int j = 0; j < 8; ++j) zv[j] = ok ? a[j] * sigmoidf_(b[j]) : 0.f;
              *(LAS f32x4*)(z + rr * 512 + lane * 8) = (f32x4){zv[0], zv[1], zv[2], zv[3]}; *(LAS f32x4*)(z + rr * 512 + lane * 8 + 4) = (f32x4){zv[4], zv[5], zv[6], zv[7]}; } } }
    __syncthreads();
#pragma unroll
    for (int rr = 0; rr < 62; ++rr) { const float zv = z[rr * 512 + tid];
#pragma unroll
        for (int t = 0; t < 32; ++t) { if (rr - t >= 0 && rr - t <= 30) acc[t] += w[rr - t] * zv; } }
    __syncthreads();
#pragma unroll
    for (int t = 0; t < 32; ++t) z[t * 512 + tid] = acc[t];
    __syncthreads();
    float gl[8], bl[8];
#pragma unroll
    for (int j = 0; j < 8; ++j) { gl[j] = lng[lane * 8 + j]; bl[j] = lnb[lane * 8 + j]; }
#pragma unroll
    for (int i = 0; i < 4; ++i) { const int t = wave * 4 + i;
        const f32x4 y0 = *(const LAS f32x4*)(z + t * 512 + lane * 8), y1 = *(const LAS f32x4*)(z + t * 512 + lane * 8 + 4);
        float x[8] = {y0.x, y0.y, y0.z, y0.w, y1.x, y1.y, y1.z, y1.w};
        float s = 0.f;
#pragma unroll
        for (int j = 0; j < 8; ++j) s += x[j];
        const float mean = wave_sum(s) * (1.f / 512.f); float qq = 0.f;
#pragma unroll
        for (int j = 0; j < 8; ++j) { const float d = x[j] - mean; qq += d * d; }
        const float rstd = __builtin_amdgcn_rsqf(wave_sum(qq) * (1.f / 512.f) + LN_EPS);
        float o[8];
#pragma unroll
        for (int j = 0; j < 8; ++j) { const float v = (x[j] - mean) * rstd * gl[j] + bl[j]; o[j] = v * sigmoidf_(v); }
        *(u32x4*)(MIX + (size_t)(row0 + t) * DM + 512 + lane * 8) = pack8(o);
    }
    __syncthreads();
}

#define XB_TMO      128
#define XB_XCNT(j)  (256  + 64 * (j))
#define XB_XSUB(j)  (1280 + 64 * (j))
#define XB_XGEN(j)  (2304 + 64 * (j))
#define XB_TOP      3328
#define XB_TOPGEN   3392
#define XCD_BAR_WORDS 3456
#define XB_SPIN_CAP (1u << 18)

__device__ __forceinline__ unsigned xb_ld(unsigned* p)              { return __hip_atomic_load(p, __ATOMIC_RELAXED, __HIP_MEMORY_SCOPE_AGENT); }
__device__ __forceinline__ unsigned xb_add(unsigned* p, unsigned v) { return __hip_atomic_fetch_add(p, v, __ATOMIC_RELAXED, __HIP_MEMORY_SCOPE_AGENT); }
__device__ __forceinline__ unsigned xb_xcc_id() { return (unsigned)__builtin_amdgcn_s_getreg((3 << 11) | 20) & 0xFu; }
#define XB_SPIN(cond, bar) do { unsigned _sp = 0; while (cond) { __builtin_amdgcn_s_sleep(1); \
    if ((++_sp & 255u) == 0u) { if (xb_ld(&(bar)[XB_TMO])) break; if (_sp > XB_SPIN_CAP) { atomicAdd(&(bar)[XB_TMO], 1u); break; } } } } while (0)

struct XcdBarrier {
    unsigned* bar; unsigned x;
    volatile LAS unsigned* st;
};

__device__ __forceinline__ XcdBarrier xcd_barrier_post(unsigned* bar, volatile LAS unsigned* st) {
    XcdBarrier b; b.bar = bar; b.x = xb_xcc_id(); b.st = st;
    if (threadIdx.x == 0) (void)xb_add(&bar[XB_XCNT(b.x)], 1u);
    return b;
}
__device__ __forceinline__ void xcd_barrier_complete(unsigned* bar, unsigned x, unsigned& nloc, unsigned& nx) {
    const unsigned G = gridDim.x * gridDim.y * gridDim.z;
    unsigned sum, cnt, mine, sp = 0u;
    for (;;) {
        sum = 0u; cnt = 0u; mine = 0u;
#pragma unroll
        for (unsigned j = 0; j < 16; ++j) { const unsigned c = xb_ld(&bar[XB_XCNT(j)]); sum += c; cnt += (c > 0u) ? 1u : 0u; mine = (j == x) ? c : mine; }
        if (sum == G) break;
        __builtin_amdgcn_s_sleep(1);
        if ((++sp & 255u) == 0u) { if (xb_ld(&bar[XB_TMO])) break; if (sp > XB_SPIN_CAP) { atomicAdd(&bar[XB_TMO], 1u); break; } }
    }
    nloc = mine > 0u ? mine : 1u; nx = cnt > 0u ? cnt : 1u;
}

__device__ __forceinline__ void xcd_barrier(const XcdBarrier& b) {
    asm volatile("s_waitcnt vmcnt(0)" ::: "memory");
    __syncthreads();
    if (threadIdx.x == 0) {
        unsigned* bar = b.bar;
        __builtin_amdgcn_s_waitcnt(0);
        unsigned nloc = b.st[0], nx = b.st[1];
        if (nloc == 0u) { xcd_barrier_complete(bar, b.x, nloc, nx); b.st[0] = nloc; b.st[1] = nx; }
        const unsigned old = xb_add(&bar[XB_XSUB(b.x)], 1u);
        const unsigned gen = old / nloc;
        if (old + 1u == (gen + 1u) * nloc) {
            __builtin_amdgcn_fence(__ATOMIC_RELEASE, "agent");
            asm volatile("s_waitcnt vmcnt(0)" ::: "memory");
            const unsigned og = xb_add(&bar[XB_TOP], 1u);
            const unsigned tg = og / nx;
            if (og + 1u == (tg + 1u) * nx) xb_add(&bar[XB_TOPGEN], 1u);
            else XB_SPIN(xb_ld(&bar[XB_TOPGEN]) == tg, bar);
            __builtin_amdgcn_fence(__ATOMIC_ACQUIRE, "agent");
            xb_add(&bar[XB_XGEN(b.x)], 1u);
            asm volatile("s_waitcnt vmcnt(0)" ::: "memory");
        } else {
            XB_SPIN(xb_ld(&bar[XB_XGEN(b.x)]) == gen, bar);
            __builtin_amdgcn_fence(__ATOMIC_ACQUIRE, "agent");
            asm volatile("s_waitcnt vmcnt(0)" ::: "memory");
        }
    }
    __syncthreads();
}

#ifndef REP_P0
#define REP_P0 0
#endif
#ifndef REP_RP
#define REP_RP 0
#endif
#ifndef REP_ATTN
#define REP_ATTN 0
#endif
#ifndef REP_PREP
#define REP_PREP 0
#endif
#ifndef REP_QKV
#define REP_QKV 0
#endif
#ifndef REP_GMLP
#define REP_GMLP 0
#endif
#ifndef REP_CONV
#define REP_CONV 0
#endif
#ifndef REP_G1
#define REP_G1 0
#endif
#ifndef REP_G3
#define REP_G3 0
#endif
#ifndef REP_G4
#define REP_G4 0
#endif
#ifndef REP_G2
#define REP_G2 0
#endif
#define REPEAT(n) for (int rep_ = 0; rep_ < 1 + (n); ++rep_)
struct Args { const float* in[24]; float* out; unsigned char* ws; int ph_lo, ph_hi; };
constexpr int N_PHASES = 2 + 8 * NLAYER;
struct Ctx {
    LAS unsigned char* lds; unsigned char* lds_raw; int tid, lane, wave, G, bx, vcu, gw, NGW, lo, hi;
    const float *w_in, *w_out, *w_ff1, *w_ff2;
    const float *x_in, *ctx_in, *a_ln_g, *a_ln_b, *a_ws, *a_bs, *b_dw, *b_dwb, *b_ln_g, *b_ln_b, *q_gain, *k_gain, *ln1_g, *ln1_b, *ln2_g, *ln2_b;
    float *rope, *MOD, *X, *out, *STAT, *PART; bf16r *Wt_in, *Wt_out, *Wt_ff1, *Wt_ff2, *H, *P, *Qb, *Kb, *Vb, *MIX, *ACT;
};
#define RUN (pid >= C.lo && pid < C.hi)
#define SEAM() do { if (pid >= C.lo && pid + 1 < C.hi) xcd_barrier(bar); ++pid; } while (0)

__device__ __forceinline__ void tail_transposes(const Ctx& C, int nwg, const float* Wa, int Ka, int Na, bf16r* Ta, const float* Wb2, int Kb, int Nb, bf16r* Tb) {
    const int first = nwg % C.G;
    if (C.bx < first) return;
    LAS float* scr = (LAS float*)(C.lds + C.wave * 16640);
    const int ia = (Ka / 64) * (Na / 64), ib = (Kb / 64) * (Nb / 64), stride = (C.G - first) * 8;
    for (int it = (C.bx - first) * 8 + C.wave; it < ia + ib; it += stride) {
        if (it < ia) p0_transpose_item(Wa, Ka, Na, Ta, scr, it, C.lane); else p0_transpose_item(Wb2, Kb, Nb, Tb, scr, it - ia, C.lane);
    }
}

template <int l> __device__ __forceinline__ void layer_body(const Ctx& C, int& pid, const XcdBarrier& bar) {
    constexpr bool last = (l == NLAYER - 1);
    constexpr int Mrows = last ? NLAT : NROW;
    const float* modl = C.MOD + (size_t)l * 5 * NMODC;
    float* Xc = C.X + (size_t)NLAT * DM;
    if (RUN) {
#if !defined(DIS_GEMM) && !defined(DIS_G1)
        pg8::Gemm g{C.H, C.Wt_in + (size_t)l * INC * DM, Mrows, INC, DM, DM / 64}; pg8::OrderX S; S.init(Mrows, INC, C.G, C.bx, 64, last ? 4 : 0, 12, 2);
        pg8::EpiBf16<0> E{C.P, INC};
        REPEAT(REP_G1) pg8::gemm_phase<pg8::EpiBf16<0>, pg8::OrderX, true, true>(C.lds, g, S, E);
        if (l == 0) tail_transposes(C, (Mrows / 256) * (INC / 256), C.w_in + (size_t)DM * INC, DM, INC, C.Wt_in + (size_t)INC * DM, C.w_out + (size_t)DM * DM, DM, DM, C.Wt_out + (size_t)DM * DM);
#endif
    }
    SEAM();
    if (RUN) {
        REPEAT(REP_PREP) {
#ifndef DIS_PREP
        REPEAT(REP_QKV) prep_qkv(C.P, C.Qb, C.Kb, C.Vb, C.q_gain + l * 128, C.k_gain + l * 128, C.rope, NROW, !last, C.gw, C.NGW, C.lane);
#endif
#ifndef DIS_GMLP
        constexpr int nch = Mrows / 128;
        REPEAT(REP_GMLP) for (int it = C.vcu; it < nch; it += C.G) gmlp_item(C.lds, C.P, C.MIX, C.a_ln_g + l * 512, C.a_ln_b + l * 512, C.a_ws + (size_t)l * 4 * 128 * 128, C.a_bs + l * 512, it, C.tid, C.wave, C.lane);
#endif
#ifndef DIS_CONV
        REPEAT(REP_CONV) for (int it = C.G - 1 - C.vcu; it < Mrows / 32; it += C.G) conv_item(C.lds, C.P, C.MIX, C.b_dw + (size_t)l * 31 * 512, C.b_dwb + l * 512, C.b_ln_g + l * 512, C.b_ln_b + l * 512, it, C.tid, C.wave, C.lane);
#endif
        }
    }
    SEAM();
    if (RUN) {
        constexpr int nunits = 512 + (last ? 0 : 32);
        REPEAT(REP_ATTN) for (int u = C.vcu; u < nunits; u += C.G) {
            int b, h, row0, seq;
            if (u < 512) { b = u >> 7; h = (u >> 4) & 7; row0 = b * SEQ + (u & 15) * 256; seq = KVLEN; }
            else { const int u2 = u - 512; b = u2 >> 3; h = u2 & 7; row0 = NLAT + b * CTX; seq = CTX; }
            const size_t kvoff = (size_t)(b * 2 + (h >> 2)) * KVLEN * 128;
#ifndef DIS_ATTN
            attn::attn_dense_body<attn::bf16>((const attn::bf16*)(C.Qb + (size_t)row0 * 1024 + h * 128), (const attn::bf16*)(C.Kb + kvoff), (const attn::bf16*)(C.Vb + kvoff),
                                              C.MIX + (size_t)row0 * DM + 1024 + h * 128, seq, (char*)C.lds_raw);
#endif
            __syncthreads();
        }
    }
    SEAM();
    if (RUN) {
#if !defined(DIS_GEMM) && !defined(DIS_G2)
        pg8::Gemm g{C.MIX, C.Wt_out + (size_t)l * DM * DM, NLAT, DM, DM, DM / 64}; pg8::OrderX S; S.init(NLAT, DM, C.G, C.bx, 0, 0, 0, 0);
        constexpr int lp = l > 0 ? l - 1 : 0;
        pg8::EpiResGate<(l > 0)> E{l == 0 ? C.x_in : C.X, l == 0 ? C.ctx_in : Xc, C.X, modl + 2 * DM, DN_ALPHA, C.STAT, C.ln2_g + lp * DM, C.ln2_b + lp * DM};
        pg8::gemm_phase<pg8::EpiResGate<(l > 0)>, pg8::OrderX, true, true>(C.lds, g, S, E);
        if (!last) {
            pg8::Gemm g2{C.MIX, C.Wt_out + (size_t)l * DM * DM, NROW, DM, DM, 4}; pg8::OrderSplit S2; S2.init(C.G, C.bx, 8, 4);
            pg8::EpiPart E2{C.PART, 4 * 128};
            pg8::gemm_phase<pg8::EpiPart, pg8::OrderSplit, true, true>(C.lds, g2, S2, E2);
        }
#endif
    }
    SEAM();
    if (RUN) REPEAT(REP_RP) {
        row_pass(C.X, Xc, NLAT, C.ln1_g + l * DM, C.ln1_b + l * DM, nullptr, nullptr, C.STAT, modl, 3 * DM, 4 * DM, C.H, C.gw, C.NGW, C.lane);
        if (!last) row_pass_ctx(C.ctx_in, nullptr, nullptr, nullptr, C.PART, modl + 4 * (size_t)NMODC + 2 * DM, Xc, C.ln1_g + l * DM, C.ln1_b + l * DM, C.STAT, modl, 3 * DM, 4 * DM, C.H, C.gw, C.NGW, C.lane);
    }
    SEAM();
    if (RUN) {
#if !defined(DIS_GEMM) && !defined(DIS_G3)
        pg8::Gemm g{C.H, C.Wt_ff1 + (size_t)l * DFF * DM, Mrows, DFF, DM, DM / 64}; pg8::OrderX S; S.init(Mrows, DFF, C.G, C.bx, 0, 0, 0, 0);
        pg8::EpiBf16<2> E{C.ACT, DFF};
        pg8::gemm_phase<pg8::EpiBf16<2>, pg8::OrderX, true, true>(C.lds, g, S, E);
        if (l == 0) tail_transposes(C, (Mrows / 256) * (DFF / 256), C.w_ff1 + (size_t)DM * DFF, DM, DFF, C.Wt_ff1 + (size_t)DFF * DM, C.w_ff2 + (size_t)DFF * DM, DFF, DM, C.Wt_ff2 + (size_t)DM * DFF);
#endif
    }
    SEAM();
    if (RUN) {
#if !defined(DIS_GEMM) && !defined(DIS_G4)
        pg8::Gemm g{C.ACT, C.Wt_ff2 + (size_t)l * DM * DFF, NLAT, DM, DFF, DFF / 64}; pg8::OrderX S; S.init(NLAT, DM, C.G, C.bx, 0, 0, 0, 0);
        pg8::EpiResGate<true> E{C.X, Xc, C.X, modl + 5 * DM, DN_ALPHA, C.STAT, C.ln1_g + l * DM, C.ln1_b + l * DM};
        pg8::gemm_phase<pg8::EpiResGate<true>, pg8::OrderX, true, true>(C.lds, g, S, E);
        if (!last) {
            pg8::Gemm g2{C.ACT, C.Wt_ff2 + (size_t)l * DM * DFF, NROW, DM, DFF, 16}; pg8::OrderSplit S2; S2.init(C.G, C.bx, 8, 16);
            pg8::EpiPart E2{C.PART, 16 * 128};
            pg8::gemm_phase<pg8::EpiPart, pg8::OrderSplit, true, true>(C.lds, g2, S2, E2);
        }
#endif
    }
    SEAM();
    if (RUN) {
        if (last) { REPEAT(REP_RP) row_pass(C.X, nullptr, NLAT, C.ln2_g + l * DM, C.ln2_b + l * DM, C.out, nullptr, nullptr, nullptr, 0, 0, nullptr, C.gw, C.NGW, C.lane); }
        else {
            REPEAT(REP_RP) row_pass(C.X, Xc, NLAT, C.ln2_g + l * DM, C.ln2_b + l * DM, nullptr, nullptr, C.STAT, modl + 5 * NMODC, 0 * DM, 1 * DM, C.H, C.gw, C.NGW, C.lane);
            row_pass_ctx(Xc, C.STAT, C.ln1_g + l * DM, C.ln1_b + l * DM, C.PART, modl + 4 * (size_t)NMODC + 5 * DM, nullptr, C.ln2_g + l * DM, C.ln2_b + l * DM, C.STAT, modl + 5 * NMODC, 0 * DM, 1 * DM, C.H, C.gw, C.NGW, C.lane);
        }
    }
    SEAM();
}

__global__ void __launch_bounds__(512, 2) fwd_megakernel(Args args) {
    extern __shared__ __attribute__((aligned(16))) unsigned char lds_raw[];
    cg::grid_group grid = cg::this_grid();
    Ctx C;
    C.lds = (LAS unsigned char*)lds_raw; C.lds_raw = lds_raw;
    C.tid = threadIdx.x; C.lane = C.tid & 63; C.wave = __builtin_amdgcn_readfirstlane(C.tid >> 6);
    C.G = gridDim.x; C.bx = blockIdx.x; C.vcu = (C.G % 8 == 0) ? (C.bx % 8) * (C.G / 8) + C.bx / 8 : C.bx;
    C.gw = C.vcu * 8 + C.wave; C.NGW = C.G * 8; C.lo = args.ph_lo; C.hi = args.ph_hi;
    unsigned char* ws = args.ws;
    C.x_in = args.in[0]; C.ctx_in = args.in[2]; C.w_in = args.in[6]; C.w_out = args.in[17]; C.w_ff1 = args.in[20]; C.w_ff2 = args.in[21];
    C.a_ln_g = args.in[7]; C.a_ln_b = args.in[8]; C.a_ws = args.in[9]; C.a_bs = args.in[10];
    C.b_dw = args.in[11]; C.b_dwb = args.in[12]; C.b_ln_g = args.in[13]; C.b_ln_b = args.in[14];
    C.q_gain = args.in[15]; C.k_gain = args.in[16]; C.ln1_g = args.in[18]; C.ln1_b = args.in[19]; C.ln2_g = args.in[22]; C.ln2_b = args.in[23];
    C.STAT = (float*)(ws + WS_STAT); C.PART = (float*)(ws + WS_PART); C.rope = (float*)(ws + WS_ROPE); C.MOD = (float*)(ws + WS_MOD); C.X = (float*)(ws + WS_X); C.out = args.out;
    C.Wt_in = (bf16r*)(ws + WS_WIN); C.Wt_out = (bf16r*)(ws + WS_WOUT); C.Wt_ff1 = (bf16r*)(ws + WS_WFF1); C.Wt_ff2 = (bf16r*)(ws + WS_WFF2);
    C.H = (bf16r*)(ws + WS_H); C.P = (bf16r*)(ws + WS_P); C.Qb = (bf16r*)(ws + WS_Q);
    C.Kb = (bf16r*)(ws + WS_K); C.Vb = (bf16r*)(ws + WS_V); C.MIX = (bf16r*)(ws + WS_MIX); C.ACT = (bf16r*)(ws + WS_ACT);
    int pid = 0;
    volatile LAS unsigned* bst = (volatile LAS unsigned*)(C.lds + LDS_BYTES - 64);
    if (C.tid < 2) bst[C.tid] = 0u;
    __syncthreads();
    const XcdBarrier bar = xcd_barrier_post((unsigned*)(ws + WS_BAR), bst);
    if (C.hi < 0) grid.sync();

    if (RUN) REPEAT(REP_P0) {
        const float* c_in = args.in[1]; const float* cctx_in = args.in[3]; const float* w_mod = args.in[4]; const float* b_mod = args.in[5];
        const float* w_in = args.in[6]; const float* w_out = args.in[17]; const float* w_ff1 = args.in[20]; const float* w_ff2 = args.in[21];
        p0_rope(C.rope, C.bx * 512 + C.tid, C.G * 512);
        p0_mod(C.lds, c_in, cctx_in, w_mod, b_mod, C.MOD, C.bx, C.G, C.tid);
        __syncthreads();
        LAS float* scr = (LAS float*)(C.lds + C.wave * 16640);
        constexpr int I_IN = (DM / 64) * (INC / 64), I_OUT = (DM / 64) * (DM / 64), I_F1 = (DM / 64) * (DFF / 64), I_F2 = (DFF / 64) * (DM / 64), I_L = I_IN + I_OUT + I_F1 + I_F2;
        for (int it = C.gw; it < I_L; it += C.NGW) {
            const int l = 0; int r = it;
            if (r < I_IN) { p0_transpose_item(w_in + (size_t)l * DM * INC, DM, INC, C.Wt_in + (size_t)l * INC * DM, scr, r, C.lane); continue; } r -= I_IN;
            if (r < I_OUT) { p0_transpose_item(w_out + (size_t)l * DM * DM, DM, DM, C.Wt_out + (size_t)l * DM * DM, scr, r, C.lane); continue; } r -= I_OUT;
            if (r < I_F1) { p0_transpose_item(w_ff1 + (size_t)l * DM * DFF, DM, DFF, C.Wt_ff1 + (size_t)l * DFF * DM, scr, r, C.lane); continue; } r -= I_F1;
            p0_transpose_item(w_ff2 + (size_t)l * DFF * DM, DFF, DM, C.Wt_ff2 + (size_t)l * DM * DFF, scr, r, C.lane);
        }
        if (REP_P0) __syncthreads();
    }
    SEAM();
    if (RUN) REPEAT(REP_RP) row_pass(C.x_in, C.ctx_in, NROW, nullptr, nullptr, nullptr, nullptr, nullptr, C.MOD, 0 * DM, 1 * DM, C.H, C.gw, C.NGW, C.lane);
    SEAM();
    layer_body<0>(C, pid, bar);
    layer_body<1>(C, pid, bar);
#ifdef EXTRA_SYNCS
    if (C.hi - C.lo > 1) { for (int i = 0; i < EXTRA_SYNCS; ++i) {
#ifdef EXTRA_DIRTY
        { f32x4* sp = (f32x4*)(ws + WS_PART) + (size_t)C.bx * 512 * EXTRA_DIRTY + C.tid;
          for (int k = 0; k < EXTRA_DIRTY; ++k) sp[k * 512] = (f32x4){(float)i, 1.f, 2.f, 3.f}; }
#endif
        xcd_barrier(bar); } }
#endif
}
#undef RUN
#undef SEAM

#ifndef MK_PER_PHASE
#define MK_PER_PHASE 0
#endif
extern "C" void kernel_launch(void* const* d_in, const int* in_sizes, int n_in, void* d_out, int out_size, void* d_ws, size_t ws_size, hipStream_t stream) {
    static int grid = 0;
    if (grid == 0) {
        if (n_in != 24 || out_size != NLAT * DM || ws_size < WS_END) { fprintf(stderr, "kernel_launch: unexpected shapes (n_in %d out %d ws %zu, need ws >= %zu)\n", n_in, out_size, ws_size, (size_t)WS_END); grid = -1; return; }
        int dev = 0, cus = 0, per_cu = 0;
        (void)hipGetDevice(&dev); (void)hipDeviceGetAttribute(&cus, hipDeviceAttributeMultiprocessorCount, dev);
        if (hipFuncSetAttribute((const void*)fwd_megakernel, hipFuncAttributeMaxDynamicSharedMemorySize, LDS_BYTES) != hipSuccess) { fprintf(stderr, "kernel_launch: hipFuncSetAttribute failed\n"); grid = -1; return; }
        if (hipOccupancyMaxActiveBlocksPerMultiprocessor(&per_cu, (const void*)fwd_megakernel, 512, LDS_BYTES) != hipSuccess || per_cu < 1) { fprintf(stderr, "kernel_launch: occupancy query says %d\n", per_cu); per_cu = 1; }
        (void)hipGetLastError();
        grid = cus;
    }
    if (grid < 0) return;
#ifndef PROBE_TWICE
#define PROBE_TWICE 0
#endif
    for (int rep_launch = 0; rep_launch <= PROBE_TWICE; ++rep_launch) {
    if (hipMemsetAsync((char*)d_ws + WS_BAR, 0, WS_BAR_BYTES, stream) != hipSuccess) { fprintf(stderr, "kernel_launch: memset failed\n"); return; }
    Args a{};
    for (int i = 0; i < 24; ++i) a.in[i] = (const float*)d_in[i];
    a.out = (float*)d_out; a.ws = (unsigned char*)d_ws;
#if MK_PER_PHASE
    for (int p = 0; p < N_PHASES; ++p) { a.ph_lo = p; a.ph_hi = p + 1; hipLaunchKernelGGL(fwd_megakernel, dim3(grid), dim3(512), LDS_BYTES, stream, a); }
#else
    a.ph_lo = 0; a.ph_hi = N_PHASES;
    void* kargs[] = {&a};
    hipError_t e = hipLaunchCooperativeKernel((const void*)fwd_megakernel, dim3(grid), dim3(512), kargs, LDS_BYTES, stream);
    if (e != hipSuccess) fprintf(stderr, "kernel_launch: cooperative launch failed: %s (grid %d)\n", hipGetErrorString(e), grid);
#endif
    }
}
```

```cpp
#include <hip/hip_runtime.h>
#include <hip/hip_cooperative_groups.h>
#include <hip/hip_bf16.h>
#include <cstdio>
#include <cstdint>
namespace cg = cooperative_groups;
namespace pg8 {
#define PG8_LAS __attribute__((address_space(3)))
typedef unsigned short bf16_t;
typedef short bf16x8 __attribute__((ext_vector_type(8)));
typedef float f32x4 __attribute__((ext_vector_type(4)));
typedef unsigned u32x4 __attribute__((ext_vector_type(4)));
constexpr int BM = 256, BK = 64, HALF = 128, HTB = HALF * BK * 2  , STAGE_BYTES = 8 * HTB, NXCD = 8, WGM = 8;

__host__ __device__ __forceinline__ int lds_byte(int r, int c) { const int st = (r >> 4) * 2 + (c >> 5), rr = r & 15, cc = c & 31, ob = rr * 64 + cc * 2; return st * 1024 + (ob ^ (((ob >> 9) & 1) << 5)); }
__host__ __device__ __forceinline__ void stage_rc(int b, int& R, int& C) { const int st = b / 1024, sb = b % 1024, swz = sb ^ (((sb >> 9) & 1) << 5); R = (st >> 1) * 16 + swz / 64; C = (st & 1) * 32 + (swz % 64) / 2; }
__host__ __device__ __forceinline__ int perm32(int rho) { const int n = rho >> 4, i = rho & 15; return 8 * (i >> 2) + 4 * n + (i & 3); }

struct Unit { int pm, pn, ko; };
struct Gemm { const bf16_t* A; const bf16_t* Bt; int M, N, K, nt; };

struct StaticOrder {
    int nM, nN, nwg, G, c;
    __host__ __device__ void init(int M, int N, int G_, int c_) { nM = M / BM; nN = N / BM; nwg = nM * nN; G = G_; c = c_; }
    __host__ __device__ bool next(int i, Unit& u) const {
        const long L = (long)i * G + c; if (L >= nwg) return false;
        int wgid = (int)L; { const int q = nwg / NXCD, r = nwg % NXCD, xcd = wgid % NXCD, off = wgid / NXCD; wgid = (xcd < r ? xcd * (q + 1) : r * (q + 1) + (xcd - r) * q) + off; }
        const int nig = WGM * nN, gid = wgid / nig, fm = gid * WGM, gsz = (nM - fm) < WGM ? (nM - fm) : WGM;
        u.pm = fm + ((wgid % nig) % gsz); u.pn = (wgid % nig) / gsz; u.ko = 0; return true;
    }
    __device__ __forceinline__ void a_ready(const Unit&) const {}
    __device__ __forceinline__ void done(const Unit&) const {}
};

__device__ __forceinline__ unsigned cvt_pk_bf16(float lo, float hi) { unsigned r; asm volatile("v_cvt_pk_bf16_f32 %0, %1, %2" : "=v"(r) : "v"(lo), "v"(hi)); return r; }
typedef float f32x2 __attribute__((ext_vector_type(2)));
#ifndef WT_STORES
#define WT_STORES 0
#endif
__device__ __forceinline__ void st16_wt(void* p, u32x4 v) {
#if WT_STORES
    asm volatile("global_store_dwordx4 %0, %1, off sc1\n\ts_nop 1" :: "v"(p), "v"(v) : "memory");
#else
    *(u32x4*)p = v;
#endif
}
template <int ACT  > struct EpiBf16 {
    static constexpr bool PERM = true, AFTER_DRAIN = false;
    bf16_t* O; int ldc;
    __device__ __forceinline__ void operator()(const f32x4 (&acc)[2][2][4][2], const Unit& u, int wr, int wc, int fr, int fq) const {
        const int row0 = u.pm * BM + wr * 64 + fr; const int col0 = u.pn * BM + wc * 32 + 8 * fq;
#pragma unroll
        for (int ai = 0; ai < 2; ++ai)
#pragma unroll
            for (int m = 0; m < 4; ++m) { bf16_t* rowp = O + (size_t)(row0 + ai * HALF + m * 16) * ldc + col0;
#pragma unroll
                for (int bj = 0; bj < 2; ++bj) { f32x4 v0 = acc[ai][bj][m][0], v1 = acc[ai][bj][m][1];
                    if (ACT == 2) {
#pragma unroll
                        for (int e = 0; e < 4; ++e) { float a = fmaxf(v0[e], 0.f), b = fmaxf(v1[e], 0.f); v0[e] = a * a; v1[e] = b * b; } }
                    u32x4 w; w.x = cvt_pk_bf16(v0[0], v0[1]); w.y = cvt_pk_bf16(v0[2], v0[3]); w.z = cvt_pk_bf16(v1[0], v1[1]); w.w = cvt_pk_bf16(v1[2], v1[3]);
                    st16_wt(rowp + bj * HALF, w); } }
    }
};
template <bool NORM> struct EpiResGate {
    static constexpr bool PERM = false, AFTER_DRAIN = false;
    const float* res_lat; const float* res_ctx; float* out; const float* gate; float alpha; const float* stat; const float* lg; const float* lb;
    __device__ __forceinline__ void operator()(const f32x4 (&acc)[2][2][4][2], const Unit& u, int wr, int wc, int fr, int fq) const {
        typedef float f32x2v __attribute__((ext_vector_type(2)));
        const int mrow = u.pm < 64 ? (u.pm >> 4) : 4;
        const float* g = gate + (size_t)mrow * 12288;
        const int col0 = u.pn * BM + wc * 32 + 4 * fq;
        f32x4 gv[2][2], gg[2][2], bb[2][2];
#pragma unroll
        for (int bj = 0; bj < 2; ++bj)
#pragma unroll
            for (int n = 0; n < 2; ++n) { gv[bj][n] = *(const f32x4*)(g + col0 + bj * HALF + n * 16);
                if (NORM) { gg[bj][n] = *(const f32x4*)(lg + col0 + bj * HALF + n * 16); bb[bj][n] = *(const f32x4*)(lb + col0 + bj * HALF + n * 16); } }
#pragma unroll
        for (int ai = 0; ai < 2; ++ai)
#pragma unroll
            for (int mp = 0; mp < 2; ++mp) {
                f32x4 r[2][2][2]; f32x2v st[2];
#pragma unroll
                for (int mm = 0; mm < 2; ++mm) { const int row = u.pm * BM + ai * HALF + wr * 64 + (mp * 2 + mm) * 16 + fr;
                    const float* rp = (row < 16384) ? res_lat + (size_t)row * 2048 : res_ctx + (size_t)(row - 16384) * 2048;
                    st[mm] = (f32x2v){0.f, 1.f}; if (NORM) st[mm] = *(const f32x2v*)(stat + 2 * (size_t)row);
#pragma unroll
                    for (int bj = 0; bj < 2; ++bj)
#pragma unroll
                        for (int n = 0; n < 2; ++n) r[mm][bj][n] = *(const f32x4*)(rp + col0 + bj * HALF + n * 16); }
#pragma unroll
                for (int mm = 0; mm < 2; ++mm) { const int m = mp * 2 + mm; const int row = u.pm * BM + ai * HALF + wr * 64 + m * 16 + fr;
                    float* op = out + (size_t)row * 2048;
#pragma unroll
                    for (int bj = 0; bj < 2; ++bj)
#pragma unroll
                        for (int n = 0; n < 2; ++n) { f32x4 x = r[mm][bj][n];
                            if (NORM) x = (x - st[mm].x) * st[mm].y * gg[bj][n] + bb[bj][n];
                            const f32x4 o = x * alpha + gv[bj][n] * acc[ai][bj][m][n]; st16_wt(op + col0 + bj * HALF + n * 16, __builtin_bit_cast(u32x4, o)); } }
                asm volatile("" ::: "memory");
            }
    }
};
struct OrderX {
    StaticOrder base; int xm0, xnm, xn0, xnn;
    __device__ void init(int M, int N, int G_, int c_, int xm0_, int xnm_, int xn0_, int xnn_) { base.init(M, N, G_, c_); xm0 = xm0_; xnm = xnm_; xn0 = xn0_; xnn = xnn_; }
    __device__ bool next(int i, Unit& u) const {
        long L = (long)i * base.G + base.c; if (L < base.nwg) return base.next(i, u);
        L -= base.nwg; if (L >= (long)xnm * xnn) return false;
        u.pm = xm0 + (int)(L % xnm); u.pn = xn0 + (int)(L / xnm); u.ko = 0; return true;
    }
    __device__ __forceinline__ void a_ready(const Unit&) const {}
    __device__ __forceinline__ void done(const Unit&) const {}
};
struct OrderSplit {
    int G, c, nsub, kbytes;
    __device__ void init(int G_, int c_, int ns, int nt) { G = G_; c = c_; nsub = 32 * ns; kbytes = nt * 128; }
    __device__ bool next(int i, Unit& u) const { const long L = (long)i * G + c; if (L >= nsub) return false; const int idx = (int)L; u.pm = 64 + (idx & 3); u.pn = (idx >> 2) & 7; u.ko = (idx >> 5) * kbytes; return true; }
    __device__ __forceinline__ void a_ready(const Unit&) const {}
    __device__ __forceinline__ void done(const Unit&) const {}
};
struct EpiPart {
    static constexpr bool PERM = false, AFTER_DRAIN = false;
    float* part; int kbytes;
    __device__ __forceinline__ void operator()(const f32x4 (&acc)[2][2][4][2], const Unit& u, int wr, int wc, int fr, int fq) const {
        const int ks = u.ko / kbytes; const int col0 = u.pn * BM + wc * 32 + 4 * fq;
        float* base = part + ((size_t)ks * 1024 + (size_t)(u.pm - 64) * BM) * 2048;
#pragma unroll
        for (int ai = 0; ai < 2; ++ai)
#pragma unroll
            for (int m = 0; m < 4; ++m) { float* op = base + (size_t)(ai * HALF + wr * 64 + m * 16 + fr) * 2048;
#pragma unroll
                for (int bj = 0; bj < 2; ++bj)
#pragma unroll
                    for (int n = 0; n < 2; ++n) st16_wt(op + col0 + bj * HALF + n * 16, __builtin_bit_cast(u32x4, acc[ai][bj][m][n])); }
    }
};
template <class Epi, class Sched, bool ALIGN_EPI = false, bool SP2 = false>
__device__ __forceinline__ void gemm_phase(PG8_LAS unsigned char* lds, const Gemm g, const Sched& S, const Epi& E) {
    const int tid = threadIdx.x, wid = __builtin_amdgcn_readfirstlane(tid >> 6), lane = tid & 63, wr = wid >> 2, wc = wid & 3, fr = lane & 15, fq = lane >> 4;
    const int K = g.K, nt = g.nt;
    unsigned voffA[2], voffB[2];
#pragma unroll
    for (int i = 0; i < 2; ++i) { int R, C; stage_rc(tid * 16 + i * 8192, R, C); const int Rb = Epi::PERM ? ((R & ~31) + perm32(R & 31)) : R;
        voffA[i] = (unsigned)(R * K + C) * 2u; voffB[i] = (unsigned)(Rb * K + C) * 2u; }
    const size_t kstep = (size_t)(BK * 2);
    const size_t hstep = (size_t)HALF * K * 2;
    const size_t tstep = 2 * hstep;
    const unsigned ldsw = (unsigned)wid * 1024u;
    const int aoff = lds_byte(wr * 64 + fr, fq * 8), boff = lds_byte(wc * 32 + fr, fq * 8);
#define PG8_SA(b, h) (((b) * 2 + (h)) * HTB)
#define PG8_SB(b, h) ((4 + (b) * 2 + (h)) * HTB)
#define PG8_STAGE(bufoff, gbase, voff) do { _Pragma("unroll") for (int _i = 0; _i < 2; ++_i) \
        __builtin_amdgcn_global_load_lds((const unsigned*)((const char*)(gbase) + (voff)[_i]), (PG8_LAS unsigned*)(lds + (bufoff) + ldsw + _i * 8192), 16, 0, 0); } while (0)
#define PG8_LDA(dst, b, h) do { _Pragma("unroll") for (int m = 0; m < 4; ++m) _Pragma("unroll") for (int k = 0; k < 2; ++k) dst[m][k] = *(const PG8_LAS bf16x8*)(lds + PG8_SA(b, h) + aoff + m * 2048 + k * 1024); } while (0)
#define PG8_LDB(dst, b, h) do { _Pragma("unroll") for (int n = 0; n < 2; ++n) _Pragma("unroll") for (int k = 0; k < 2; ++k) dst[n][k] = *(const PG8_LAS bf16x8*)(lds + PG8_SB(b, h) + boff + n * 2048 + k * 1024); } while (0)
#define PG8_MMA(ai, bj, At, Bt) do { __builtin_amdgcn_s_setprio(1); _Pragma("unroll") for (int m = 0; m < 4; ++m) _Pragma("unroll") for (int n = 0; n < 2; ++n) _Pragma("unroll") for (int k = 0; k < 2; ++k) \
        acc[ai][bj][m][n] = __builtin_amdgcn_mfma_f32_16x16x32_bf16(Bt[n][k], At[m][k], acc[ai][bj][m][n], 0, 0, 0); __builtin_amdgcn_s_setprio(0); } while (0)
#define PG8_WAIT_V(n) asm volatile("s_waitcnt vmcnt(" #n ")" ::: "memory")
#define PG8_WAIT_L(n) asm volatile("s_waitcnt lgkmcnt(" #n ")" ::: "memory")
#define PG8_BAR __builtin_amdgcn_s_barrier()
#define PG8_SCHED __builtin_amdgcn_sched_barrier(0)
    Unit cur, nxt; int ui = 0;
    if (!S.next(0, cur)) return;
    f32x4 acc[2][2][4][2];
#pragma unroll
    for (int a = 0; a < 2; ++a)
#pragma unroll
        for (int b = 0; b < 2; ++b)
#pragma unroll
            for (int m = 0; m < 4; ++m)
#pragma unroll
                for (int n = 0; n < 2; ++n) acc[a][b][m][n] = (f32x4){0.f, 0.f, 0.f, 0.f};
    bf16x8 At[4][2], B0[2][2], B1[2][2];
    const char* cA = (const char*)g.A + (size_t)cur.pm * tstep + cur.ko; const char* cB = (const char*)g.Bt + (size_t)cur.pn * tstep + cur.ko;
    S.a_ready(cur);
    if constexpr (SP2) {
        PG8_STAGE(PG8_SB(0, 0), cB, voffB); PG8_STAGE(PG8_SB(0, 1), cB + hstep, voffB); PG8_STAGE(PG8_SA(0, 0), cA, voffA); PG8_STAGE(PG8_SA(0, 1), cA + hstep, voffA);
        if (wr == 1) PG8_BAR;
        PG8_WAIT_V(2); PG8_BAR;
        PG8_STAGE(PG8_SB(1, 0), cB + kstep, voffB); PG8_STAGE(PG8_SA(1, 0), cA + kstep, voffA); PG8_STAGE(PG8_SB(1, 1), cB + hstep + kstep, voffB);
        PG8_WAIT_V(6); PG8_BAR;
    } else {
        PG8_STAGE(PG8_SB(0, 0), cB, voffB); PG8_STAGE(PG8_SA(0, 0), cA, voffA); PG8_STAGE(PG8_SB(0, 1), cB + hstep, voffB); PG8_STAGE(PG8_SA(0, 1), cA + hstep, voffA);
        if (wr == 1) PG8_BAR;
        PG8_WAIT_V(4); PG8_BAR;
        PG8_STAGE(PG8_SB(1, 0), cB + kstep, voffB); PG8_STAGE(PG8_SA(1, 0), cA + kstep, voffA); PG8_STAGE(PG8_SB(1, 1), cB + hstep + kstep, voffB);
        PG8_WAIT_V(6); PG8_BAR;
    }
    for (;;) {
        const bool has_next = S.next(ui + 1, nxt);
        const char* nA = has_next ? (const char*)g.A + (size_t)nxt.pm * tstep + nxt.ko : cA; const char* nB = has_next ? (const char*)g.Bt + (size_t)nxt.pn * tstep + nxt.ko : cB;
        for (int t = 0; t < nt; t += 2) {
            const bool last = (t == nt - 2);
            const char* a1 = cA + (size_t)(t + 1) * kstep;
            const char* a2 = last ? nA : cA + (size_t)(t + 2) * kstep; const char* b2 = last ? nB : cB + (size_t)(t + 2) * kstep;
            const char* a3 = a2 + kstep; const char* b3 = b2 + kstep;
            if (last && has_next) S.a_ready(nxt);
            if constexpr (SP2) {
            PG8_LDB(B0, 0, 0); PG8_LDB(B1, 0, 1); PG8_SCHED; PG8_LDA(At, 0, 0); PG8_STAGE(PG8_SA(1, 1), a1 + hstep, voffA);
            PG8_WAIT_V(8); PG8_WAIT_L(0); PG8_BAR; PG8_MMA(0, 0, At, B0); PG8_MMA(0, 1, At, B1); PG8_BAR; PG8_SCHED;
            PG8_LDA(At, 0, 1); PG8_STAGE(PG8_SB(0, 0), b2, voffB); PG8_STAGE(PG8_SB(0, 1), b2 + hstep, voffB); PG8_STAGE(PG8_SA(0, 0), a2, voffA);
            PG8_WAIT_V(8); PG8_WAIT_L(0); PG8_BAR; PG8_MMA(1, 0, At, B0); PG8_MMA(1, 1, At, B1); PG8_BAR; PG8_SCHED;
            PG8_LDB(B0, 1, 0); PG8_LDB(B1, 1, 1); PG8_SCHED; PG8_LDA(At, 1, 0); PG8_STAGE(PG8_SA(0, 1), a2 + hstep, voffA);
            PG8_WAIT_V(8); PG8_WAIT_L(0); PG8_BAR; PG8_MMA(0, 0, At, B0); PG8_MMA(0, 1, At, B1); PG8_BAR; PG8_SCHED;
            PG8_LDA(At, 1, 1); PG8_STAGE(PG8_SB(1, 0), b3, voffB); PG8_STAGE(PG8_SB(1, 1), b3 + hstep, voffB); PG8_STAGE(PG8_SA(1, 0), a3, voffA);
            PG8_WAIT_V(8); PG8_WAIT_L(0); PG8_BAR; PG8_MMA(1, 0, At, B0); PG8_MMA(1, 1, At, B1); PG8_BAR; PG8_SCHED;
            } else {
            PG8_LDB(B0, 0, 0); PG8_SCHED; PG8_LDA(At, 0, 0); PG8_STAGE(PG8_SA(1, 1), a1 + hstep, voffA);
            PG8_WAIT_L(8); PG8_BAR; PG8_WAIT_L(0); PG8_MMA(0, 0, At, B0); PG8_BAR; PG8_SCHED;
            PG8_LDB(B1, 0, 1); PG8_STAGE(PG8_SB(0, 0), b2, voffB);
            PG8_BAR; PG8_WAIT_L(0); PG8_MMA(0, 1, At, B1); PG8_BAR;
            PG8_LDA(At, 0, 1); PG8_STAGE(PG8_SA(0, 0), a2, voffA);
            PG8_BAR; PG8_WAIT_L(0); PG8_MMA(1, 0, At, B0); PG8_BAR; PG8_SCHED;
            PG8_STAGE(PG8_SB(0, 1), b2 + hstep, voffB);
            PG8_WAIT_V(6); PG8_BAR; PG8_MMA(1, 1, At, B1); PG8_BAR;
            PG8_LDB(B0, 1, 0); PG8_SCHED; PG8_LDA(At, 1, 0); PG8_STAGE(PG8_SA(0, 1), a2 + hstep, voffA);
            PG8_WAIT_L(8); PG8_BAR; PG8_WAIT_L(0); PG8_MMA(0, 0, At, B0); PG8_BAR; PG8_SCHED;
            PG8_LDB(B1, 1, 1); PG8_STAGE(PG8_SB(1, 0), b3, voffB);
            PG8_BAR; PG8_WAIT_L(0); PG8_MMA(0, 1, At, B1); PG8_BAR;
            PG8_LDA(At, 1, 1); PG8_STAGE(PG8_SA(1, 0), a3, voffA);
            PG8_BAR; PG8_WAIT_L(0); PG8_MMA(1, 0, At, B0); PG8_BAR; PG8_SCHED;
            PG8_STAGE(PG8_SB(1, 1), b3 + hstep, voffB);
            PG8_WAIT_V(6); PG8_BAR; PG8_MMA(1, 1, At, B1); PG8_BAR;
            }
        }
        if constexpr (ALIGN_EPI) { if (wr == 0) PG8_BAR; }
        if constexpr (!Epi::AFTER_DRAIN) { E(acc, cur, wr, wc, fr, fq); S.done(cur); }
        if (!has_next) break;
#pragma unroll
        for (int a = 0; a < 2; ++a)
#pragma unroll
            for (int b = 0; b < 2; ++b)
#pragma unroll
                for (int m = 0; m < 4; ++m)
#pragma unroll
                    for (int n = 0; n < 2; ++n) acc[a][b][m][n] = (f32x4){0.f, 0.f, 0.f, 0.f};
        cur = nxt; cA = nA; cB = nB; ++ui;
        if constexpr (ALIGN_EPI) { if (wr == 1) PG8_BAR; }
    }
    PG8_WAIT_V(0);
    if constexpr (!ALIGN_EPI) { if (wr == 0) PG8_BAR; }
    PG8_BAR;
    if constexpr (Epi::AFTER_DRAIN) { E.fused(acc, cur, wr, wc, fr, fq, lds, wid, lane); S.done(cur); }
#undef PG8_SA
#undef PG8_SB
#undef PG8_STAGE
#undef PG8_LDA
#undef PG8_LDB
#undef PG8_MMA
#undef PG8_WAIT_V
#undef PG8_WAIT_L
#undef PG8_BAR
#undef PG8_SCHED
}
}
namespace attn {
using bf16 = __hip_bfloat16;
constexpr int   D = 128, NW = 8, QBLK = 32, KVBLK = 64;
constexpr float SCALE = 0.088388347648318440f;
#ifndef ATTN_THR
#define ATTN_THR 8.f
#endif
constexpr float THR = ATTN_THR;
constexpr int SDEPTH = 2;
constexpr int LDQ = 1024, LDK = 128, LDO = 2048;
constexpr size_t SHM_V = KVBLK * D * 2, SHM_K = KVBLK * D * 2, SHM_ATTN = 2 * SHM_V + 2 * SHM_K + NW * 64 * 4;
__device__ __forceinline__ unsigned short f2bf16(float f) { unsigned u = __builtin_bit_cast(unsigned, f); return (unsigned short)((u + 0x7fffu + ((u >> 16) & 1u)) >> 16); }
using bf16x8 = __attribute__((ext_vector_type(8))) short;
using s16x4  = __attribute__((ext_vector_type(4))) short;
using f32x16 = __attribute__((ext_vector_type(16))) float;
using f32x8  = __attribute__((ext_vector_type(8))) float;
using u32x4  = __attribute__((ext_vector_type(4))) unsigned;
#define KSWZ(row, colB) ((row) * 256 + ((colB) ^ (((row) & 7) << 4)))
#define SBAR() __builtin_amdgcn_sched_barrier(0)
__device__ __forceinline__ int crow(int r, int hi) { return (r & 3) + 8 * (r >> 2) + 4 * hi; }
__device__ __forceinline__ unsigned cvtpk(float lo, float hi) {
  unsigned r; asm volatile("v_cvt_pk_bf16_f32 %0, %1, %2" : "=v"(r) : "v"(lo), "v"(hi)); return r;
}
template <typename TIn> struct Stage;
template <> struct Stage<bf16>  { using T = bf16x8;
  __device__ static __forceinline__ T ld8(const bf16* p) { return *reinterpret_cast<const bf16x8*>(p); }
  __device__ static __forceinline__ bf16x8 tobf(T x) { return x; } };
template <> struct Stage<float> { using T = f32x8;
  __device__ static __forceinline__ T ld8(const float* p) { return *reinterpret_cast<const f32x8*>(p); }
  __device__ static __forceinline__ bf16x8 tobf(T x) {
    u32x4 w = {cvtpk(x[0], x[1]), cvtpk(x[2], x[3]), cvtpk(x[4], x[5]), cvtpk(x[6], x[7])}; return *reinterpret_cast<bf16x8*>(&w); } };

__device__ __forceinline__ void partialSM(f32x16& p0, f32x16& p1, float& m_reg, float& mn, float& alpha) {
  constexpr float C = SCALE * 1.4426950408889634f;
  float pmax = p0[0]; for (int r = 1; r < 16; ++r) pmax = fmaxf(pmax, p0[r]); for (int r = 0; r < 16; ++r) pmax = fmaxf(pmax, p1[r]);
  { auto rr = __builtin_amdgcn_permlane32_swap(__float_as_uint(pmax), __float_as_uint(pmax), false, false);
    pmax = fmaxf(__uint_as_float(rr[0]), __uint_as_float(rr[1])); }
  if (__builtin_expect(__all(pmax - m_reg <= THR / SCALE), 1)) { mn = m_reg; alpha = 1.f; }
  else { mn = fmaxf(m_reg, pmax); alpha = __builtin_amdgcn_exp2f((m_reg - mn) * C); m_reg = mn; }
  float mnC = -mn * C;
  for (int r = 0; r < 16; ++r) p0[r] = fmaf(p0[r], C, mnC); for (int r = 0; r < 16; ++r) p1[r] = fmaf(p1[r], C, mnC);
  for (int r = 0; r < 16; ++r) p0[r] = __builtin_amdgcn_exp2f(p0[r]);
}
__device__ __forceinline__ void finishSM(f32x16& p0, f32x16& p1, float alpha, float& l_reg, bf16x8& pa0, bf16x8& pa1, bf16x8& pa2, bf16x8& pa3) {
  for (int r = 0; r < 16; ++r) p1[r] = __builtin_amdgcn_exp2f(p1[r]);
  float ps = 0; for (int r = 0; r < 16; ++r) ps += p0[r]; for (int r = 0; r < 16; ++r) ps += p1[r];
  { auto rr = __builtin_amdgcn_permlane32_swap(__float_as_uint(ps), __float_as_uint(ps), false, false);
    ps = __uint_as_float(rr[0]) + __uint_as_float(rr[1]); }
  l_reg = l_reg * alpha + ps;
#define PK4(P, BASE, OUT) do { unsigned a0 = cvtpk(P[BASE + 0], P[BASE + 1]), a1 = cvtpk(P[BASE + 2], P[BASE + 3]);   \
    unsigned b0 = cvtpk(P[BASE + 4], P[BASE + 5]), b1 = cvtpk(P[BASE + 6], P[BASE + 7]);                              \
    auto r0 = __builtin_amdgcn_permlane32_swap(a0, b0, false, false); auto r1 = __builtin_amdgcn_permlane32_swap(a1, b1, false, false); \
    u32x4 w = {r0[0], r1[0], r0[1], r1[1]}; OUT = *reinterpret_cast<bf16x8*>(&w); } while (0)
  PK4(p0, 0, pa0); PK4(p0, 8, pa1); PK4(p1, 0, pa2); PK4(p1, 8, pa3);
#undef PK4
}
__device__ __forceinline__ void qkt(f32x16& p0, f32x16& p1, const bf16* Ks, const bf16x8* qr, int r32, int hi) {
  p0 = f32x16{}; p1 = f32x16{};
  for (int d0 = 0; d0 < 8; ++d0) { int cb = (d0 * 16 + hi * 8) * 2;
    bf16x8 b0 = *reinterpret_cast<const bf16x8*>((const char*)Ks + KSWZ(r32, cb));
    bf16x8 b1 = *reinterpret_cast<const bf16x8*>((const char*)Ks + KSWZ(32 + r32, cb));
    p0 = __builtin_amdgcn_mfma_f32_32x32x16_bf16(b0, qr[d0], p0, 0, 0, 0);
    p1 = __builtin_amdgcn_mfma_f32_32x32x16_bf16(b1, qr[d0], p1, 0, 0, 0); }
}
__device__ __forceinline__ int v_st(int k, int c) { const int kk = (k & ~0xC) | ((k & 4) << 1) | ((k & 8) >> 1); return ((kk >> 3) * 4 + (c >> 5)) * 512 + ((kk & 7) * 32 + (c & 31)) * 2; }
__device__ __forceinline__ int v_rd_base(int lane) { return ((lane & 3) << 3) | (((lane >> 2) & 3) << 6) | (((lane >> 4) & 1) << 5) | (((lane >> 5) & 1) << 8); }
constexpr int v_rd_off(int d0, int ks, int half) { return d0 * 512 + ks * 4096 + half * 2048; }
template <int OFF> __device__ __forceinline__ s16x4 tr_read(int vb) {
  s16x4 r; asm volatile("ds_read_b64_tr_b16 %0, %1 offset:%2" : "=&v"(r) : "v"(vb), "i"(OFF) : "memory"); return r;
}
template <int D0> __device__ __forceinline__ void pv_one(f32x16& od, int vb, bf16x8 pa0, bf16x8 pa1, bf16x8 pa2, bf16x8 pa3) {
  const s16x4 l0 = tr_read<v_rd_off(D0, 0, 0)>(vb), h0 = tr_read<v_rd_off(D0, 0, 1)>(vb), l1 = tr_read<v_rd_off(D0, 1, 0)>(vb), h1 = tr_read<v_rd_off(D0, 1, 1)>(vb);
  const s16x4 l2 = tr_read<v_rd_off(D0, 2, 0)>(vb), h2 = tr_read<v_rd_off(D0, 2, 1)>(vb), l3 = tr_read<v_rd_off(D0, 3, 0)>(vb), h3 = tr_read<v_rd_off(D0, 3, 1)>(vb);
  asm volatile("s_waitcnt lgkmcnt(0)" ::: "memory"); SBAR();
#define PK(L, H) (bf16x8){L[0], L[1], L[2], L[3], H[0], H[1], H[2], H[3]}
  od = __builtin_amdgcn_mfma_f32_32x32x16_bf16(pa0, PK(l0, h0), od, 0, 0, 0);
  od = __builtin_amdgcn_mfma_f32_32x32x16_bf16(pa1, PK(l1, h1), od, 0, 0, 0);
  od = __builtin_amdgcn_mfma_f32_32x32x16_bf16(pa2, PK(l2, h2), od, 0, 0, 0);
  od = __builtin_amdgcn_mfma_f32_32x32x16_bf16(pa3, PK(l3, h3), od, 0, 0, 0);
#undef PK
}
__device__ __forceinline__ void pv_d0(f32x16* o, int vb, bf16x8 pa0, bf16x8 pa1, bf16x8 pa2, bf16x8 pa3) {
  pv_one<0>(o[0], vb, pa0, pa1, pa2, pa3); pv_one<1>(o[1], vb, pa0, pa1, pa2, pa3); pv_one<2>(o[2], vb, pa0, pa1, pa2, pa3); pv_one<3>(o[3], vb, pa0, pa1, pa2, pa3);
}
template <typename TQ>
__device__ __forceinline__ void attn_dense_body(const TQ* __restrict__ Qb, const bf16* __restrict__ Kh, const bf16* __restrict__ Vh,
                                                unsigned short* __restrict__ Ob, int seq, char* lds) {
  using St = Stage<bf16>; using SQ = Stage<TQ>;
  const int tid = threadIdx.x, wid = tid >> 6, lane = tid & 63, r32 = lane & 31, hi = lane >> 5;
  bf16* V_lds = (bf16*)lds; bf16* K_lds = (bf16*)(lds + 2 * SHM_V);
  float* ws = (float*)(lds + 2 * SHM_V + 2 * SHM_K) + wid * 64; float* li_l = ws; float* al_l = ws + 32;
  float m_reg = -1e30f, l_reg = 0; f32x16 o[4] = {}; bf16x8 qr[8];
  const TQ* Qw = Qb + (long)(wid * QBLK + r32) * LDQ + hi * 8;
#pragma unroll
  for (int d0 = 0; d0 < 8; ++d0) qr[d0] = SQ::tobf(SQ::ld8(Qw + d0 * 16));
  const int sr = tid >> 4, sc = (tid & 15) * 8, vst0 = v_st(sr, sc), vst1 = v_st(32 + sr, sc);
  const int vb0 = (int)(uintptr_t)V_lds + v_rd_base(lane);
  struct { typename St::T vs0, vs1, ks0, ks1; } sr_[SDEPTH];
#define SLOAD(i, k0) do { sr_[i].vs0 = St::ld8(&Vh[(long)((k0) + sr) * LDK + sc]); sr_[i].vs1 = St::ld8(&Vh[(long)((k0) + 32 + sr) * LDK + sc]); \
    sr_[i].ks0 = St::ld8(&Kh[(long)((k0) + sr) * LDK + sc]); sr_[i].ks1 = St::ld8(&Kh[(long)((k0) + 32 + sr) * LDK + sc]); } while (0)
#define SWRITE(b, i) do { *(bf16x8*)((char*)V_lds + (b) * SHM_V + vst0) = St::tobf(sr_[i].vs0);          \
    *(bf16x8*)((char*)V_lds + (b) * SHM_V + vst1) = St::tobf(sr_[i].vs1); int kc = sc * 2;               \
    *(bf16x8*)((char*)K_lds + (b) * SHM_K + KSWZ(sr, kc)) = St::tobf(sr_[i].ks0);                       \
    *(bf16x8*)((char*)K_lds + (b) * SHM_K + KSWZ(32 + sr, kc)) = St::tobf(sr_[i].ks1); } while (0)
#define SWAIT() do { if constexpr (SDEPTH == 2) asm volatile("s_waitcnt vmcnt(4)" ::: "memory"); else asm volatile("s_waitcnt vmcnt(0)" ::: "memory"); } while (0)
#define RESC(a) do { if (__any((a) < 1.f)) { if (hi == 0) al_l[r32] = (a); asm volatile("s_waitcnt lgkmcnt(0)" ::: "memory"); \
    for (int d = 0; d < 4; ++d) for (int r = 0; r < 16; ++r) o[d][r] *= al_l[crow(r, hi)]; } } while (0)
  f32x16 pA0, pA1, pB0, pB1; float mnA, mnB, alA, alB; bf16x8 pa0, pa1, pa2, pa3; const int NT = seq / KVBLK;
  constexpr int SE = 0, SO = SDEPTH - 1;
  SLOAD(SE, 0); asm volatile("s_waitcnt vmcnt(0)" ::: "memory"); SWRITE(0, SE); __syncthreads();
  qkt(pA0, pA1, K_lds, qr, r32, hi); partialSM(pA0, pA1, m_reg, mnA, alA);
  SLOAD(SO, KVBLK); if constexpr (SDEPTH == 2) { if (2 < NT) SLOAD(SE, 2 * KVBLK); }
  SWAIT(); SWRITE(1, SO); __syncthreads();
  for (int j = 1; j + 1 < NT; j += 2) {
    SBAR(); qkt(pB0, pB1, (bf16*)((char*)K_lds + SHM_K), qr, r32, hi);
    finishSM(pA0, pA1, alA, l_reg, pa0, pa1, pa2, pa3); SBAR();
    SLOAD(SO, (j + SDEPTH) * KVBLK); SBAR();
    pv_d0(o, vb0, pa0, pa1, pa2, pa3); partialSM(pB0, pB1, m_reg, mnB, alB);
    __syncthreads(); SWAIT(); SWRITE(0, SE);
    RESC(alB); __syncthreads();
    SBAR(); qkt(pA0, pA1, K_lds, qr, r32, hi);
    finishSM(pB0, pB1, alB, l_reg, pa0, pa1, pa2, pa3); SBAR();
    if (SDEPTH == 1 || j + 3 < NT) SLOAD(SE, (j + 1 + SDEPTH) * KVBLK); SBAR();
    pv_d0(o, vb0 + (int)SHM_V, pa0, pa1, pa2, pa3); partialSM(pA0, pA1, m_reg, mnA, alA);
    __syncthreads(); SWAIT(); SWRITE(1, SO);
    RESC(alA); __syncthreads();
  }
  SBAR(); qkt(pB0, pB1, (bf16*)((char*)K_lds + SHM_K), qr, r32, hi);
  finishSM(pA0, pA1, alA, l_reg, pa0, pa1, pa2, pa3); SBAR();
  pv_d0(o, vb0, pa0, pa1, pa2, pa3); partialSM(pB0, pB1, m_reg, mnB, alB);
  __syncthreads(); RESC(alB);
  finishSM(pB0, pB1, alB, l_reg, pa0, pa1, pa2, pa3); SBAR();
  pv_d0(o, vb0 + (int)SHM_V, pa0, pa1, pa2, pa3);
  if (hi == 0) li_l[r32] = l_reg; asm volatile("s_waitcnt lgkmcnt(0)" ::: "memory");
  float rli[16];
#pragma unroll
  for (int r = 0; r < 16; ++r) rli[r] = __builtin_amdgcn_rcpf(li_l[crow(r, hi)]);
  unsigned short* Ow = Ob + (long)(wid * QBLK) * LDO;
#pragma unroll
  for (int r = 0; r < 16; ++r) { int orow = crow(r, hi);
    for (int d0 = 0; d0 < 4; ++d0) Ow[(long)orow * LDO + d0 * 32 + r32] = f2bf16(o[d0][r] * rli[r]); }
#undef SLOAD
#undef SWRITE
#undef SWAIT
#undef RESC
}
}
#define GAS __attribute__((address_space(1)))
#define LAS __attribute__((address_space(3)))
typedef unsigned short bf16r;
typedef float f32x4 __attribute__((ext_vector_type(4)));
typedef unsigned u32x4 __attribute__((ext_vector_type(4)));
typedef unsigned u32x2 __attribute__((ext_vector_type(2)));
typedef short bf16x8 __attribute__((ext_vector_type(8)));

constexpr int DM = 2048, NB = 4, SEQ = 4096, CTX = 256, NLAT = NB * SEQ, NCTX = NB * CTX, NROW = NLAT + NCTX;
constexpr int INC = 3584, DFF = 8192, NMODC = 6 * DM, KVLEN = CTX + SEQ;
constexpr int NLAYER = 2;
constexpr float LN_EPS = 1e-6f, RMS_EPS = 1e-6f, DN_ALPHA = 1.4142135623730951f;
constexpr size_t MiB = 1u << 20;
constexpr size_t WS_ROPE = 0, WS_BAR = 768 * 1024, WS_BAR_BYTES = 16384, WS_STAT = 576 * 1024, WS_MOD = 64 * 1024, WS_WIN = 1 * MiB, WS_WOUT = 29 * MiB, WS_WFF1 = 45 * MiB, WS_WFF2 = 109 * MiB;
constexpr size_t WS_X = 173 * MiB, WS_H = 309 * MiB, WS_S = 377 * MiB;
constexpr size_t WS_P = WS_S, WS_Q = 496 * MiB, WS_K = 530 * MiB, WS_V = 539 * MiB, WS_MIX = 548 * MiB, WS_ACT = WS_S, WS_PART = 649 * MiB, WS_END = 713 * MiB;
static_assert(WS_WIN + 2ull * INC * DM * 2 <= WS_WOUT && WS_WOUT + 2ull * DM * DM * 2 <= WS_WFF1 && WS_WFF1 + 2ull * DFF * DM * 2 <= WS_WFF2 && WS_WFF2 + 2ull * DFF * DM * 2 <= WS_X, "ws weights");
static_assert(WS_X + (size_t)NROW * DM * 4 <= WS_H && WS_H + (size_t)NROW * DM * 2 <= WS_S && WS_P + (size_t)NROW * INC * 2 <= WS_Q && WS_Q + (size_t)NROW * 1024 * 2 <= WS_K, "ws act 1");
static_assert(WS_K + (size_t)NB * 2 * KVLEN * 128 * 2 <= WS_V && WS_V + (size_t)NB * 2 * KVLEN * 128 * 2 <= WS_MIX && WS_MIX + (size_t)NROW * DM * 2 <= WS_PART && WS_ACT + (size_t)NROW * DFF * 2 <= WS_PART && WS_PART + 8ull * NCTX * DM * 4 <= WS_END, "ws act 2");
static_assert(WS_MOD + 2ull * 5 * NMODC * 4 <= WS_STAT && WS_STAT + (size_t)NROW * 8 <= WS_BAR && WS_BAR + WS_BAR_BYTES <= WS_WIN, "ws mod");
constexpr int LDS_BYTES = 147456;

__device__ __forceinline__ unsigned f2bf(float f) { unsigned u = __builtin_bit_cast(unsigned, f); return (u + 0x7fffu + ((u >> 16) & 1u)) >> 16; }
__device__ __forceinline__ unsigned pk2(float lo, float hi) { return f2bf(lo) | (f2bf(hi) << 16); }
__device__ __forceinline__ float bflo(unsigned w) { return __builtin_bit_cast(float, w << 16); }
__device__ __forceinline__ float bfhi(unsigned w) { return __builtin_bit_cast(float, w & 0xffff0000u); }
__device__ __forceinline__ void unpack8(const u32x4 w, float (&x)[8]) { x[0] = bflo(w.x); x[1] = bfhi(w.x); x[2] = bflo(w.y); x[3] = bfhi(w.y); x[4] = bflo(w.z); x[5] = bfhi(w.z); x[6] = bflo(w.w); x[7] = bfhi(w.w); }
__device__ __forceinline__ u32x4 pack8(const float (&x)[8]) { u32x4 w; w.x = pk2(x[0], x[1]); w.y = pk2(x[2], x[3]); w.z = pk2(x[4], x[5]); w.w = pk2(x[6], x[7]); return w; }
__device__ __forceinline__ float wave_sum(float v) {
#pragma unroll
    for (int o = 1; o < 64; o <<= 1) v += __shfl_xor(v, o);
    return v;
}
__device__ __forceinline__ float gelu_tanh(float x) {
    const float u = 0.7978845608028654f * (x + 0.044715f * x * x * x);
    const float e = __expf(2.f * u);
    const float t = 1.f - 2.f * __builtin_amdgcn_rcpf(e + 1.f);
    return 0.5f * x * (1.f + t);
}
__device__ __forceinline__ float sigmoidf_(float x) { return __builtin_amdgcn_rcpf(1.f + __expf(-x)); }
#define LDS_WAIT() asm volatile("s_waitcnt lgkmcnt(0)" ::: "memory")

static __device__ const double ROPE_FREQ[32] = {1.0, 0.7498942093324559, 0.5623413251903491, 0.4216965034285822, 0.31622776601683794, 0.23713737056616552, 0.1778279410038923, 0.1333521432163324, 0.1, 0.07498942093324558, 0.05623413251903491, 0.042169650342858224, 0.03162277660168379, 0.023713737056616554, 0.01778279410038923, 0.01333521432163324, 0.01, 0.007498942093324558, 0.005623413251903491, 0.004216965034285823, 0.0031622776601683794, 0.0023713737056616554, 0.0017782794100389228, 0.001333521432163324, 0.001, 0.0007498942093324559, 0.0005623413251903491, 0.00042169650342858224, 0.00031622776601683794, 0.00023713737056616554, 0.00017782794100389227, 0.0001333521432163324};

__device__ __forceinline__ void p0_rope(float* rope, int gtid, int gthreads) {
    for (int idx = gtid; idx < 64 * 32; idx += gthreads) {
        const int p = idx >> 5, f = idx & 31;
        const double ang = (double)p * ROPE_FREQ[f];
        const double k = __builtin_rint(ang * 0.15915494309189535);
        const double r = ang - k * 6.283185307179586;
        const double r2 = r * r; double tc = 1.0, ts = 1.0, cc = 1.0, ss = 1.0;
#pragma unroll
        for (int n = 1; n <= 14; ++n) { tc *= -r2 * (1.0 / (double)((2 * n - 1) * (2 * n))); cc += tc; ts *= -r2 * (1.0 / (double)((2 * n) * (2 * n + 1))); ss += ts; }
        rope[2 * idx] = (float)cc; rope[2 * idx + 1] = (float)(r * ss);
    }
}
__device__ __forceinline__ void p0_mod(LAS unsigned char* lds, const float* c, const float* c_ctx, const float* w_mod, const float* b_mod, float* MOD, int bid, int G, int tid) {
    constexpr int NITEM = NLAYER * (NMODC / 128);
    if (bid >= NITEM) return;
    LAS float* condS = (LAS float*)lds;
    LAS float* red = (LAS float*)(lds + 5 * 2048 * 4);
    for (int i = tid; i < 5 * 2048; i += 512) { const int r = i >> 11, k = i & 2047; const float cv = (r < 4) ? c[r * 2048 + k] : c_ctx[k]; condS[i] = cv / (1.f + __expf(-cv)); }
    __syncthreads();
    const int kr = tid >> 5, cl = tid & 31;
    for (int item = bid; item < NITEM; item += G) {
        const int l = item / (NMODC / 128), n0 = (item % (NMODC / 128)) * 128;
        const float* wp = w_mod + ((size_t)l * 2048 + kr) * NMODC + n0 + 4 * cl;
        float acc[5][4];
#pragma unroll
        for (int r = 0; r < 5; ++r)
#pragma unroll
            for (int j = 0; j < 4; ++j) acc[r][j] = 0.f;
#pragma unroll 4
        for (int ks = 0; ks < 128; ++ks) {
            const f32x4 w = *(const f32x4*)(wp + (size_t)ks * 16 * NMODC); const int k = ks * 16 + kr;
#pragma unroll
            for (int r = 0; r < 5; ++r) { const float s = condS[r * 2048 + k];
#pragma unroll
                for (int j = 0; j < 4; ++j) acc[r][j] += s * w[j]; }
        }
#pragma unroll
        for (int r = 0; r < 5; ++r)
#pragma unroll
            for (int j = 0; j < 4; ++j) red[(kr * 32 + cl) * 20 + r * 4 + j] = acc[r][j];
        __syncthreads();
        for (int o = tid; o < 5 * 128; o += 512) { const int r = o >> 7, col = o & 127; float s = 0.f;
#pragma unroll
            for (int k2 = 0; k2 < 16; ++k2) s += red[(k2 * 32 + (col >> 2)) * 20 + r * 4 + (col & 3)];
            MOD[((size_t)l * 5 + r) * NMODC + n0 + col] = s + b_mod[(size_t)l * NMODC + n0 + col]; }
        __syncthreads();
    }
}
__device__ __forceinline__ void p0_transpose_item(const float* W, int K, int N, bf16r* WT, LAS float* scr, int item, int lane) {
    const int nblk = N / 64, kb = item / nblk, nb = item % nblk, k0 = 64 * kb, n0 = 64 * nb;
    const int r4 = lane >> 4, c4 = (lane & 15) * 4;
    f32x4 v[16];
#pragma unroll
    for (int i = 0; i < 16; ++i) v[i] = *(const f32x4*)(W + (size_t)(k0 + 4 * i + r4) * N + n0 + c4);
#pragma unroll
    for (int i = 0; i < 16; ++i) { LAS float* d = scr + (4 * i + r4) * 65 + c4; d[0] = v[i].x; d[1] = v[i].y; d[2] = v[i].z; d[3] = v[i].w; }
    LDS_WAIT(); asm volatile("" ::: "memory");
    const int c = lane & 7;
#pragma unroll
    for (int j = 0; j < 8; ++j) { const int n = (lane >> 3) + 8 * j; const LAS float* s = scr + (8 * c) * 65 + n;
        u32x4 o; o.x = pk2(s[0 * 65], s[1 * 65]); o.y = pk2(s[2 * 65], s[3 * 65]); o.z = pk2(s[4 * 65], s[5 * 65]); o.w = pk2(s[6 * 65], s[7 * 65]);
        *(u32x4*)(WT + (size_t)(n0 + n) * K + k0 + 8 * c) = o; }
    LDS_WAIT(); asm volatile("" ::: "memory");
}

__device__ __forceinline__ void row_stats(const f32x4 (&v)[8], float& mean, float& rstd) {
    float s = 0.f;
#pragma unroll
    for (int j = 0; j < 8; ++j) s += (v[j].x + v[j].y) + (v[j].z + v[j].w);
    mean = wave_sum(s) * (1.f / DM); float q = 0.f;
#pragma unroll
    for (int j = 0; j < 8; ++j) { const f32x4 d = v[j] - mean; q += (d.x * d.x + d.y * d.y) + (d.z * d.z + d.w * d.w); }
    rstd = 1.f / sqrtf(wave_sum(q) * (1.f / DM) + LN_EPS);
}
__device__ __forceinline__ void row_pass(const float* src_lat, const float* src_ctx, int nrows, const float* lng, const float* lnb, float* dst_lat, float* dst_ctx, float* stat,
                                         const float* modl  , int shift_off, int scale_off, bf16r* H, int gw, int NGW, int lane) {
    f32x4 v[8], vn[8];
    if (gw < nrows) { const float* sp = gw < NLAT ? src_lat + (size_t)gw * DM : src_ctx + (size_t)(gw - NLAT) * DM;
#pragma unroll
        for (int j = 0; j < 8; ++j) v[j] = *((const f32x4*)sp + 64 * j + lane); }
    for (int row = gw; row < nrows; row += NGW) {
        const bool lat = row < NLAT;
        const int rown = row + NGW;
        if (rown < nrows) { const float* sp = rown < NLAT ? src_lat + (size_t)rown * DM : src_ctx + (size_t)(rown - NLAT) * DM;
#pragma unroll
            for (int j = 0; j < 8; ++j) vn[j] = *((const f32x4*)sp + 64 * j + lane); }
        float mean, rstd;
        if (lng) {
            row_stats(v, mean, rstd);
            if (stat && lane == 0) { stat[2 * (size_t)row] = mean; stat[2 * (size_t)row + 1] = rstd; }
            float* dp = lat ? (dst_lat ? dst_lat + (size_t)row * DM : nullptr) : (dst_ctx ? dst_ctx + (size_t)(row - NLAT) * DM : nullptr);
#pragma unroll
            for (int j = 0; j < 8; ++j) { const f32x4 g = *((const f32x4*)lng + 64 * j + lane), b = *((const f32x4*)lnb + 64 * j + lane);
                v[j] = (v[j] - mean) * rstd * g + b; if (dp) *((f32x4*)dp + 64 * j + lane) = v[j]; }
        }
        if (modl) {
            row_stats(v, mean, rstd);
            const float* mr = modl + (size_t)(lat ? (row >> 12) : 4) * NMODC;
            bf16r* hp = H + (size_t)row * DM;
#pragma unroll
            for (int j = 0; j < 8; ++j) { const f32x4 sh = *((const f32x4*)(mr + shift_off) + 64 * j + lane), sc = *((const f32x4*)(mr + scale_off) + 64 * j + lane);
                const f32x4 o = (v[j] - mean) * rstd * (sc + 1.f) + sh; u32x2 w; w.x = pk2(o.x, o.y); w.y = pk2(o.z, o.w);
                *((u32x2*)hp + 64 * j + lane) = w; }
        }
#pragma unroll
        for (int j = 0; j < 8; ++j) v[j] = vn[j];
    }
}
__device__ __forceinline__ void row_pass_ctx(const float* src, const float* bstat, const float* bg, const float* bb, const float* part, const float* gate  , float* xdst,
                                             const float* lng, const float* lnb, float* stat, const float* modl, int shift_off, int scale_off, bf16r* H, int gw, int NGW, int lane) {
    for (int r = gw; r < NCTX; r += NGW) {
        const int row = NLAT + r;
        f32x4 v[8];
        float bm = 0.f, brs = 1.f; if (bstat) { bm = bstat[2 * (size_t)row]; brs = bstat[2 * (size_t)row + 1]; }
#pragma unroll
        for (int j = 0; j < 8; ++j) { f32x4 x = *((const f32x4*)(src + (size_t)r * DM) + 64 * j + lane);
            if (bstat) x = (x - bm) * brs * *((const f32x4*)bg + 64 * j + lane) + *((const f32x4*)bb + 64 * j + lane);
            f32x4 s = *((const f32x4*)(part + (size_t)r * DM) + 64 * j + lane);
#pragma unroll
            for (int k = 1; k < 8; ++k) s += *((const f32x4*)(part + ((size_t)k * NCTX + r) * DM) + 64 * j + lane);
            v[j] = x * DN_ALPHA + *((const f32x4*)gate + 64 * j + lane) * s;
            if (xdst) *((f32x4*)(xdst + (size_t)r * DM) + 64 * j + lane) = v[j]; }
        float mean, rstd;
        row_stats(v, mean, rstd);
        if (lane == 0) { stat[2 * (size_t)row] = mean; stat[2 * (size_t)row + 1] = rstd; }
#pragma unroll
        for (int j = 0; j < 8; ++j) v[j] = (v[j] - mean) * rstd * *((const f32x4*)lng + 64 * j + lane) + *((const f32x4*)lnb + 64 * j + lane);
        row_stats(v, mean, rstd);
        const float* mr = modl + (size_t)4 * NMODC;
        bf16r* hp = H + (size_t)row * DM;
#pragma unroll
        for (int j = 0; j < 8; ++j) { const f32x4 sh = *((const f32x4*)(mr + shift_off) + 64 * j + lane), sc = *((const f32x4*)(mr + scale_off) + 64 * j + lane);
            const f32x4 o = (v[j] - mean) * rstd * (sc + 1.f) + sh; u32x2 w; w.x = pk2(o.x, o.y); w.y = pk2(o.z, o.w);
            *((u32x2*)hp + 64 * j + lane) = w; }
    }
}

__device__ __forceinline__ void rms_rope_apply(const u32x4 w1, const u32x4 w2, const float (&g1)[8], const float (&g2)[8], const f32x4 (&rp)[4], bool rope_on, u32x4& o1w, u32x4& o2w) {
    float x1[8], x2[8]; unpack8(w1, x1); unpack8(w2, x2);
    float ss = 0.f;
#pragma unroll
    for (int j = 0; j < 8; ++j) ss += x1[j] * x1[j] + x2[j] * x2[j];
    ss += __shfl_xor(ss, 1); ss += __shfl_xor(ss, 2); ss += __shfl_xor(ss, 4);
    const float rn = 1.f / sqrtf(ss * (1.f / 128.f) + RMS_EPS);
    float o1[8], o2[8];
#pragma unroll
    for (int j = 0; j < 8; ++j) { const float y1 = x1[j] * rn * g1[j], y2 = x2[j] * rn * g2[j];
        float c = 1.f, s = 0.f; if (rope_on) { c = rp[j >> 1][(j & 1) * 2]; s = rp[j >> 1][(j & 1) * 2 + 1]; }
        o1[j] = y1 * c - y2 * s; o2[j] = y1 * s + y2 * c; }
    o1w = pack8(o1); o2w = pack8(o2);
}
__device__ __forceinline__ void prep_qkv(const bf16r* __restrict__ P, bf16r* __restrict__ Qb, bf16r* __restrict__ Kb, bf16r* __restrict__ Vb, const float* __restrict__ qg, const float* __restrict__ kg,
                                         const float* __restrict__ rope, int nrows, bool ctx_q, int gw, int NGW, int lane) {
    const int i = lane & 7, a = i >> 2, f0 = (i & 3) * 8, head = lane >> 3, kvh = (lane & 15) >> 3, vj = lane & 31;
    float gq1[8], gq2[8], gk1[8], gk2[8];
#pragma unroll
    for (int j = 0; j < 8; ++j) { gq1[j] = qg[a * 64 + f0 + j]; gq2[j] = qg[a * 64 + 32 + f0 + j]; gk1[j] = kg[a * 64 + f0 + j]; gk2[j] = kg[a * 64 + 32 + f0 + j]; }
    for (int row0 = gw * 2; row0 < nrows; row0 += NGW * 2) {
        u32x4 q1[2], q2[2], k1[2], k2[2], vv[2]; f32x4 rp[2][4];
#pragma unroll
        for (int r = 0; r < 2; ++r) { const int row = row0 + r; const bf16r* prow = P + (size_t)row * INC;
            const bool lat = row < NLAT; const int t = lat ? (row & 4095) : ((row - NLAT) & 255);
            const bf16r* qs = prow + 2048 + head * 128 + a * 64 + f0; const bf16r* ks = prow + 3072 + kvh * 128 + a * 64 + f0;
            q1[r] = *(const u32x4*)qs; q2[r] = *(const u32x4*)(qs + 32); k1[r] = *(const u32x4*)ks; k2[r] = *(const u32x4*)(ks + 32); vv[r] = *(const u32x4*)(prow + 3328 + vj * 8);
            const int pos = (a == 0) ? (t >> 6) : (t & 63); const float* rpp = rope + (size_t)(pos * 32 + f0) * 2;
#pragma unroll
            for (int jj = 0; jj < 4; ++jj) rp[r][jj] = *(const f32x4*)(rpp + 4 * jj); }
#pragma unroll
        for (int r = 0; r < 2; ++r) { const int row = row0 + r;
            const bool lat = row < NLAT; const int b = lat ? (row >> 12) : ((row - NLAT) >> 8), t = lat ? (row & 4095) : ((row - NLAT) & 255);
            const int posk = lat ? CTX + t : t;
            u32x4 o1, o2;
            rms_rope_apply(q1[r], q2[r], gq1, gq2, rp[r], lat, o1, o2);
            if (lat || ctx_q) { bf16r* dst = Qb + (size_t)row * 1024 + head * 128 + a * 64 + f0; *(u32x4*)dst = o1; *(u32x4*)(dst + 32) = o2; }
            rms_rope_apply(k1[r], k2[r], gk1, gk2, rp[r], lat, o1, o2);
            if (lane < 16) { bf16r* dst = Kb + ((size_t)(b * 2 + kvh) * KVLEN + posk) * 128 + a * 64 + f0; *(u32x4*)dst = o1; *(u32x4*)(dst + 32) = o2; }
            if (lane < 32) *(u32x4*)(Vb + ((size_t)(b * 2 + (vj >> 4)) * KVLEN + posk) * 128 + (vj & 15) * 8) = vv[r]; }
    }
}

__device__ __forceinline__ void gmlp_ldw(const float* __restrict__ Wh, int wave, int lane, f32x4 (&w)[8]) {
    const float* p = Wh + (size_t)(16 * wave + (lane & 15)) * 128 + 8 * (lane >> 4);
#pragma unroll
    for (int ks = 0; ks < 4; ++ks) { w[2 * ks] = *(const f32x4*)(p + ks * 32); w[2 * ks + 1] = *(const f32x4*)(p + ks * 32 + 4); }
}
__device__ __forceinline__ void gmlp_item(LAS unsigned char* lds, const bf16r* __restrict__ P, bf16r* __restrict__ MIX, const float* __restrict__ lng, const float* __restrict__ lnb,
                                          const float* __restrict__ Ws  , const float* __restrict__ bs  , int ch, int tid, int wave, int lane) {
    constexpr int LDT = 136;
    LAS bf16r* vT = (LAS bf16r*)lds;
    const int r0 = ch * 128;
    f32x4 wreg[8]; gmlp_ldw(Ws, wave, lane, wreg);
    { float gl[8], bl[8];
#pragma unroll
      for (int j = 0; j < 8; ++j) { gl[j] = lng[lane * 8 + j]; bl[j] = lnb[lane * 8 + j]; }
#pragma unroll
      for (int hb = 0; hb < 2; ++hb) {
        u32x4 raw[8];
#pragma unroll
        for (int i = 0; i < 8; ++i) raw[i] = *(const u32x4*)(P + (size_t)(r0 + wave + 8 * (hb * 8 + i)) * INC + 512 + lane * 8);
#pragma unroll
        for (int i = 0; i < 8; ++i) { const int q = wave + 8 * (hb * 8 + i);
            float x[8]; unpack8(raw[i], x);
            float s = 0.f;
#pragma unroll
            for (int j = 0; j < 8; ++j) { x[j] = gelu_tanh(x[j]); s += x[j]; }
            const float mean = wave_sum(s) * (1.f / 512.f); float qq = 0.f;
#pragma unroll
            for (int j = 0; j < 8; ++j) { const float d = x[j] - mean; qq += d * d; }
            const float rstd = __builtin_amdgcn_rsqf(wave_sum(qq) * (1.f / 512.f) + LN_EPS);
#pragma unroll
            for (int j = 0; j < 8; ++j) { const float v = (x[j] - mean) * rstd * gl[j] + bl[j]; vT[(lane * 8 + j) * LDT + (((q >> 3) ^ (lane & 15)) << 3) + (q & 7)] = (bf16r)f2bf(v); } }
      } }
    __syncthreads();
    const int p = 16 * wave + (lane & 15); const size_t row = (size_t)(r0 + p);
#pragma unroll 1
    for (int h = 0; h < 4; ++h) {
        bf16x8 bfr[4];
#pragma unroll
        for (int ks = 0; ks < 4; ++ks) { u32x4 t; t.x = pk2(wreg[2 * ks].x, wreg[2 * ks].y); t.y = pk2(wreg[2 * ks].z, wreg[2 * ks].w); t.z = pk2(wreg[2 * ks + 1].x, wreg[2 * ks + 1].y); t.w = pk2(wreg[2 * ks + 1].z, wreg[2 * ks + 1].w);
            bfr[ks] = __builtin_bit_cast(bf16x8, t); }
        if (h < 3) gmlp_ldw(Ws + (size_t)(h + 1) * 128 * 128, wave, lane, wreg);
        const float bsv = bs[h * 128 + p];
        u32x2 uw[8];
#pragma unroll
        for (int dt = 0; dt < 8; ++dt) uw[dt] = *(const u32x2*)(P + row * INC + h * 128 + 16 * dt + 4 * (lane >> 4));
#pragma unroll
        for (int dt = 0; dt < 8; ++dt) {
            pg8::f32x4 acc = {0.f, 0.f, 0.f, 0.f};
#pragma unroll
            for (int ks = 0; ks < 4; ++ks) { const int c = h * 128 + 16 * dt + (lane & 15); const bf16x8 af = *(const LAS bf16x8*)(vT + c * LDT + (((ks * 4 + (lane >> 4)) ^ ((c >> 3) & 15)) << 3));
                acc = __builtin_amdgcn_mfma_f32_16x16x32_bf16(af, bfr[ks], acc, 0, 0, 0); }
            const float u0 = gelu_tanh(bflo(uw[dt].x)), u1 = gelu_tanh(bfhi(uw[dt].x)), u2 = gelu_tanh(bflo(uw[dt].y)), u3 = gelu_tanh(bfhi(uw[dt].y));
            u32x2 o; o.x = pk2(u0 * (acc[0] + bsv), u1 * (acc[1] + bsv)); o.y = pk2(u2 * (acc[2] + bsv), u3 * (acc[3] + bsv));
            *(u32x2*)(MIX + row * DM + h * 128 + 16 * dt + 4 * (lane >> 4)) = o;
        }
    }
    __syncthreads();
}

__device__ __forceinline__ void conv_item(LAS unsigned char* lds, const bf16r* __restrict__ P, bf16r* __restrict__ MIX, const float* __restrict__ wdw  , const float* __restrict__ bdw,
                                          const float* __restrict__ lng, const float* __restrict__ lnb, int item, int tid, int wave, int lane) {
    LAS float* z = (LAS float*)lds;
    const int row0 = item * 32;
    const int seq0 = row0 < NLAT ? (row0 & ~4095) : (NLAT + ((row0 - NLAT) & ~255)), seq1 = seq0 + (row0 < NLAT ? SEQ : CTX);
    float acc[32]; float w[31];
    { const float bv = bdw[tid];
#pragma unroll
      for (int t = 0; t < 32; ++t) acc[t] = bv;
#pragma unroll
      for (int j = 0; j < 31; ++j) w[j] = wdw[j * 512 + tid]; }
    { u32x4 ra[8], rb[8];
#pragma unroll
      for (int i = 0; i < 8; ++i) { const int rr = wave + 8 * i; int g = row0 - 15 + rr; const bool ok = rr < 62 && g >= seq0 && g < seq1; if (!ok) g = row0;
          ra[i] = *(const u32x4*)(P + (size_t)g * INC + 1024 + lane * 8); rb[i] = *(const u32x4*)(P + (size_t)g * INC + 1536 + lane * 8); }
#pragma unroll
      for (int i = 0; i < 8; ++i) { const int rr = wave + 8 * i; const int g = row0 - 15 + rr; const bool ok = g >= seq0 && g < seq1;
          if (rr < 62) { float a[8], b[8], zv[8]; unpack8(ra[i], a); unpack8(rb[i], b);
#pragma unroll
              for (int j = 0; j < 8; ++j) zv[j] = ok ? a[j] * sigmoidf_(b[j]) : 0.f;
              *(LAS f32x4*)(z + rr * 512 + lane * 8) = (f32x4){zv[0], zv[1], zv[2], zv[3]}; *(LAS f32x4*)(z + rr * 512 + lane * 8 + 4) = (f32x4){zv[4], zv[5], zv[6], zv[7]}; } } }
    __syncthreads();
#pragma unroll
    for (int rr = 0; rr < 62; ++rr) { const float zv = z[rr * 512 + tid];
#pragma unroll
        for (int t = 0; t < 32; ++t) { if (rr - t >= 0 && rr - t <= 30) acc[t] += w[rr - t] * zv; } }
    __syncthreads();
#pragma unroll
    for (int t = 0; t < 32; ++t) z[t * 512 + tid] = acc[t];
    __syncthreads();
    float gl[8], bl[8];
#pragma unroll
    for (int j = 0; j < 8; ++j) { gl[j] = lng[lane * 8 + j]; bl[j] = lnb[lane * 8 + j]; }
#pragma unroll
    for (int i = 0; i < 4; ++i) { const int t = wave * 4 + i;
        const f32x4 y0 = *(const LAS f32x4*)(z + t * 512 + lane * 8), y1 = *(const LAS f32x4*)(z + t * 512 + lane * 8 + 4);
        float x[8] = {y0.x, y0.y, y0.z, y0.w, y1.x, y1.y, y1.z, y1.w};
        float s = 0.f;
#pragma unroll
        for (int j = 0; j < 8; ++j) s += x[j];
        const float mean = wave_sum(s) * (1.f / 512.f); float qq = 0.f;
#pragma unroll
        for (int j = 0; j < 8; ++j) { const float d = x[j] - mean; qq += d * d; }
        const float rstd = __builtin_amdgcn_rsqf(wave_sum(qq) * (1.f / 512.f) + LN_EPS);
        float o[8];
#pragma unroll
        for (int j = 0; j < 8; ++j) { const float v = (x[j] - mean) * rstd * gl[j] + bl[j]; o[j] = v * sigmoidf_(v); }
        *(u32x4*)(MIX + (size_t)(row0 + t) * DM + 512 + lane * 8) = pack8(o);
    }
    __syncthreads();
}

#define XB_TMO      128
#define XB_XCNT(j)  (256  + 64 * (j))
#define XB_XSUB(j)  (1280 + 64 * (j))
#define XB_XGEN(j)  (2304 + 64 * (j))
#define XB_TOP      3328
#define XB_TOPGEN   3392
#define XCD_BAR_WORDS 3456
#define XB_SPIN_CAP (1u << 18)

__device__ __forceinline__ unsigned xb_ld(unsigned* p)              { return __hip_atomic_load(p, __ATOMIC_RELAXED, __HIP_MEMORY_SCOPE_AGENT); }
__device__ __forceinline__ unsigned xb_add(unsigned* p, unsigned v) { return __hip_atomic_fetch_add(p, v, __ATOMIC_RELAXED, __HIP_MEMORY_SCOPE_AGENT); }
__device__ __forceinline__ unsigned xb_xcc_id() { return (unsigned)__builtin_amdgcn_s_getreg((3 << 11) | 20) & 0xFu; }
#define XB_SPIN(cond, bar) do { unsigned _sp = 0; while (cond) { __builtin_amdgcn_s_sleep(1); \
    if ((++_sp & 255u) == 0u) { if (xb_ld(&(bar)[XB_TMO])) break; if (_sp > XB_SPIN_CAP) { atomicAdd(&(bar)[XB_TMO], 1u); break; } } } } while (0)

struct XcdBarrier {
    unsigned* bar; unsigned x;
    volatile LAS unsigned* st;
};

__device__ __forceinline__ XcdBarrier xcd_barrier_post(unsigned* bar, volatile LAS unsigned* st) {
    XcdBarrier b; b.bar = bar; b.x = xb_xcc_id(); b.st = st;
    if (threadIdx.x == 0) (void)xb_add(&bar[XB_XCNT(b.x)], 1u);
    return b;
}
__device__ __forceinline__ void xcd_barrier_complete(unsigned* bar, unsigned x, unsigned& nloc, unsigned& nx) {
    const unsigned G = gridDim.x * gridDim.y * gridDim.z;
    unsigned sum, cnt, mine, sp = 0u;
    for (;;) {
        sum = 0u; cnt = 0u; mine = 0u;
#pragma unroll
        for (unsigned j = 0; j < 16; ++j) { const unsigned c = xb_ld(&bar[XB_XCNT(j)]); sum += c; cnt += (c > 0u) ? 1u : 0u; mine = (j == x) ? c : mine; }
        if (sum == G) break;
        __builtin_amdgcn_s_sleep(1);
        if ((++sp & 255u) == 0u) { if (xb_ld(&bar[XB_TMO])) break; if (sp > XB_SPIN_CAP) { atomicAdd(&bar[XB_TMO], 1u); break; } }
    }
    nloc = mine > 0u ? mine : 1u; nx = cnt > 0u ? cnt : 1u;
}

__device__ __forceinline__ void xcd_barrier(const XcdBarrier& b) {
    asm volatile("s_waitcnt vmcnt(0)" ::: "memory");
    __syncthreads();
    if (threadIdx.x == 0) {
        unsigned* bar = b.bar;
        __builtin_amdgcn_s_waitcnt(0);
        unsigned nloc = b.st[0], nx = b.st[1];
        if (nloc == 0u) { xcd_barrier_complete(bar, b.x, nloc, nx); b.st[0] = nloc; b.st[1] = nx; }
        const unsigned old = xb_add(&bar[XB_XSUB(b.x)], 1u);
        const unsigned gen = old / nloc;
        if (old + 1u == (gen + 1u) * nloc) {
            __builtin_amdgcn_fence(__ATOMIC_RELEASE, "agent");
            asm volatile("s_waitcnt vmcnt(0)" ::: "memory");
            const unsigned og = xb_add(&bar[XB_TOP], 1u);
            const unsigned tg = og / nx;
            if (og + 1u == (tg + 1u) * nx) xb_add(&bar[XB_TOPGEN], 1u);
            else XB_SPIN(xb_ld(&bar[XB_TOPGEN]) == tg, bar);
            __builtin_amdgcn_fence(__ATOMIC_ACQUIRE, "agent");
            xb_add(&bar[XB_XGEN(b.x)], 1u);
            asm volatile("s_waitcnt vmcnt(0)" ::: "memory");
        } else {
            XB_SPIN(xb_ld(&bar[XB_XGEN(b.x)]) == gen, bar);
            __builtin_amdgcn_fence(__ATOMIC_ACQUIRE, "agent");
            asm volatile("s_waitcnt vmcnt(0)" ::: "memory");
        }
    }
    __syncthreads();
}

#ifndef REP_P0
#define REP_P0 0
#endif
#ifndef REP_RP
#define REP_RP 0
#endif
#ifndef REP_ATTN
#define REP_ATTN 0
#endif
#ifndef REP_PREP
#define REP_PREP 0
#endif
#ifndef REP_QKV
#define REP_QKV 0
#endif
#ifndef REP_GMLP
#define REP_GMLP 0
#endif
#ifndef REP_CONV
#define REP_CONV 0
#endif
#ifndef REP_G1
#define REP_G1 0
#endif
#ifndef REP_G3
#define REP_G3 0
#endif
#ifndef REP_G4
#define REP_G4 0
#endif
#ifndef REP_G2
#define REP_G2 0
#endif
#define REPEAT(n) for (int rep_ = 0; rep_ < 1 + (n); ++rep_)
struct Args { const float* in[24]; float* out; unsigned char* ws; int ph_lo, ph_hi; };
constexpr int N_PHASES = 2 + 8 * NLAYER;
struct Ctx {
    LAS unsigned char* lds; unsigned char* lds_raw; int tid, lane, wave, G, bx, vcu, gw, NGW, lo, hi;
    const float *w_in, *w_out, *w_ff1, *w_ff2;
    const float *x_in, *ctx_in, *a_ln_g, *a_ln_b, *a_ws, *a_bs, *b_dw, *b_dwb, *b_ln_g, *b_ln_b, *q_gain, *k_gain, *ln1_g, *ln1_b, *ln2_g, *ln2_b;
    float *rope, *MOD, *X, *out, *STAT, *PART; bf16r *Wt_in, *Wt_out, *Wt_ff1, *Wt_ff2, *H, *P, *Qb, *Kb, *Vb, *MIX, *ACT;
};
#define RUN (pid >= C.lo && pid < C.hi)
#define SEAM() do { if (pid >= C.lo && pid + 1 < C.hi) xcd_barrier(bar); ++pid; } while (0)

__device__ __forceinline__ void tail_transposes(const Ctx& C, int nwg, const float* Wa, int Ka, int Na, bf16r* Ta, const float* Wb2, int Kb, int Nb, bf16r* Tb) {
    const int first = nwg % C.G;
    if (C.bx < first) return;
    LAS float* scr = (LAS float*)(C.lds + C.wave * 16640);
    const int ia = (Ka / 64) * (Na / 64), ib = (Kb / 64) * (Nb / 64), stride = (C.G - first) * 8;
    for (int it = (C.bx - first) * 8 + C.wave; it < ia + ib; it += stride) {
        if (it < ia) p0_transpose_item(Wa, Ka, Na, Ta, scr, it, C.lane); else p0_transpose_item(Wb2, Kb, Nb, Tb, scr, it - ia, C.lane);
    }
}

template <int l> __device__ __forceinline__ void layer_body(const Ctx& C, int& pid, const XcdBarrier& bar) {
    constexpr bool last = (l == NLAYER - 1);
    constexpr int Mrows = last ? NLAT : NROW;
    const float* modl = C.MOD + (size_t)l * 5 * NMODC;
    float* Xc = C.X + (size_t)NLAT * DM;
    if (RUN) {
#if !defined(DIS_GEMM) && !defined(DIS_G1)
        pg8::Gemm g{C.H, C.Wt_in + (size_t)l * INC * DM, Mrows, INC, DM, DM / 64}; pg8::OrderX S; S.init(Mrows, INC, C.G, C.bx, 64, last ? 4 : 0, 12, 2);
        pg8::EpiBf16<0> E{C.P, INC};
        REPEAT(REP_G1) pg8::gemm_phase<pg8::EpiBf16<0>, pg8::OrderX, true, true>(C.lds, g, S, E);
        if (l == 0) tail_transposes(C, (Mrows / 256) * (INC / 256), C.w_in + (size_t)DM * INC, DM, INC, C.Wt_in + (size_t)INC * DM, C.w_out + (size_t)DM * DM, DM, DM, C.Wt_out + (size_t)DM * DM);
#endif
    }
    SEAM();
    if (RUN) {
        REPEAT(REP_PREP) {
#ifndef DIS_PREP
        REPEAT(REP_QKV) prep_qkv(C.P, C.Qb, C.Kb, C.Vb, C.q_gain + l * 128, C.k_gain + l * 128, C.rope, NROW, !last, C.gw, C.NGW, C.lane);
#endif
#ifndef DIS_GMLP
        constexpr int nch = Mrows / 128;
        REPEAT(REP_GMLP) for (int it = C.vcu; it < nch; it += C.G) gmlp_item(C.lds, C.P, C.MIX, C.a_ln_g + l * 512, C.a_ln_b + l * 512, C.a_ws + (size_t)l * 4 * 128 * 128, C.a_bs + l * 512, it, C.tid, C.wave, C.lane);
#endif
#ifndef DIS_CONV
        REPEAT(REP_CONV) for (int it = C.G - 1 - C.vcu; it < Mrows / 32; it += C.G) conv_item(C.lds, C.P, C.MIX, C.b_dw + (size_t)l * 31 * 512, C.b_dwb + l * 512, C.b_ln_g + l * 512, C.b_ln_b + l * 512, it, C.tid, C.wave, C.lane);
#endif
        }
    }
    SEAM();
    if (RUN) {
        constexpr int nunits = 512 + (last ? 0 : 32);
        REPEAT(REP_ATTN) for (int u = C.vcu; u < nunits; u += C.G) {
            int b, h, row0, seq;
            if (u < 512) { b = u >> 7; h = (u >> 4) & 7; row0 = b * SEQ + (u & 15) * 256; seq = KVLEN; }
            else { const int u2 = u - 512; b = u2 >> 3; h = u2 & 7; row0 = NLAT + b * CTX; seq = CTX; }
            const size_t kvoff = (size_t)(b * 2 + (h >> 2)) * KVLEN * 128;
#ifndef DIS_ATTN
            attn::attn_dense_body<attn::bf16>((const attn::bf16*)(C.Qb + (size_t)row0 * 1024 + h * 128), (const attn::bf16*)(C.Kb + kvoff), (const attn::bf16*)(C.Vb + kvoff),
                                              C.MIX + (size_t)row0 * DM + 1024 + h * 128, seq, (char*)C.lds_raw);
#endif
            __syncthreads();
        }
    }
    SEAM();
    if (RUN) {
#if !defined(DIS_GEMM) && !defined(DIS_G2)
        pg8::Gemm g{C.MIX, C.Wt_out + (size_t)l * DM * DM, NLAT, DM, DM, DM / 64}; pg8::OrderX S; S.init(NLAT, DM, C.G, C.bx, 0, 0, 0, 0);
        constexpr int lp = l > 0 ? l - 1 : 0;
        pg8::EpiResGate<(l > 0)> E{l == 0 ? C.x_in : C.X, l == 0 ? C.ctx_in : Xc, C.X, modl + 2 * DM, DN_ALPHA, C.STAT, C.ln2_g + lp * DM, C.ln2_b + lp * DM};
        pg8::gemm_phase<pg8::EpiResGate<(l > 0)>, pg8::OrderX, true, true>(C.lds, g, S, E);
        if (REP_G2) { E.out = C.out; pg8::gemm_phase<pg8::EpiResGate<(l > 0)>, pg8::OrderX, true, true>(C.lds, g, S, E); }
        if (!last) {
            pg8::Gemm g2{C.MIX, C.Wt_out + (size_t)l * DM * DM, NROW, DM, DM, 4}; pg8::OrderSplit S2; S2.init(C.G, C.bx, 8, 4);
            pg8::EpiPart E2{C.PART, 4 * 128};
            pg8::gemm_phase<pg8::EpiPart, pg8::OrderSplit, true, true>(C.lds, g2, S2, E2);
        }
#endif
    }
    SEAM();
    if (RUN) REPEAT(REP_RP) {
        row_pass(C.X, Xc, NLAT, C.ln1_g + l * DM, C.ln1_b + l * DM, nullptr, nullptr, C.STAT, modl, 3 * DM, 4 * DM, C.H, C.gw, C.NGW, C.lane);
        if (!last) row_pass_ctx(C.ctx_in, nullptr, nullptr, nullptr, C.PART, modl + 4 * (size_t)NMODC + 2 * DM, Xc, C.ln1_g + l * DM, C.ln1_b + l * DM, C.STAT, modl, 3 * DM, 4 * DM, C.H, C.gw, C.NGW, C.lane);
    }
    SEAM();
    if (RUN) {
#if !defined(DIS_GEMM) && !defined(DIS_G3)
        pg8::Gemm g{C.H, C.Wt_ff1 + (size_t)l * DFF * DM, Mrows, DFF, DM, DM / 64}; pg8::OrderX S; S.init(Mrows, DFF, C.G, C.bx, 0, 0, 0, 0);
        pg8::EpiBf16<2> E{C.ACT, DFF};
        pg8::gemm_phase<pg8::EpiBf16<2>, pg8::OrderX, true, true>(C.lds, g, S, E);
        if (REP_G3) { pg8::gemm_phase<pg8::EpiBf16<2>, pg8::OrderX, true, true>(C.lds, g, S, E); }
        if (l == 0) tail_transposes(C, (Mrows / 256) * (DFF / 256), C.w_ff1 + (size_t)DM * DFF, DM, DFF, C.Wt_ff1 + (size_t)DFF * DM, C.w_ff2 + (size_t)DFF * DM, DFF, DM, C.Wt_ff2 + (size_t)DM * DFF);
#endif
    }
    SEAM();
    if (RUN) {
#if !defined(DIS_GEMM) && !defined(DIS_G4)
        pg8::Gemm g{C.ACT, C.Wt_ff2 + (size_t)l * DM * DFF, NLAT, DM, DFF, DFF / 64}; pg8::OrderX S; S.init(NLAT, DM, C.G, C.bx, 0, 0, 0, 0);
        pg8::EpiResGate<true> E{C.X, Xc, C.X, modl + 5 * DM, DN_ALPHA, C.STAT, C.ln1_g + l * DM, C.ln1_b + l * DM};
        pg8::gemm_phase<pg8::EpiResGate<true>, pg8::OrderX, true, true>(C.lds, g, S, E);
        if (REP_G4) { E.out = C.out; pg8::gemm_phase<pg8::EpiResGate<true>, pg8::OrderX, true, true>(C.lds, g, S, E); }
        if (!last) {
            pg8::Gemm g2{C.ACT, C.Wt_ff2 + (size_t)l * DM * DFF, NROW, DM, DFF, 16}; pg8::OrderSplit S2; S2.init(C.G, C.bx, 8, 16);
            pg8::EpiPart E2{C.PART, 16 * 128};
            pg8::gemm_phase<pg8::EpiPart, pg8::OrderSplit, true, true>(C.lds, g2, S2, E2);
        }
#endif
    }
    SEAM();
    if (RUN) {
        if (last) { REPEAT(REP_RP) row_pass(C.X, nullptr, NLAT, C.ln2_g + l * DM, C.ln2_b + l * DM, C.out, nullptr, nullptr, nullptr, 0, 0, nullptr, C.gw, C.NGW, C.lane); }
        else {
            REPEAT(REP_RP) row_pass(C.X, Xc, NLAT, C.ln2_g + l * DM, C.ln2_b + l * DM, nullptr, nullptr, C.STAT, modl + 5 * NMODC, 0 * DM, 1 * DM, C.H, C.gw, C.NGW, C.lane);
            row_pass_ctx(Xc, C.STAT, C.ln1_g + l * DM, C.ln1_b + l * DM, C.PART, modl + 4 * (size_t)NMODC + 5 * DM, nullptr, C.ln2_g + l * DM, C.ln2_b + l * DM, C.STAT, modl + 5 * NMODC, 0 * DM, 1 * DM, C.H, C.gw, C.NGW, C.lane);
        }
    }
    SEAM();
}

__global__ void __launch_bounds__(512, 2) fwd_megakernel(Args args) {
    extern __shared__ __attribute__((aligned(16))) unsigned char lds_raw[];
    cg::grid_group grid = cg::this_grid();
    Ctx C;
    C.lds = (LAS unsigned char*)lds_raw; C.lds_raw = lds_raw;
    C.tid = threadIdx.x; C.lane = C.tid & 63; C.wave = __builtin_amdgcn_readfirstlane(C.tid >> 6);
    C.G = gridDim.x; C.bx = blockIdx.x; C.vcu = (C.G % 8 == 0) ? (C.bx % 8) * (C.G / 8) + C.bx / 8 : C.bx;
    C.gw = C.vcu * 8 + C.wave; C.NGW = C.G * 8; C.lo = args.ph_lo; C.hi = args.ph_hi;
    unsigned char* ws = args.ws;
    C.x_in = args.in[0]; C.ctx_in = args.in[2]; C.w_in = args.in[6]; C.w_out = args.in[17]; C.w_ff1 = args.in[20]; C.w_ff2 = args.in[21];
    C.a_ln_g = args.in[7]; C.a_ln_b = args.in[8]; C.a_ws = args.in[9]; C.a_bs = args.in[10];
    C.b_dw = args.in[11]; C.b_dwb = args.in[12]; C.b_ln_g = args.in[13]; C.b_ln_b = args.in[14];
    C.q_gain = args.in[15]; C.k_gain = args.in[16]; C.ln1_g = args.in[18]; C.ln1_b = args.in[19]; C.ln2_g = args.in[22]; C.ln2_b = args.in[23];
    C.STAT = (float*)(ws + WS_STAT); C.PART = (float*)(ws + WS_PART); C.rope = (float*)(ws + WS_ROPE); C.MOD = (float*)(ws + WS_MOD); C.X = (float*)(ws + WS_X); C.out = args.out;
    C.Wt_in = (bf16r*)(ws + WS_WIN); C.Wt_out = (bf16r*)(ws + WS_WOUT); C.Wt_ff1 = (bf16r*)(ws + WS_WFF1); C.Wt_ff2 = (bf16r*)(ws + WS_WFF2);
    C.H = (bf16r*)(ws + WS_H); C.P = (bf16r*)(ws + WS_P); C.Qb = (bf16r*)(ws + WS_Q);
    C.Kb = (bf16r*)(ws + WS_K); C.Vb = (bf16r*)(ws + WS_V); C.MIX = (bf16r*)(ws + WS_MIX); C.ACT = (bf16r*)(ws + WS_ACT);
    int pid = 0;
    volatile LAS unsigned* bst = (volatile LAS unsigned*)(C.lds + LDS_BYTES - 64);
    if (C.tid < 2) bst[C.tid] = 0u;
    __syncthreads();
    const XcdBarrier bar = xcd_barrier_post((unsigned*)(ws + WS_BAR), bst);
    if (C.hi < 0) grid.sync();

    if (RUN) REPEAT(REP_P0) {
        const float* c_in = args.in[1]; const float* cctx_in = args.in[3]; const float* w_mod = args.in[4]; const float* b_mod = args.in[5];
        const float* w_in = args.in[6]; const float* w_out = args.in[17]; const float* w_ff1 = args.in[20]; const float* w_ff2 = args.in[21];
        p0_rope(C.rope, C.bx * 512 + C.tid, C.G * 512);
        p0_mod(C.lds, c_in, cctx_in, w_mod, b_mod, C.MOD, C.bx, C.G, C.tid);
        __syncthreads();
        LAS float* scr = (LAS float*)(C.lds + C.wave * 16640);
        constexpr int I_IN = (DM / 64) * (INC / 64), I_OUT = (DM / 64) * (DM / 64), I_F1 = (DM / 64) * (DFF / 64), I_F2 = (DFF / 64) * (DM / 64), I_L = I_IN + I_OUT + I_F1 + I_F2;
        for (int it = C.gw; it < I_L; it += C.NGW) {
            const int l = 0; int r = it;
            if (r < I_IN) { p0_transpose_item(w_in + (size_t)l * DM * INC, DM, INC, C.Wt_in + (size_t)l * INC * DM, scr, r, C.lane); continue; } r -= I_IN;
            if (r < I_OUT) { p0_transpose_item(w_out + (size_t)l * DM * DM, DM, DM, C.Wt_out + (size_t)l * DM * DM, scr, r, C.lane); continue; } r -= I_OUT;
            if (r < I_F1) { p0_transpose_item(w_ff1 + (size_t)l * DM * DFF, DM, DFF, C.Wt_ff1 + (size_t)l * DFF * DM, scr, r, C.lane); continue; } r -= I_F1;
            p0_transpose_item(w_ff2 + (size_t)l * DFF * DM, DFF, DM, C.Wt_ff2 + (size_t)l * DM * DFF, scr, r, C.lane);
        }
        if (REP_P0) __syncthreads();
    }
    SEAM();
    if (RUN) REPEAT(REP_RP) row_pass(C.x_in, C.ctx_in, NROW, nullptr, nullptr, nullptr, nullptr, nullptr, C.MOD, 0 * DM, 1 * DM, C.H, C.gw, C.NGW, C.lane);
    SEAM();
    layer_body<0>(C, pid, bar);
    layer_body<1>(C, pid, bar);
#ifdef EXTRA_SYNCS
    if (C.hi - C.lo > 1) { for (int i = 0; i < EXTRA_SYNCS; ++i) {
#ifdef EXTRA_DIRTY
        { f32x4* sp = (f32x4*)(ws + WS_PART) + (size_t)C.bx * 512 * EXTRA_DIRTY + C.tid;
          for (int k = 0; k < EXTRA_DIRTY; ++k) sp[k * 512] = (f32x4){(float)i, 1.f, 2.f, 3.f}; }
#endif
        xcd_barrier(bar); } }
#endif
}
#undef RUN
#undef SEAM

#ifndef MK_PER_PHASE
#define MK_PER_PHASE 0
#endif
extern "C" void kernel_launch(void* const* d_in, const int* in_sizes, int n_in, void* d_out, int out_size, void* d_ws, size_t ws_size, hipStream_t stream) {
    static int grid = 0;
    if (grid == 0) {
        if (n_in != 24 || out_size != NLAT * DM || ws_size < WS_END) { fprintf(stderr, "kernel_launch: unexpected shapes (n_in %d out %d ws %zu, need ws >= %zu)\n", n_in, out_size, ws_size, (size_t)WS_END); grid = -1; return; }
        int dev = 0, cus = 0, per_cu = 0;
        (void)hipGetDevice(&dev); (void)hipDeviceGetAttribute(&cus, hipDeviceAttributeMultiprocessorCount, dev);
        if (hipFuncSetAttribute((const void*)fwd_megakernel, hipFuncAttributeMaxDynamicSharedMemorySize, LDS_BYTES) != hipSuccess) { fprintf(stderr, "kernel_launch: hipFuncSetAttribute failed\n"); grid = -1; return; }
        if (hipOccupancyMaxActiveBlocksPerMultiprocessor(&per_cu, (const void*)fwd_megakernel, 512, LDS_BYTES) != hipSuccess || per_cu < 1) { fprintf(stderr, "kernel_launch: occupancy query says %d\n", per_cu); per_cu = 1; }
        (void)hipGetLastError();
        grid = cus;
    }
    if (grid < 0) return;
#ifndef PROBE_TWICE
#define PROBE_TWICE 0
#endif
    for (int rep_launch = 0; rep_launch <= PROBE_TWICE; ++rep_launch) {
    if (hipMemsetAsync((char*)d_ws + WS_BAR, 0, WS_BAR_BYTES, stream) != hipSuccess) { fprintf(stderr, "kernel_launch: memset failed\n"); return; }
    Args a{};
    for (int i = 0; i < 24; ++i) a.in[i] = (const float*)d_in[i];
    a.out = (float*)d_out; a.ws = (unsigned char*)d_ws;
#if MK_PER_PHASE
    for (int p = 0; p < N_PHASES; ++p) { a.ph_lo = p; a.ph_hi = p + 1; hipLaunchKernelGGL(fwd_megakernel, dim3(grid), dim3(512), LDS_BYTES, stream, a); }
#else
    a.ph_lo = 0; a.ph_hi = N_PHASES;
    void* kargs[] = {&a};
    hipError_t e = hipLaunchCooperativeKernel((const void*)fwd_megakernel, dim3(grid), dim3(512), kargs, LDS_BYTES, stream);
    if (e != hipSuccess) fprintf(stderr, "kernel_launch: cooperative launch failed: %s (grid %d)\n", hipGetErrorString(e), grid);
#endif
    }
}
```

```cpp
#include <hip/hip_runtime.h>
#include <hip/hip_cooperative_groups.h>
#include <hip/hip_bf16.h>
#include <cstdio>
#include <cstdint>
namespace cg = cooperative_groups;
namespace pg8 {
#define PG8_LAS __attribute__((address_space(3)))
typedef unsigned short bf16_t;
typedef short bf16x8 __attribute__((ext_vector_type(8)));
typedef float f32x4 __attribute__((ext_vector_type(4)));
typedef unsigned u32x4 __attribute__((ext_vector_type(4)));
constexpr int BM = 256, BK = 64, HALF = 128, HTB = HALF * BK * 2  , STAGE_BYTES = 8 * HTB, NXCD = 8, WGM = 8;

__host__ __device__ __forceinline__ int lds_byte(int r, int c) { const int st = (r >> 4) * 2 + (c >> 5), rr = r & 15, cc = c & 31, ob = rr * 64 + cc * 2; return st * 1024 + (ob ^ (((ob >> 9) & 1) << 5)); }
__host__ __device__ __forceinline__ void stage_rc(int b, int& R, int& C) { const int st = b / 1024, sb = b % 1024, swz = sb ^ (((sb >> 9) & 1) << 5); R = (st >> 1) * 16 + swz / 64; C = (st & 1) * 32 + (swz % 64) / 2; }
__host__ __device__ __forceinline__ int perm32(int rho) { const int n = rho >> 4, i = rho & 15; return 8 * (i >> 2) + 4 * n + (i & 3); }

struct Unit { int pm, pn, ko; };
struct Gemm { const bf16_t* A; const bf16_t* Bt; int M, N, K, nt, krev; };

struct StaticOrder {
    int nM, nN, nwg, G, c;
    __host__ __device__ void init(int M, int N, int G_, int c_) { nM = M / BM; nN = N / BM; nwg = nM * nN; G = G_; c = c_; }
    __host__ __device__ bool next(int i, Unit& u) const {
        const long L = (long)i * G + c; if (L >= nwg) return false;
        int wgid = (int)L; { const int q = nwg / NXCD, r = nwg % NXCD, xcd = wgid % NXCD, off = wgid / NXCD; wgid = (xcd < r ? xcd * (q + 1) : r * (q + 1) + (xcd - r) * q) + off; }
        const int nig = WGM * nN, gid = wgid / nig, fm = gid * WGM, gsz = (nM - fm) < WGM ? (nM - fm) : WGM;
        u.pm = fm + ((wgid % nig) % gsz); u.pn = (wgid % nig) / gsz; u.ko = 0; return true;
    }
    __device__ __forceinline__ void a_ready(const Unit&) const {}
    __device__ __forceinline__ void done(const Unit&) const {}
};

__device__ __forceinline__ unsigned cvt_pk_bf16(float lo, float hi) { unsigned r; asm volatile("v_cvt_pk_bf16_f32 %0, %1, %2" : "=v"(r) : "v"(lo), "v"(hi)); return r; }
typedef float f32x2 __attribute__((ext_vector_type(2)));
#ifndef WT_STORES
#define WT_STORES 0
#endif
__device__ __forceinline__ void st16_wt(void* p, u32x4 v) {
#if WT_STORES
    asm volatile("global_store_dwordx4 %0, %1, off sc1\n\ts_nop 1" :: "v"(p), "v"(v) : "memory");
#else
    *(u32x4*)p = v;
#endif
}
template <int ACT  > struct EpiBf16 {
    static constexpr bool PERM = true, AFTER_DRAIN = false;
    bf16_t* O; int ldc;
    __device__ __forceinline__ void operator()(const f32x4 (&acc)[2][2][4][2], const Unit& u, int wr, int wc, int fr, int fq) const {
        const int row0 = u.pm * BM + wr * 64 + fr; const int col0 = u.pn * BM + wc * 32 + 8 * fq;
#pragma unroll
        for (int ai = 0; ai < 2; ++ai)
#pragma unroll
            for (int m = 0; m < 4; ++m) { bf16_t* rowp = O + (size_t)(row0 + ai * HALF + m * 16) * ldc + col0;
#pragma unroll
                for (int bj = 0; bj < 2; ++bj) { f32x4 v0 = acc[ai][bj][m][0], v1 = acc[ai][bj][m][1];
                    if (ACT == 2) {
#pragma unroll
                        for (int e = 0; e < 4; ++e) { float a = fmaxf(v0[e], 0.f), b = fmaxf(v1[e], 0.f); v0[e] = a * a; v1[e] = b * b; } }
                    u32x4 w; w.x = cvt_pk_bf16(v0[0], v0[1]); w.y = cvt_pk_bf16(v0[2], v0[3]); w.z = cvt_pk_bf16(v1[0], v1[1]); w.w = cvt_pk_bf16(v1[2], v1[3]);
                    st16_wt(rowp + bj * HALF, w); } }
    }
};
template <bool NORM> struct EpiResGate {
    static constexpr bool PERM = false, AFTER_DRAIN = false;
    const float* res_lat; const float* res_ctx; float* out; const float* gate; float alpha; const float* stat; const float* lg; const float* lb;
    __device__ __forceinline__ void operator()(const f32x4 (&acc)[2][2][4][2], const Unit& u, int wr, int wc, int fr, int fq) const {
        typedef float f32x2v __attribute__((ext_vector_type(2)));
        const int mrow = u.pm < 64 ? (u.pm >> 4) : 4;
        const float* g = gate + (size_t)mrow * 12288;
        const int col0 = u.pn * BM + wc * 32 + 4 * fq;
        f32x4 gv[2][2], gg[2][2], bb[2][2];
#pragma unroll
        for (int bj = 0; bj < 2; ++bj)
#pragma unroll
            for (int n = 0; n < 2; ++n) { gv[bj][n] = *(const f32x4*)(g + col0 + bj * HALF + n * 16);
                if (NORM) { gg[bj][n] = *(const f32x4*)(lg + col0 + bj * HALF + n * 16); bb[bj][n] = *(const f32x4*)(lb + col0 + bj * HALF + n * 16); } }
#pragma unroll
        for (int ai = 0; ai < 2; ++ai)
#pragma unroll
            for (int mp = 0; mp < 2; ++mp) {
                f32x4 r[2][2][2]; f32x2v st[2];
#pragma unroll
                for (int mm = 0; mm < 2; ++mm) { const int row = u.pm * BM + ai * HALF + wr * 64 + (mp * 2 + mm) * 16 + fr;
                    const float* rp = (row < 16384) ? res_lat + (size_t)row * 2048 : res_ctx + (size_t)(row - 16384) * 2048;
                    st[mm] = (f32x2v){0.f, 1.f}; if (NORM) st[mm] = *(const f32x2v*)(stat + 2 * (size_t)row);
#pragma unroll
                    for (int bj = 0; bj < 2; ++bj)
#pragma unroll
                        for (int n = 0; n < 2; ++n) r[mm][bj][n] = *(const f32x4*)(rp + col0 + bj * HALF + n * 16); }
#pragma unroll
                for (int mm = 0; mm < 2; ++mm) { const int m = mp * 2 + mm; const int row = u.pm * BM + ai * HALF + wr * 64 + m * 16 + fr;
                    float* op = out + (size_t)row * 2048;
#pragma unroll
                    for (int bj = 0; bj < 2; ++bj)
#pragma unroll
                        for (int n = 0; n < 2; ++n) { f32x4 x = r[mm][bj][n];
                            if (NORM) x = (x - st[mm].x) * st[mm].y * gg[bj][n] + bb[bj][n];
                            const f32x4 o = x * alpha + gv[bj][n] * acc[ai][bj][m][n]; st16_wt(op + col0 + bj * HALF + n * 16, __builtin_bit_cast(u32x4, o)); } }
                asm volatile("" ::: "memory");
            }
    }
};
template <int MODE> struct EpiProbe {
    static constexpr bool PERM = false, AFTER_DRAIN = false;
    const float* res; float* out;
    __device__ __forceinline__ void operator()(const f32x4 (&acc)[2][2][4][2], const Unit& u, int wr, int wc, int fr, int fq) const {
        const int col0 = u.pn * BM + wc * 32 + 4 * fq; f32x4 s = {0.f, 0.f, 0.f, 0.f};
#pragma unroll
        for (int ai = 0; ai < 2; ++ai)
#pragma unroll
            for (int m = 0; m < 4; ++m) { const int row = u.pm * BM + ai * HALF + wr * 64 + m * 16 + fr;
#pragma unroll
                for (int bj = 0; bj < 2; ++bj)
#pragma unroll
                    for (int n = 0; n < 2; ++n) { const int c = col0 + bj * HALF + n * 16;
                        if (MODE == 1) *(f32x4*)(out + (size_t)row * 2048 + c) = acc[ai][bj][m][n];
                        else s += *(const f32x4*)(res + (size_t)row * 2048 + c) * acc[ai][bj][m][n]; } }
        if (MODE == 2) *(f32x4*)(out + (size_t)(u.pm * BM + wr * 64 + fr) * 2048 + col0) = s;
    }
};
struct OrderX {
    StaticOrder base; int xm0, xnm, xn0, xnn;
    __device__ void init(int M, int N, int G_, int c_, int xm0_, int xnm_, int xn0_, int xnn_) { base.init(M, N, G_, c_); xm0 = xm0_; xnm = xnm_; xn0 = xn0_; xnn = xnn_; }
    __device__ bool next(int i, Unit& u) const {
        long L = (long)i * base.G + base.c; if (L < base.nwg) return base.next(i, u);
        L -= base.nwg; if (L >= (long)xnm * xnn) return false;
        u.pm = xm0 + (int)(L % xnm); u.pn = xn0 + (int)(L / xnm); u.ko = 0; return true;
    }
    __device__ __forceinline__ void a_ready(const Unit&) const {}
    __device__ __forceinline__ void done(const Unit&) const {}
};
struct OrderSplit {
    int G, c, nsub, kbytes;
    __device__ void init(int G_, int c_, int ns, int nt) { G = G_; c = c_; nsub = 32 * ns; kbytes = nt * 128; }
    __device__ bool next(int i, Unit& u) const { const long L = (long)i * G + c; if (L >= nsub) return false; const int idx = (int)L; u.pm = 64 + (idx & 3); u.pn = (idx >> 2) & 7; u.ko = (idx >> 5) * kbytes; return true; }
    __device__ __forceinline__ void a_ready(const Unit&) const {}
    __device__ __forceinline__ void done(const Unit&) const {}
};
struct EpiPart {
    static constexpr bool PERM = false, AFTER_DRAIN = false;
    float* part; int kbytes;
    __device__ __forceinline__ void operator()(const f32x4 (&acc)[2][2][4][2], const Unit& u, int wr, int wc, int fr, int fq) const {
        typedef _Float16 h16x4v __attribute__((ext_vector_type(4)));
        const int ks = u.ko / kbytes; const int col0 = u.pn * BM + wc * 32 + 4 * fq;
        _Float16* base = (_Float16*)part + ((size_t)ks * 1024 + (size_t)(u.pm - 64) * BM) * 2048;
#pragma unroll
        for (int ai = 0; ai < 2; ++ai)
#pragma unroll
            for (int m = 0; m < 4; ++m) { _Float16* op = base + (size_t)(ai * HALF + wr * 64 + m * 16 + fr) * 2048;
#pragma unroll
                for (int bj = 0; bj < 2; ++bj)
#pragma unroll
                    for (int n = 0; n < 2; ++n) *(h16x4v*)(op + col0 + bj * HALF + n * 16) = __builtin_convertvector(acc[ai][bj][m][n], h16x4v); }
    }
};
template <class Epi, class Sched, bool ALIGN_EPI = false, bool SP2 = false>
__device__ __forceinline__ void gemm_phase(PG8_LAS unsigned char* lds, const Gemm g, const Sched& S, const Epi& E) {
    const int tid = threadIdx.x, wid = __builtin_amdgcn_readfirstlane(tid >> 6), lane = tid & 63, wr = wid >> 2, wc = wid & 3, fr = lane & 15, fq = lane >> 4;
    const int K = g.K, nt = g.nt;
    unsigned voffA[2], voffB[2];
#pragma unroll
    for (int i = 0; i < 2; ++i) { int R, C; stage_rc(tid * 16 + i * 8192, R, C); const int Rb = Epi::PERM ? ((R & ~31) + perm32(R & 31)) : R;
        voffA[i] = (unsigned)(R * K + C) * 2u; voffB[i] = (unsigned)(Rb * K + C) * 2u; }
    const ptrdiff_t kstep = g.krev ? -(ptrdiff_t)(BK * 2) : (ptrdiff_t)(BK * 2);
    const size_t krev0 = g.krev ? (size_t)(nt - 1) * (BK * 2) : 0;
    const size_t hstep = (size_t)HALF * K * 2;
    const size_t tstep = 2 * hstep;
    const unsigned ldsw = (unsigned)wid * 1024u;
    const int aoff = lds_byte(wr * 64 + fr, fq * 8), boff = lds_byte(wc * 32 + fr, fq * 8);
#define PG8_SA(b, h) (((b) * 2 + (h)) * HTB)
#define PG8_SB(b, h) ((4 + (b) * 2 + (h)) * HTB)
#define PG8_STAGE(bufoff, gbase, voff) do { _Pragma("unroll") for (int _i = 0; _i < 2; ++_i) \
        __builtin_amdgcn_global_load_lds((const unsigned*)((const char*)(gbase) + (voff)[_i]), (PG8_LAS unsigned*)(lds + (bufoff) + ldsw + _i * 8192), 16, 0, 0); } while (0)
#define PG8_LDA(dst, b, h) do { _Pragma("unroll") for (int m = 0; m < 4; ++m) _Pragma("unroll") for (int k = 0; k < 2; ++k) dst[m][k] = *(const PG8_LAS bf16x8*)(lds + PG8_SA(b, h) + aoff + m * 2048 + k * 1024); } while (0)
#define PG8_LDB(dst, b, h) do { _Pragma("unroll") for (int n = 0; n < 2; ++n) _Pragma("unroll") for (int k = 0; k < 2; ++k) dst[n][k] = *(const PG8_LAS bf16x8*)(lds + PG8_SB(b, h) + boff + n * 2048 + k * 1024); } while (0)
#define PG8_MMA(ai, bj, At, Bt) do { __builtin_amdgcn_s_setprio(1); _Pragma("unroll") for (int m = 0; m < 4; ++m) _Pragma("unroll") for (int n = 0; n < 2; ++n) _Pragma("unroll") for (int k = 0; k < 2; ++k) \
        acc[ai][bj][m][n] = __builtin_amdgcn_mfma_f32_16x16x32_bf16(Bt[n][k], At[m][k], acc[ai][bj][m][n], 0, 0, 0); __builtin_amdgcn_s_setprio(0); } while (0)
#define PG8_WAIT_V(n) asm volatile("s_waitcnt vmcnt(" #n ")" ::: "memory")
#define PG8_WAIT_L(n) asm volatile("s_waitcnt lgkmcnt(" #n ")" ::: "memory")
#define PG8_BAR __builtin_amdgcn_s_barrier()
#define PG8_SCHED __builtin_amdgcn_sched_barrier(0)
    Unit cur, nxt; int ui = 0;
    if (!S.next(0, cur)) return;
    f32x4 acc[2][2][4][2];
#pragma unroll
    for (int a = 0; a < 2; ++a)
#pragma unroll
        for (int b = 0; b < 2; ++b)
#pragma unroll
            for (int m = 0; m < 4; ++m)
#pragma unroll
                for (int n = 0; n < 2; ++n) acc[a][b][m][n] = (f32x4){0.f, 0.f, 0.f, 0.f};
    bf16x8 At[4][2], B0[2][2], B1[2][2];
    const char* cA = (const char*)g.A + (size_t)cur.pm * tstep + cur.ko + krev0; const char* cB = (const char*)g.Bt + (size_t)cur.pn * tstep + cur.ko + krev0;
    S.a_ready(cur);
    if constexpr (SP2) {
        PG8_STAGE(PG8_SB(0, 0), cB, voffB); PG8_STAGE(PG8_SB(0, 1), cB + hstep, voffB); PG8_STAGE(PG8_SA(0, 0), cA, voffA); PG8_STAGE(PG8_SA(0, 1), cA + hstep, voffA);
        if (wr == 1) PG8_BAR;
        PG8_WAIT_V(2); PG8_BAR;
        PG8_STAGE(PG8_SB(1, 0), cB + kstep, voffB); PG8_STAGE(PG8_SA(1, 0), cA + kstep, voffA); PG8_STAGE(PG8_SB(1, 1), cB + hstep + kstep, voffB);
        PG8_WAIT_V(6); PG8_BAR;
    } else {
        PG8_STAGE(PG8_SB(0, 0), cB, voffB); PG8_STAGE(PG8_SA(0, 0), cA, voffA); PG8_STAGE(PG8_SB(0, 1), cB + hstep, voffB); PG8_STAGE(PG8_SA(0, 1), cA + hstep, voffA);
        if (wr == 1) PG8_BAR;
        PG8_WAIT_V(4); PG8_BAR;
        PG8_STAGE(PG8_SB(1, 0), cB + kstep, voffB); PG8_STAGE(PG8_SA(1, 0), cA + kstep, voffA); PG8_STAGE(PG8_SB(1, 1), cB + hstep + kstep, voffB);
        PG8_WAIT_V(6); PG8_BAR;
    }
    for (;;) {
        const bool has_next = S.next(ui + 1, nxt);
        const char* nA = has_next ? (const char*)g.A + (size_t)nxt.pm * tstep + nxt.ko + krev0 : cA; const char* nB = has_next ? (const char*)g.Bt + (size_t)nxt.pn * tstep + nxt.ko + krev0 : cB;
        for (int t = 0; t < nt; t += 2) {
            const bool last = (t == nt - 2);
            const char* a1 = cA + (ptrdiff_t)(t + 1) * kstep;
            const char* a2 = last ? nA : cA + (ptrdiff_t)(t + 2) * kstep; const char* b2 = last ? nB : cB + (ptrdiff_t)(t + 2) * kstep;
            const char* a3 = a2 + kstep; const char* b3 = b2 + kstep;
            if (last && has_next) S.a_ready(nxt);
            if constexpr (SP2) {
            PG8_LDB(B0, 0, 0); PG8_LDB(B1, 0, 1); PG8_SCHED; PG8_LDA(At, 0, 0); PG8_STAGE(PG8_SA(1, 1), a1 + hstep, voffA);
            PG8_WAIT_V(8); PG8_WAIT_L(0); PG8_BAR; PG8_MMA(0, 0, At, B0); PG8_MMA(0, 1, At, B1); PG8_BAR; PG8_SCHED;
            PG8_LDA(At, 0, 1); PG8_STAGE(PG8_SB(0, 0), b2, voffB); PG8_STAGE(PG8_SB(0, 1), b2 + hstep, voffB); PG8_STAGE(PG8_SA(0, 0), a2, voffA);
            PG8_WAIT_V(8); PG8_WAIT_L(0); PG8_BAR; PG8_MMA(1, 0, At, B0); PG8_MMA(1, 1, At, B1); PG8_BAR; PG8_SCHED;
            PG8_LDB(B0, 1, 0); PG8_LDB(B1, 1, 1); PG8_SCHED; PG8_LDA(At, 1, 0); PG8_STAGE(PG8_SA(0, 1), a2 + hstep, voffA);
            PG8_WAIT_V(8); PG8_WAIT_L(0); PG8_BAR; PG8_MMA(0, 0, At, B0); PG8_MMA(0, 1, At, B1); PG8_BAR; PG8_SCHED;
            PG8_LDA(At, 1, 1); PG8_STAGE(PG8_SB(1, 0), b3, voffB); PG8_STAGE(PG8_SB(1, 1), b3 + hstep, voffB); PG8_STAGE(PG8_SA(1, 0), a3, voffA);
            PG8_WAIT_V(8); PG8_WAIT_L(0); PG8_BAR; PG8_MMA(1, 0, At, B0); PG8_MMA(1, 1, At, B1); PG8_BAR; PG8_SCHED;
            } else {
            PG8_LDB(B0, 0, 0); PG8_SCHED; PG8_LDA(At, 0, 0); PG8_STAGE(PG8_SA(1, 1), a1 + hstep, voffA);
            PG8_WAIT_L(8); PG8_BAR; PG8_WAIT_L(0); PG8_MMA(0, 0, At, B0); PG8_BAR; PG8_SCHED;
            PG8_LDB(B1, 0, 1); PG8_STAGE(PG8_SB(0, 0), b2, voffB);
            PG8_BAR; PG8_WAIT_L(0); PG8_MMA(0, 1, At, B1); PG8_BAR;
            PG8_LDA(At, 0, 1); PG8_STAGE(PG8_SA(0, 0), a2, voffA);
            PG8_BAR; PG8_WAIT_L(0); PG8_MMA(1, 0, At, B0); PG8_BAR; PG8_SCHED;
            PG8_STAGE(PG8_SB(0, 1), b2 + hstep, voffB);
            PG8_WAIT_V(6); PG8_BAR; PG8_MMA(1, 1, At, B1); PG8_BAR;
            PG8_LDB(B0, 1, 0); PG8_SCHED; PG8_LDA(At, 1, 0); PG8_STAGE(PG8_SA(0, 1), a2 + hstep, voffA);
            PG8_WAIT_L(8); PG8_BAR; PG8_WAIT_L(0); PG8_MMA(0, 0, At, B0); PG8_BAR; PG8_SCHED;
            PG8_LDB(B1, 1, 1); PG8_STAGE(PG8_SB(1, 0), b3, voffB);
            PG8_BAR; PG8_WAIT_L(0); PG8_MMA(0, 1, At, B1); PG8_BAR;
            PG8_LDA(At, 1, 1); PG8_STAGE(PG8_SA(1, 0), a3, voffA);
            PG8_BAR; PG8_WAIT_L(0); PG8_MMA(1, 0, At, B0); PG8_BAR; PG8_SCHED;
            PG8_STAGE(PG8_SB(1, 1), b3 + hstep, voffB);
            PG8_WAIT_V(6); PG8_BAR; PG8_MMA(1, 1, At, B1); PG8_BAR;
            }
        }
        if constexpr (ALIGN_EPI) { if (wr == 0) PG8_BAR; }
        if constexpr (!Epi::AFTER_DRAIN) { E(acc, cur, wr, wc, fr, fq); S.done(cur); }
        if (!has_next) break;
#pragma unroll
        for (int a = 0; a < 2; ++a)
#pragma unroll
            for (int b = 0; b < 2; ++b)
#pragma unroll
                for (int m = 0; m < 4; ++m)
#pragma unroll
                    for (int n = 0; n < 2; ++n) acc[a][b][m][n] = (f32x4){0.f, 0.f, 0.f, 0.f};
        cur = nxt; cA = nA; cB = nB; ++ui;
        if constexpr (ALIGN_EPI) { if (wr == 1) PG8_BAR; }
    }
    PG8_WAIT_V(0);
    if constexpr (!ALIGN_EPI) { if (wr == 0) PG8_BAR; }
    PG8_BAR;
    if constexpr (Epi::AFTER_DRAIN) { E.fused(acc, cur, wr, wc, fr, fq, lds, wid, lane); S.done(cur); }
#undef PG8_SA
#undef PG8_SB
#undef PG8_STAGE
#undef PG8_LDA
#undef PG8_LDB
#undef PG8_MMA
#undef PG8_WAIT_V
#undef PG8_WAIT_L
#undef PG8_BAR
#undef PG8_SCHED
}
}
namespace attn {
using bf16 = __hip_bfloat16;
constexpr int   D = 128, NW = 8, QBLK = 32, KVBLK = 64;
constexpr float SCALE = 0.088388347648318440f;
#ifndef ATTN_THR
#define ATTN_THR 8.f
#endif
constexpr float THR = ATTN_THR;
constexpr int SDEPTH = 2;
constexpr int LDQ = 3584, LDK = 128, LDO = 2048;
constexpr size_t SHM_V = KVBLK * D * 2, SHM_K = KVBLK * D * 2, SHM_ATTN = 2 * SHM_V + 2 * SHM_K + NW * 64 * 4;
__device__ __forceinline__ unsigned short f2bf16(float f) { unsigned u = __builtin_bit_cast(unsigned, f); return (unsigned short)((u + 0x7fffu + ((u >> 16) & 1u)) >> 16); }
using bf16x8 = __attribute__((ext_vector_type(8))) short;
using s16x4  = __attribute__((ext_vector_type(4))) short;
using f32x16 = __attribute__((ext_vector_type(16))) float;
using f32x8  = __attribute__((ext_vector_type(8))) float;
using u32x4  = __attribute__((ext_vector_type(4))) unsigned;
#define KSWZ(row, colB) ((row) * 256 + ((colB) ^ (((row) & 7) << 4)))
#define SBAR() __builtin_amdgcn_sched_barrier(0)
__device__ __forceinline__ int crow(int r, int hi) { return (r & 3) + 8 * (r >> 2) + 4 * hi; }
__device__ __forceinline__ unsigned cvtpk(float lo, float hi) {
  unsigned r; asm volatile("v_cvt_pk_bf16_f32 %0, %1, %2" : "=v"(r) : "v"(lo), "v"(hi)); return r;
}
template <typename TIn> struct Stage;
template <> struct Stage<bf16>  { using T = bf16x8;
  __device__ static __forceinline__ T ld8(const bf16* p) { return *reinterpret_cast<const bf16x8*>(p); }
  __device__ static __forceinline__ bf16x8 tobf(T x) { return x; } };
template <> struct Stage<float> { using T = f32x8;
  __device__ static __forceinline__ T ld8(const float* p) { return *reinterpret_cast<const f32x8*>(p); }
  __device__ static __forceinline__ bf16x8 tobf(T x) {
    u32x4 w = {cvtpk(x[0], x[1]), cvtpk(x[2], x[3]), cvtpk(x[4], x[5]), cvtpk(x[6], x[7])}; return *reinterpret_cast<bf16x8*>(&w); } };

__device__ __forceinline__ void partialSM(f32x16& p0, f32x16& p1, float& m_reg, float& mn, float& alpha) {
  constexpr float C = SCALE * 1.4426950408889634f;
  float pmax = p0[0]; for (int r = 1; r < 16; ++r) pmax = fmaxf(pmax, p0[r]); for (int r = 0; r < 16; ++r) pmax = fmaxf(pmax, p1[r]);
  { auto rr = __builtin_amdgcn_permlane32_swap(__float_as_uint(pmax), __float_as_uint(pmax), false, false);
    pmax = fmaxf(__uint_as_float(rr[0]), __uint_as_float(rr[1])); }
  if (__builtin_expect(__all(pmax - m_reg <= THR / SCALE), 1)) { mn = m_reg; alpha = 1.f; }
  else { mn = fmaxf(m_reg, pmax); alpha = __builtin_amdgcn_exp2f((m_reg - mn) * C); m_reg = mn; }
  float mnC = -mn * C;
  for (int r = 0; r < 16; ++r) p0[r] = fmaf(p0[r], C, mnC); for (int r = 0; r < 16; ++r) p1[r] = fmaf(p1[r], C, mnC);
  for (int r = 0; r < 16; ++r) p0[r] = __builtin_amdgcn_exp2f(p0[r]);
}
__device__ __forceinline__ void finishSM(f32x16& p0, f32x16& p1, float alpha, float& l_reg, bf16x8& pa0, bf16x8& pa1, bf16x8& pa2, bf16x8& pa3) {
  for (int r = 0; r < 16; ++r) p1[r] = __builtin_amdgcn_exp2f(p1[r]);
  float ps = 0; for (int r = 0; r < 16; ++r) ps += p0[r]; for (int r = 0; r < 16; ++r) ps += p1[r];
  { auto rr = __builtin_amdgcn_permlane32_swap(__float_as_uint(ps), __float_as_uint(ps), false, false);
    ps = __uint_as_float(rr[0]) + __uint_as_float(rr[1]); }
  l_reg = l_reg * alpha + ps;
#define PK4(P, BASE, OUT) do { unsigned a0 = cvtpk(P[BASE + 0], P[BASE + 1]), a1 = cvtpk(P[BASE + 2], P[BASE + 3]);   \
    unsigned b0 = cvtpk(P[BASE + 4], P[BASE + 5]), b1 = cvtpk(P[BASE + 6], P[BASE + 7]);                              \
    auto r0 = __builtin_amdgcn_permlane32_swap(a0, b0, false, false); auto r1 = __builtin_amdgcn_permlane32_swap(a1, b1, false, false); \
    u32x4 w = {r0[0], r1[0], r0[1], r1[1]}; OUT = *reinterpret_cast<bf16x8*>(&w); } while (0)
  PK4(p0, 0, pa0); PK4(p0, 8, pa1); PK4(p1, 0, pa2); PK4(p1, 8, pa3);
#undef PK4
}
__device__ __forceinline__ void qkt(f32x16& p0, f32x16& p1, const bf16* Ks, const bf16x8* qr, int r32, int hi) {
  p0 = f32x16{}; p1 = f32x16{};
  for (int d0 = 0; d0 < 8; ++d0) { int cb = (d0 * 16 + hi * 8) * 2;
    bf16x8 b0 = *reinterpret_cast<const bf16x8*>((const char*)Ks + KSWZ(r32, cb));
    bf16x8 b1 = *reinterpret_cast<const bf16x8*>((const char*)Ks + KSWZ(32 + r32, cb));
    p0 = __builtin_amdgcn_mfma_f32_32x32x16_bf16(b0, qr[d0], p0, 0, 0, 0);
    p1 = __builtin_amdgcn_mfma_f32_32x32x16_bf16(b1, qr[d0], p1, 0, 0, 0); }
}
__device__ __forceinline__ int v_st(int k, int c) { const int kk = (k & ~0xC) | ((k & 4) << 1) | ((k & 8) >> 1); return ((kk >> 3) * 4 + (c >> 5)) * 512 + ((kk & 7) * 32 + (c & 31)) * 2; }
__device__ __forceinline__ int v_rd_base(int lane) { return ((lane & 3) << 3) | (((lane >> 2) & 3) << 6) | (((lane >> 4) & 1) << 5) | (((lane >> 5) & 1) << 8); }
constexpr int v_rd_off(int d0, int ks, int half) { return d0 * 512 + ks * 4096 + half * 2048; }
template <int OFF> __device__ __forceinline__ s16x4 tr_read(int vb) {
  s16x4 r; asm volatile("ds_read_b64_tr_b16 %0, %1 offset:%2" : "=&v"(r) : "v"(vb), "i"(OFF) : "memory"); return r;
}
template <int D0> __device__ __forceinline__ void pv_one(f32x16& od, int vb, bf16x8 pa0, bf16x8 pa1, bf16x8 pa2, bf16x8 pa3) {
  const s16x4 l0 = tr_read<v_rd_off(D0, 0, 0)>(vb), h0 = tr_read<v_rd_off(D0, 0, 1)>(vb), l1 = tr_read<v_rd_off(D0, 1, 0)>(vb), h1 = tr_read<v_rd_off(D0, 1, 1)>(vb);
  const s16x4 l2 = tr_read<v_rd_off(D0, 2, 0)>(vb), h2 = tr_read<v_rd_off(D0, 2, 1)>(vb), l3 = tr_read<v_rd_off(D0, 3, 0)>(vb), h3 = tr_read<v_rd_off(D0, 3, 1)>(vb);
  asm volatile("s_waitcnt lgkmcnt(0)" ::: "memory"); SBAR();
#define PK(L, H) (bf16x8){L[0], L[1], L[2], L[3], H[0], H[1], H[2], H[3]}
  od = __builtin_amdgcn_mfma_f32_32x32x16_bf16(pa0, PK(l0, h0), od, 0, 0, 0);
  od = __builtin_amdgcn_mfma_f32_32x32x16_bf16(pa1, PK(l1, h1), od, 0, 0, 0);
  od = __builtin_amdgcn_mfma_f32_32x32x16_bf16(pa2, PK(l2, h2), od, 0, 0, 0);
  od = __builtin_amdgcn_mfma_f32_32x32x16_bf16(pa3, PK(l3, h3), od, 0, 0, 0);
#undef PK
}
__device__ __forceinline__ void pv_d0(f32x16* o, int vb, bf16x8 pa0, bf16x8 pa1, bf16x8 pa2, bf16x8 pa3) {
  pv_one<0>(o[0], vb, pa0, pa1, pa2, pa3); pv_one<1>(o[1], vb, pa0, pa1, pa2, pa3); pv_one<2>(o[2], vb, pa0, pa1, pa2, pa3); pv_one<3>(o[3], vb, pa0, pa1, pa2, pa3);
}
__device__ __forceinline__ void attn_dense_body(const unsigned short* __restrict__ Qraw, const float* __restrict__ qgain, const float* __restrict__ rope, int t0,
                                                const bf16* __restrict__ Kh, const bf16* __restrict__ Vh, unsigned short* __restrict__ Ob, int seq, char* lds) {
  using St = Stage<bf16>;
  const int tid = threadIdx.x, wid = tid >> 6, lane = tid & 63, r32 = lane & 31, hi = lane >> 5;
  bf16* V_lds = (bf16*)lds; bf16* K_lds = (bf16*)(lds + 2 * SHM_V);
  float* ws = (float*)(lds + 2 * SHM_V + 2 * SHM_K) + wid * 64; float* li_l = ws; float* al_l = ws + 32;
  float m_reg = -1e30f, l_reg = 0; f32x16 o[4] = {}; bf16x8 qr[8];
  { const unsigned short* Qw = Qraw + (long)(wid * QBLK + r32) * LDQ + hi * 8;
    float xf[8][8]; float ss = 0.f;
#pragma unroll
    for (int d0 = 0; d0 < 8; ++d0) { const u32x4 w = *reinterpret_cast<const u32x4*>(Qw + d0 * 16);
#pragma unroll
      for (int j = 0; j < 4; ++j) { xf[d0][2 * j] = __uint_as_float(w[j] << 16); xf[d0][2 * j + 1] = __uint_as_float(w[j] & 0xffff0000u); }
#pragma unroll
      for (int j = 0; j < 8; ++j) ss += xf[d0][j] * xf[d0][j]; }
    { auto rr = __builtin_amdgcn_permlane32_swap(__float_as_uint(ss), __float_as_uint(ss), false, false); ss = __uint_as_float(rr[0]) + __uint_as_float(rr[1]); }
    const float rn = 1.f / sqrtf(ss * (1.f / 128.f) + 1e-6f);
#pragma unroll
    for (int d0 = 0; d0 < 8; ++d0) { const float4 g0 = *reinterpret_cast<const float4*>(qgain + d0 * 16 + hi * 8), g1 = *reinterpret_cast<const float4*>(qgain + d0 * 16 + hi * 8 + 4);
      xf[d0][0] *= rn * g0.x; xf[d0][1] *= rn * g0.y; xf[d0][2] *= rn * g0.z; xf[d0][3] *= rn * g0.w; xf[d0][4] *= rn * g1.x; xf[d0][5] *= rn * g1.y; xf[d0][6] *= rn * g1.z; xf[d0][7] *= rn * g1.w; }
    if (t0 >= 0) { const int t = t0 + wid * QBLK + r32;
#pragma unroll
      for (int a = 0; a < 2; ++a) { const int pos = a ? (t & 63) : (t >> 6);
#pragma unroll
        for (int hh = 0; hh < 2; ++hh) { const int d1 = 4 * a + hh, d2 = d1 + 2; const float* rp = rope + (long)(pos * 32 + hh * 16 + hi * 8) * 2;
#pragma unroll
          for (int jj = 0; jj < 4; ++jj) { const float4 cs = *reinterpret_cast<const float4*>(rp + 4 * jj);
            { const float y1 = xf[d1][2 * jj], y2 = xf[d2][2 * jj]; xf[d1][2 * jj] = y1 * cs.x - y2 * cs.y; xf[d2][2 * jj] = y1 * cs.y + y2 * cs.x; }
            { const float y1 = xf[d1][2 * jj + 1], y2 = xf[d2][2 * jj + 1]; xf[d1][2 * jj + 1] = y1 * cs.z - y2 * cs.w; xf[d2][2 * jj + 1] = y1 * cs.w + y2 * cs.z; } } } } }
#pragma unroll
    for (int d0 = 0; d0 < 8; ++d0) { u32x4 w = {cvtpk(xf[d0][0], xf[d0][1]), cvtpk(xf[d0][2], xf[d0][3]), cvtpk(xf[d0][4], xf[d0][5]), cvtpk(xf[d0][6], xf[d0][7])}; qr[d0] = *reinterpret_cast<bf16x8*>(&w); } }
  const int sr = tid >> 4, sc = (tid & 15) * 8, vst0 = v_st(sr, sc), vst1 = v_st(32 + sr, sc);
  const int vb0 = (int)(uintptr_t)V_lds + v_rd_base(lane);
  struct { typename St::T vs0, vs1, ks0, ks1; } sr_[SDEPTH];
#define SLOAD(i, k0) do { sr_[i].vs0 = St::ld8(&Vh[(long)((k0) + sr) * LDK + sc]); sr_[i].vs1 = St::ld8(&Vh[(long)((k0) + 32 + sr) * LDK + sc]); \
    sr_[i].ks0 = St::ld8(&Kh[(long)((k0) + sr) * LDK + sc]); sr_[i].ks1 = St::ld8(&Kh[(long)((k0) + 32 + sr) * LDK + sc]); } while (0)
#define SWRITE(b, i) do { *(bf16x8*)((char*)V_lds + (b) * SHM_V + vst0) = St::tobf(sr_[i].vs0);          \
    *(bf16x8*)((char*)V_lds + (b) * SHM_V + vst1) = St::tobf(sr_[i].vs1); int kc = sc * 2;               \
    *(bf16x8*)((char*)K_lds + (b) * SHM_K + KSWZ(sr, kc)) = St::tobf(sr_[i].ks0);                       \
    *(bf16x8*)((char*)K_lds + (b) * SHM_K + KSWZ(32 + sr, kc)) = St::tobf(sr_[i].ks1); } while (0)
#define SWAIT() do { if constexpr (SDEPTH == 2) asm volatile("s_waitcnt vmcnt(4)" ::: "memory"); else asm volatile("s_waitcnt vmcnt(0)" ::: "memory"); } while (0)
#define RESC(a) do { if (__any((a) < 1.f)) { if (hi == 0) al_l[r32] = (a); asm volatile("s_waitcnt lgkmcnt(0)" ::: "memory"); \
    for (int d = 0; d < 4; ++d) for (int r = 0; r < 16; ++r) o[d][r] *= al_l[crow(r, hi)]; } } while (0)
  f32x16 pA0, pA1, pB0, pB1; float mnA, mnB, alA, alB; bf16x8 pa0, pa1, pa2, pa3; const int NT = seq / KVBLK;
  constexpr int SE = 0, SO = SDEPTH - 1;
  SLOAD(SE, 0); asm volatile("s_waitcnt vmcnt(0)" ::: "memory"); SWRITE(0, SE); __syncthreads();
  qkt(pA0, pA1, K_lds, qr, r32, hi); partialSM(pA0, pA1, m_reg, mnA, alA);
  SLOAD(SO, KVBLK); if constexpr (SDEPTH == 2) { if (2 < NT) SLOAD(SE, 2 * KVBLK); }
  SWAIT(); SWRITE(1, SO); __syncthreads();
  for (int j = 1; j + 1 < NT; j += 2) {
    SBAR(); qkt(pB0, pB1, (bf16*)((char*)K_lds + SHM_K), qr, r32, hi);
    finishSM(pA0, pA1, alA, l_reg, pa0, pa1, pa2, pa3); SBAR();
    SLOAD(SO, (j + SDEPTH) * KVBLK); SBAR();
    pv_d0(o, vb0, pa0, pa1, pa2, pa3); partialSM(pB0, pB1, m_reg, mnB, alB);
    __syncthreads(); SWAIT(); SWRITE(0, SE);
    RESC(alB); __syncthreads();
    SBAR(); qkt(pA0, pA1, K_lds, qr, r32, hi);
    finishSM(pB0, pB1, alB, l_reg, pa0, pa1, pa2, pa3); SBAR();
    if (SDEPTH == 1 || j + 3 < NT) SLOAD(SE, (j + 1 + SDEPTH) * KVBLK); SBAR();
    pv_d0(o, vb0 + (int)SHM_V, pa0, pa1, pa2, pa3); partialSM(pA0, pA1, m_reg, mnA, alA);
    __syncthreads(); SWAIT(); SWRITE(1, SO);
    RESC(alA); __syncthreads();
  }
  SBAR(); qkt(pB0, pB1, (bf16*)((char*)K_lds + SHM_K), qr, r32, hi);
  finishSM(pA0, pA1, alA, l_reg, pa0, pa1, pa2, pa3); SBAR();
  pv_d0(o, vb0, pa0, pa1, pa2, pa3); partialSM(pB0, pB1, m_reg, mnB, alB);
  __syncthreads(); RESC(alB);
  finishSM(pB0, pB1, alB, l_reg, pa0, pa1, pa2, pa3); SBAR();
  pv_d0(o, vb0 + (int)SHM_V, pa0, pa1, pa2, pa3);
  if (hi == 0) li_l[r32] = l_reg; asm volatile("s_waitcnt lgkmcnt(0)" ::: "memory");
  float rli[16];
#pragma unroll
  for (int r = 0; r < 16; ++r) rli[r] = __builtin_amdgcn_rcpf(li_l[crow(r, hi)]);
  unsigned short* Ow = Ob + (long)(wid * QBLK) * LDO;
#pragma unroll
  for (int r = 0; r < 16; ++r) { int orow = crow(r, hi);
    for (int d0 = 0; d0 < 4; ++d0) Ow[(long)orow * LDO + d0 * 32 + r32] = f2bf16(o[d0][r] * rli[r]); }
#undef SLOAD
#undef SWRITE
#undef SWAIT
#undef RESC
}
}
#define GAS __attribute__((address_space(1)))
#define LAS __attribute__((address_space(3)))
typedef unsigned short bf16r;
typedef float f32x4 __attribute__((ext_vector_type(4)));
typedef unsigned u32x4 __attribute__((ext_vector_type(4)));
typedef unsigned u32x2 __attribute__((ext_vector_type(2)));
typedef short bf16x8 __attribute__((ext_vector_type(8)));

constexpr int DM = 2048, NB = 4, SEQ = 4096, CTX = 256, NLAT = NB * SEQ, NCTX = NB * CTX, NROW = NLAT + NCTX;
constexpr int INC = 3584, DFF = 8192, NMODC = 6 * DM, KVLEN = CTX + SEQ;
constexpr int NLAYER = 2;
constexpr float LN_EPS = 1e-6f, RMS_EPS = 1e-6f, DN_ALPHA = 1.4142135623730951f;
constexpr size_t MiB = 1u << 20;
constexpr size_t WS_ROPE = 0, WS_BAR = 768 * 1024, WS_BAR_BYTES = 16384, WS_STAT = 576 * 1024, WS_MOD = 64 * 1024, WS_WIN = 1 * MiB, WS_WOUT = 29 * MiB, WS_WFF1 = 45 * MiB, WS_WFF2 = 109 * MiB;
constexpr size_t WS_X = 173 * MiB, WS_H = 309 * MiB, WS_S = 377 * MiB;
constexpr size_t WS_P = WS_S, WS_Q = 496 * MiB, WS_K = 530 * MiB, WS_V = 539 * MiB, WS_MIX = 548 * MiB, WS_ACT = WS_S, WS_PART = 649 * MiB, WS_END = 713 * MiB;
static_assert(WS_WIN + 2ull * INC * DM * 2 <= WS_WOUT && WS_WOUT + 2ull * DM * DM * 2 <= WS_WFF1 && WS_WFF1 + 2ull * DFF * DM * 2 <= WS_WFF2 && WS_WFF2 + 2ull * DFF * DM * 2 <= WS_X, "ws weights");
static_assert(WS_X + (size_t)NROW * DM * 4 <= WS_H && WS_H + (size_t)NROW * DM * 2 <= WS_S && WS_P + (size_t)NROW * INC * 2 <= WS_Q && WS_Q + (size_t)NROW * 1024 * 2 <= WS_K, "ws act 1");
static_assert(WS_K + (size_t)NB * 2 * KVLEN * 128 * 2 <= WS_V && WS_V + (size_t)NB * 2 * KVLEN * 128 * 2 <= WS_MIX && WS_MIX + (size_t)NROW * DM * 2 <= WS_PART && WS_ACT + (size_t)NROW * DFF * 2 <= WS_PART && WS_PART + 8ull * NCTX * DM * 4 <= WS_END, "ws act 2");
static_assert(WS_MOD + 2ull * 5 * NMODC * 4 <= WS_STAT && WS_STAT + (size_t)NROW * 8 <= WS_BAR && WS_BAR + WS_BAR_BYTES <= WS_WIN, "ws mod");
constexpr int LDS_BYTES = 147456;

__device__ __forceinline__ unsigned f2bf(float f) { unsigned u = __builtin_bit_cast(unsigned, f); return (u + 0x7fffu + ((u >> 16) & 1u)) >> 16; }
__device__ __forceinline__ unsigned pk2(float lo, float hi) { return f2bf(lo) | (f2bf(hi) << 16); }
__device__ __forceinline__ float bflo(unsigned w) { return __builtin_bit_cast(float, w << 16); }
__device__ __forceinline__ float bfhi(unsigned w) { return __builtin_bit_cast(float, w & 0xffff0000u); }
__device__ __forceinline__ void unpack8(const u32x4 w, float (&x)[8]) { x[0] = bflo(w.x); x[1] = bfhi(w.x); x[2] = bflo(w.y); x[3] = bfhi(w.y); x[4] = bflo(w.z); x[5] = bfhi(w.z); x[6] = bflo(w.w); x[7] = bfhi(w.w); }
__device__ __forceinline__ u32x4 pack8(const float (&x)[8]) { u32x4 w; w.x = pk2(x[0], x[1]); w.y = pk2(x[2], x[3]); w.z = pk2(x[4], x[5]); w.w = pk2(x[6], x[7]); return w; }
__device__ __forceinline__ float wave_sum(float v) {
#pragma unroll
    for (int o = 1; o < 64; o <<= 1) v += __shfl_xor(v, o);
    return v;
}
__device__ __forceinline__ float gelu_tanh(float x) {
    const float u = 0.7978845608028654f * (x + 0.044715f * x * x * x);
    const float e = __expf(2.f * u);
    const float t = 1.f - 2.f * __builtin_amdgcn_rcpf(e + 1.f);
    return 0.5f * x * (1.f + t);
}
__device__ __forceinline__ float sigmoidf_(float x) { return __builtin_amdgcn_rcpf(1.f + __expf(-x)); }
#define LDS_WAIT() asm volatile("s_waitcnt lgkmcnt(0)" ::: "memory")

static __device__ const double ROPE_FREQ[32] = {1.0, 0.7498942093324559, 0.5623413251903491, 0.4216965034285822, 0.31622776601683794, 0.23713737056616552, 0.1778279410038923, 0.1333521432163324, 0.1, 0.07498942093324558, 0.05623413251903491, 0.042169650342858224, 0.03162277660168379, 0.023713737056616554, 0.01778279410038923, 0.01333521432163324, 0.01, 0.007498942093324558, 0.005623413251903491, 0.004216965034285823, 0.0031622776601683794, 0.0023713737056616554, 0.0017782794100389228, 0.001333521432163324, 0.001, 0.0007498942093324559, 0.0005623413251903491, 0.00042169650342858224, 0.00031622776601683794, 0.00023713737056616554, 0.00017782794100389227, 0.0001333521432163324};

__device__ __forceinline__ void p0_rope(float* rope, int gtid, int gthreads) {
    for (int idx = gtid; idx < 64 * 32; idx += gthreads) {
        const int p = idx >> 5, f = idx & 31;
        const double ang = (double)p * ROPE_FREQ[f];
        const double k = __builtin_rint(ang * 0.15915494309189535);
        const double r = ang - k * 6.283185307179586;
        const double r2 = r * r; double tc = 1.0, ts = 1.0, cc = 1.0, ss = 1.0;
#pragma unroll
        for (int n = 1; n <= 14; ++n) { tc *= -r2 * (1.0 / (double)((2 * n - 1) * (2 * n))); cc += tc; ts *= -r2 * (1.0 / (double)((2 * n) * (2 * n + 1))); ss += ts; }
        rope[2 * idx] = (float)cc; rope[2 * idx + 1] = (float)(r * ss);
    }
}
__device__ __forceinline__ void p0_mod(LAS unsigned char* lds, const float* c, const float* c_ctx, const float* w_mod, const float* b_mod, float* MOD, int item0, int nitem, int bid, int G, int tid) {
    const int NITEM = item0 + nitem;
    if (bid < 0 || bid >= nitem) return;
    LAS float* condS = (LAS float*)lds;
    LAS float* red = (LAS float*)(lds + 5 * 2048 * 4);
    for (int i = tid; i < 5 * 2048; i += 512) { const int r = i >> 11, k = i & 2047; const float cv = (r < 4) ? c[r * 2048 + k] : c_ctx[k]; condS[i] = cv / (1.f + __expf(-cv)); }
    __syncthreads();
    const int kr = tid >> 5, cl = tid & 31;
    for (int item = item0 + bid; item < NITEM; item += G) {
        const int l = item / (NMODC / 128), n0 = (item % (NMODC / 128)) * 128;
        const float* wp = w_mod + ((size_t)l * 2048 + kr) * NMODC + n0 + 4 * cl;
        float acc[5][4];
#pragma unroll
        for (int r = 0; r < 5; ++r)
#pragma unroll
            for (int j = 0; j < 4; ++j) acc[r][j] = 0.f;
#pragma unroll 4
        for (int ks = 0; ks < 128; ++ks) {
            const f32x4 w = *(const f32x4*)(wp + (size_t)ks * 16 * NMODC); const int k = ks * 16 + kr;
#pragma unroll
            for (int r = 0; r < 5; ++r) { const float s = condS[r * 2048 + k];
#pragma unroll
                for (int j = 0; j < 4; ++j) acc[r][j] += s * w[j]; }
        }
#pragma unroll
        for (int r = 0; r < 5; ++r)
#pragma unroll
            for (int j = 0; j < 4; ++j) red[(kr * 32 + cl) * 20 + r * 4 + j] = acc[r][j];
        __syncthreads();
        for (int o = tid; o < 5 * 128; o += 512) { const int r = o >> 7, col = o & 127; float s = 0.f;
#pragma unroll
            for (int k2 = 0; k2 < 16; ++k2) s += red[(k2 * 32 + (col >> 2)) * 20 + r * 4 + (col & 3)];
            MOD[((size_t)l * 5 + r) * NMODC + n0 + col] = s + b_mod[(size_t)l * NMODC + n0 + col]; }
        __syncthreads();
    }
}
__device__ __forceinline__ void p0_transpose_item(const float* W, int K, int N, bf16r* WT, LAS float* scr, int item, int lane) {
    const int nblk = N / 64, kb = item / nblk, nb = item % nblk, k0 = 64 * kb, n0 = 64 * nb;
    const int r4 = lane >> 4, c4 = (lane & 15) * 4;
    f32x4 v[16];
#pragma unroll
    for (int i = 0; i < 16; ++i) v[i] = *(const f32x4*)(W + (size_t)(k0 + 4 * i + r4) * N + n0 + c4);
#pragma unroll
    for (int i = 0; i < 16; ++i) { LAS float* d = scr + (4 * i + r4) * 65 + c4; d[0] = v[i].x; d[1] = v[i].y; d[2] = v[i].z; d[3] = v[i].w; }
    LDS_WAIT(); asm volatile("" ::: "memory");
    const int c = lane & 7;
#pragma unroll
    for (int j = 0; j < 8; ++j) { const int n = (lane >> 3) + 8 * j; const LAS float* s = scr + (8 * c) * 65 + n;
        u32x4 o; o.x = pk2(s[0 * 65], s[1 * 65]); o.y = pk2(s[2 * 65], s[3 * 65]); o.z = pk2(s[4 * 65], s[5 * 65]); o.w = pk2(s[6 * 65], s[7 * 65]);
        *(u32x4*)(WT + (size_t)(n0 + n) * K + k0 + 8 * c) = o; }
    LDS_WAIT(); asm volatile("" ::: "memory");
}

__device__ __forceinline__ void row_stats(const f32x4 (&v)[8], float& mean, float& rstd) {
    float s = 0.f;
#pragma unroll
    for (int j = 0; j < 8; ++j) s += (v[j].x + v[j].y) + (v[j].z + v[j].w);
    mean = wave_sum(s) * (1.f / DM); float q = 0.f;
#pragma unroll
    for (int j = 0; j < 8; ++j) { const f32x4 d = v[j] - mean; q += (d.x * d.x + d.y * d.y) + (d.z * d.z + d.w * d.w); }
    rstd = 1.f / sqrtf(wave_sum(q) * (1.f / DM) + LN_EPS);
}
__device__ __forceinline__ void row_pass(const float* src_lat, const float* src_ctx, int nrows, const float* lng, const float* lnb, float* dst_lat, float* dst_ctx, float* stat,
                                         const float* modl  , int shift_off, int scale_off, bf16r* H, int gw, int NGW, int lane) {
    f32x4 v[8], vn[8];
    if (gw < nrows) { const float* sp = gw < NLAT ? src_lat + (size_t)gw * DM : src_ctx + (size_t)(gw - NLAT) * DM;
#pragma unroll
        for (int j = 0; j < 8; ++j) v[j] = *((const f32x4*)sp + 64 * j + lane); }
    for (int row = gw; row < nrows; row += NGW) {
        const bool lat = row < NLAT;
        const int rown = row + NGW;
        if (rown < nrows) { const float* sp = rown < NLAT ? src_lat + (size_t)rown * DM : src_ctx + (size_t)(rown - NLAT) * DM;
#pragma unroll
            for (int j = 0; j < 8; ++j) vn[j] = *((const f32x4*)sp + 64 * j + lane); }
        float mean, rstd;
        if (lng) {
            row_stats(v, mean, rstd);
            if (stat && lane == 0) { stat[2 * (size_t)row] = mean; stat[2 * (size_t)row + 1] = rstd; }
            float* dp = lat ? (dst_lat ? dst_lat + (size_t)row * DM : nullptr) : (dst_ctx ? dst_ctx + (size_t)(row - NLAT) * DM : nullptr);
#pragma unroll
            for (int j = 0; j < 8; ++j) { const f32x4 g = *((const f32x4*)lng + 64 * j + lane), b = *((const f32x4*)lnb + 64 * j + lane);
                v[j] = (v[j] - mean) * rstd * g + b; if (dp) *((f32x4*)dp + 64 * j + lane) = v[j]; }
        }
        if (modl) {
            row_stats(v, mean, rstd);
            const float* mr = modl + (size_t)(lat ? (row >> 12) : 4) * NMODC;
            bf16r* hp = H + (size_t)row * DM;
#pragma unroll
            for (int j = 0; j < 8; ++j) { const f32x4 sh = *((const f32x4*)(mr + shift_off) + 64 * j + lane), sc = *((const f32x4*)(mr + scale_off) + 64 * j + lane);
                const f32x4 o = (v[j] - mean) * rstd * (sc + 1.f) + sh; u32x2 w; w.x = pk2(o.x, o.y); w.y = pk2(o.z, o.w);
                *((u32x2*)hp + 64 * j + lane) = w; }
        }
#pragma unroll
        for (int j = 0; j < 8; ++j) v[j] = vn[j];
    }
}
__device__ __forceinline__ void row_pass_ctx(const float* src, const float* bstat, const float* bg, const float* bb, const float* part, const float* gate  , float* xdst,
                                             const float* lng, const float* lnb, float* stat, const float* modl, int shift_off, int scale_off, bf16r* H, int gw, int NGW, int lane) {
    for (int r = gw; r < NCTX; r += NGW) {
        const int row = NLAT + r;
        f32x4 v[8];
        float bm = 0.f, brs = 1.f; if (bstat) { bm = bstat[2 * (size_t)row]; brs = bstat[2 * (size_t)row + 1]; }
#pragma unroll
        for (int j = 0; j < 8; ++j) { f32x4 x = *((const f32x4*)(src + (size_t)r * DM) + 64 * j + lane);
            if (bstat) x = (x - bm) * brs * *((const f32x4*)bg + 64 * j + lane) + *((const f32x4*)bb + 64 * j + lane);
            f32x4 s = *((const f32x4*)(part + (size_t)r * DM) + 64 * j + lane);
#pragma unroll
            for (int k = 1; k < 8; ++k) s += *((const f32x4*)(part + ((size_t)k * NCTX + r) * DM) + 64 * j + lane);
            v[j] = x * DN_ALPHA + *((const f32x4*)gate + 64 * j + lane) * s;
            if (xdst) *((f32x4*)(xdst + (size_t)r * DM) + 64 * j + lane) = v[j]; }
        float mean, rstd;
        row_stats(v, mean, rstd);
        if (lane == 0) { stat[2 * (size_t)row] = mean; stat[2 * (size_t)row + 1] = rstd; }
#pragma unroll
        for (int j = 0; j < 8; ++j) v[j] = (v[j] - mean) * rstd * *((const f32x4*)lng + 64 * j + lane) + *((const f32x4*)lnb + 64 * j + lane);
        row_stats(v, mean, rstd);
        const float* mr = modl + (size_t)4 * NMODC;
        bf16r* hp = H + (size_t)row * DM;
#pragma unroll
        for (int j = 0; j < 8; ++j) { const f32x4 sh = *((const f32x4*)(mr + shift_off) + 64 * j + lane), sc = *((const f32x4*)(mr + scale_off) + 64 * j + lane);
            const f32x4 o = (v[j] - mean) * rstd * (sc + 1.f) + sh; u32x2 w; w.x = pk2(o.x, o.y); w.y = pk2(o.z, o.w);
            *((u32x2*)hp + 64 * j + lane) = w; }
    }
}

__device__ __forceinline__ f32x4 ld4_bf(const bf16r* p) { const u32x2 w = *(const u32x2*)p; return (f32x4){bflo(w.x), bfhi(w.x), bflo(w.y), bfhi(w.y)}; }
__device__ __forceinline__ void st4_bf(bf16r* p, const f32x4 o) { u32x2 w; w.x = pk2(o.x, o.y); w.y = pk2(o.z, o.w); *(u32x2*)p = w; }
typedef _Float16 h16x4 __attribute__((ext_vector_type(4)));
__device__ __forceinline__ f32x4 ld4_h(const bf16r* p) { const h16x4 h = *(const h16x4*)p; return __builtin_convertvector(h, f32x4); }
__device__ __forceinline__ void st4_h(bf16r* p, const f32x4 o) { *(h16x4*)p = __builtin_convertvector(o, h16x4); }
typedef _Float16 h16x8 __attribute__((ext_vector_type(8)));
typedef float f32x8v __attribute__((ext_vector_type(8)));
__device__ __forceinline__ void ld8_h(const bf16r* p, f32x4& a, f32x4& b) { const h16x8 h = *(const h16x8*)p; const f32x8v f = __builtin_convertvector(h, f32x8v); a = (f32x4){f[0], f[1], f[2], f[3]}; b = (f32x4){f[4], f[5], f[6], f[7]}; }
__device__ __forceinline__ void st8_h(bf16r* p, const f32x4 a, const f32x4 b) { const f32x8v f = {a.x, a.y, a.z, a.w, b.x, b.y, b.z, b.w}; *(h16x8*)p = __builtin_convertvector(f, h16x8); }
__device__ __forceinline__ void ld8_bf(const bf16r* p, f32x4& a, f32x4& b) { const u32x4 w = *(const u32x4*)p; a = (f32x4){bflo(w.x), bfhi(w.x), bflo(w.y), bfhi(w.y)}; b = (f32x4){bflo(w.z), bfhi(w.z), bflo(w.w), bfhi(w.w)}; }
__device__ __forceinline__ void st8_bf(bf16r* p, const f32x4 a, const f32x4 b) { u32x4 w; w.x = pk2(a.x, a.y); w.y = pk2(a.z, a.w); w.z = pk2(b.x, b.y); w.w = pk2(b.z, b.w); *(u32x4*)p = w; }
template <bool SRC_F32, bool OUT_F32>
__device__ __forceinline__ void row_pass_res(LAS unsigned char* lds, const float* srcf, const bf16r* XSi, const bf16r* Y, int nrows, const float* modl_cur, int gate_off, const float* lng, const float* lnb,
                                             bf16r* XSo, float* outf, const float* modl_next, int shift_off, int scale_off, bf16r* H, int gw, int NGW, int lane) {
    constexpr int wpb = 512;
    if (NGW != wpb * NB || nrows != NLAT) return;
    const int b = gw >> 9, w0 = gw & 511;
    LAS f32x4* V = (LAS f32x4*)lds;
    { const float* gp = modl_cur + (size_t)b * NMODC + gate_off; const float* mr = modl_next ? modl_next + (size_t)b * NMODC : modl_cur;
      const int t = threadIdx.x;
      V[t] = *(const f32x4*)(gp + 4 * t); V[512 + t] = *(const f32x4*)(lng + 4 * t); V[1024 + t] = *(const f32x4*)(lnb + 4 * t);
      if (modl_next) { V[1536 + t] = *(const f32x4*)(mr + scale_off + 4 * t) + 1.f; V[2048 + t] = *(const f32x4*)(mr + shift_off + 4 * t); } }
    __syncthreads();
#pragma unroll 1
    for (int rr = w0; rr < SEQ; rr += wpb) {
        const int row = b * SEQ + rr;
        f32x4 v[8];
#pragma unroll
        for (int j = 0; j < 4; ++j) { const int q = 2 * (64 * j + lane), e = 4 * q;
            f32x4 x0, x1, y0, y1;
            if (SRC_F32) { x0 = *(const f32x4*)(srcf + (size_t)row * DM + e); x1 = *(const f32x4*)(srcf + (size_t)row * DM + e + 4); } else ld8_h(XSi + (size_t)row * DM + e, x0, x1);
            ld8_bf(Y + (size_t)row * DM + e, y0, y1);
            v[2 * j] = x0 * DN_ALPHA + V[q] * y0; v[2 * j + 1] = x1 * DN_ALPHA + V[q + 1] * y1; }
        float mean, rstd; row_stats(v, mean, rstd);
#pragma unroll
        for (int j = 0; j < 4; ++j) { const int q = 2 * (64 * j + lane), e = 4 * q;
            v[2 * j] = (v[2 * j] - mean) * rstd * V[512 + q] + V[1024 + q]; v[2 * j + 1] = (v[2 * j + 1] - mean) * rstd * V[512 + q + 1] + V[1024 + q + 1];
            if (OUT_F32) { *(f32x4*)(outf + (size_t)row * DM + e) = v[2 * j]; *(f32x4*)(outf + (size_t)row * DM + e + 4) = v[2 * j + 1]; } else st8_h(XSo + (size_t)row * DM + e, v[2 * j], v[2 * j + 1]); }
        if (modl_next) { row_stats(v, mean, rstd);
#pragma unroll
            for (int j = 0; j < 4; ++j) { const int q = 2 * (64 * j + lane), e = 4 * q;
                const f32x4 o0 = (v[2 * j] - mean) * rstd * V[1536 + q] + V[2048 + q], o1 = (v[2 * j + 1] - mean) * rstd * V[1536 + q + 1] + V[2048 + q + 1];
                st8_bf(H + (size_t)row * DM + e, o0, o1); } }
    }
    __syncthreads();
}
template <bool SRC_F32>
__device__ __forceinline__ void row_pass_ctx_res(const float* srcf, bf16r* XS, const float* part, const float* gate, const float* lng, const float* lnb, bool write_xs,
                                                 const float* modl_next, int shift_off, int scale_off, bf16r* H, int gw, int NGW, int lane) {
    for (int r = gw; r < NCTX; r += NGW) {
        const int row = NLAT + r; f32x4 v[8];
#pragma unroll
        for (int j = 0; j < 8; ++j) { const int e = 4 * (64 * j + lane);
            f32x4 xp; if (SRC_F32) xp = *(const f32x4*)(srcf + (size_t)r * DM + e); else xp = ld4_h(XS + (size_t)row * DM + e);
            const bf16r* p16 = (const bf16r*)part;
            f32x4 s = ld4_h(p16 + (size_t)r * DM + e);
#pragma unroll
            for (int k = 1; k < 8; ++k) s += ld4_h(p16 + ((size_t)k * NCTX + r) * DM + e);
            v[j] = xp * DN_ALPHA + *(const f32x4*)(gate + e) * s; }
        float mean, rstd; row_stats(v, mean, rstd);
#pragma unroll
        for (int j = 0; j < 8; ++j) { const int e = 4 * (64 * j + lane);
            v[j] = (v[j] - mean) * rstd * *(const f32x4*)(lng + e) + *(const f32x4*)(lnb + e);
            if (write_xs) st4_h(XS + (size_t)row * DM + e, v[j]); }
        row_stats(v, mean, rstd); const float* mr = modl_next + (size_t)4 * NMODC;
#pragma unroll
        for (int j = 0; j < 8; ++j) { const int e = 4 * (64 * j + lane);
            const f32x4 o = (v[j] - mean) * rstd * (*(const f32x4*)(mr + scale_off + e) + 1.f) + *(const f32x4*)(mr + shift_off + e);
            st4_bf(H + (size_t)row * DM + e, o); }
    }
}

__device__ __forceinline__ void row_pass0(LAS unsigned char* lds, const float* x_in, const float* ctx_in, const float* mod0  , bf16r* H, int gw, int NGW, int lane) {
    constexpr int wpb = 512;
    if (NGW != wpb * NB) { row_pass(x_in, ctx_in, NROW, nullptr, nullptr, nullptr, nullptr, nullptr, mod0, 0 * DM, 1 * DM, H, gw, NGW, lane); return; }
    const int b = gw >> 9, w0 = gw & 511;
    LAS f32x4* V = (LAS f32x4*)lds;
    { const float* mr = mod0 + (size_t)b * NMODC; const int t = threadIdx.x;
      V[t] = *(const f32x4*)(mr + 1 * DM + 4 * t) + 1.f; V[512 + t] = *(const f32x4*)(mr + 0 * DM + 4 * t); }
    __syncthreads();
#pragma unroll 1
    for (int rr = w0; rr < SEQ; rr += wpb) {
        const int row = b * SEQ + rr; f32x4 v[8];
#pragma unroll
        for (int j = 0; j < 8; ++j) v[j] = *(const f32x4*)(x_in + (size_t)row * DM + 4 * (64 * j + lane));
        float mean, rstd; row_stats(v, mean, rstd);
#pragma unroll
        for (int j = 0; j < 8; ++j) { const f32x4 o = (v[j] - mean) * rstd * V[64 * j + lane] + V[512 + 64 * j + lane]; st4_bf(H + (size_t)row * DM + 4 * (64 * j + lane), o); }
    }
    __syncthreads();
    const float* mr = mod0 + (size_t)4 * NMODC;
    for (int r = gw; r < NCTX; r += NGW) {
        const int row = NLAT + r; f32x4 v[8];
#pragma unroll
        for (int j = 0; j < 8; ++j) v[j] = *(const f32x4*)(ctx_in + (size_t)r * DM + 4 * (64 * j + lane));
        float mean, rstd; row_stats(v, mean, rstd);
#pragma unroll
        for (int j = 0; j < 8; ++j) { const int e = 4 * (64 * j + lane);
            const f32x4 o = (v[j] - mean) * rstd * (*(const f32x4*)(mr + 1 * DM + e) + 1.f) + *(const f32x4*)(mr + 0 * DM + e); st4_bf(H + (size_t)row * DM + e, o); }
    }
}

__device__ __forceinline__ void rms_rope_apply(const u32x4 w1, const u32x4 w2, const float (&g1)[8], const float (&g2)[8], const f32x4 (&rp)[4], bool rope_on, u32x4& o1w, u32x4& o2w) {
    float x1[8], x2[8]; unpack8(w1, x1); unpack8(w2, x2);
    float ss = 0.f;
#pragma unroll
    for (int j = 0; j < 8; ++j) ss += x1[j] * x1[j] + x2[j] * x2[j];
    ss += __shfl_xor(ss, 1); ss += __shfl_xor(ss, 2); ss += __shfl_xor(ss, 4);
    const float rn = 1.f / sqrtf(ss * (1.f / 128.f) + RMS_EPS);
    float o1[8], o2[8];
#pragma unroll
    for (int j = 0; j < 8; ++j) { const float y1 = x1[j] * rn * g1[j], y2 = x2[j] * rn * g2[j];
        float c = 1.f, s = 0.f; if (rope_on) { c = rp[j >> 1][(j & 1) * 2]; s = rp[j >> 1][(j & 1) * 2 + 1]; }
        o1[j] = y1 * c - y2 * s; o2[j] = y1 * s + y2 * c; }
    o1w = pack8(o1); o2w = pack8(o2);
}
__device__ __forceinline__ void prep_qkv(const bf16r* __restrict__ P, bf16r* __restrict__ Qb, bf16r* __restrict__ Kb, bf16r* __restrict__ Vb, const float* __restrict__ qg, const float* __restrict__ kg,
                                         const float* __restrict__ rope, int nrows, bool ctx_q, int gw, int NGW, int lane) {
    const int i = lane & 7, a = i >> 2, f0 = (i & 3) * 8, head = lane >> 3, kvh = (lane & 15) >> 3, vj = lane & 31;
    float gq1[8], gq2[8], gk1[8], gk2[8];
#pragma unroll
    for (int j = 0; j < 8; ++j) { gq1[j] = qg[a * 64 + f0 + j]; gq2[j] = qg[a * 64 + 32 + f0 + j]; gk1[j] = kg[a * 64 + f0 + j]; gk2[j] = kg[a * 64 + 32 + f0 + j]; }
    for (int row0 = gw * 2; row0 < nrows; row0 += NGW * 2) {
        u32x4 k1[2], k2[2], vv[2]; f32x4 rp[2][4];
#pragma unroll
        for (int r = 0; r < 2; ++r) { const int row = row0 + r; const bf16r* prow = P + (size_t)row * INC;
            const bool lat = row < NLAT; const int t = lat ? (row & 4095) : ((row - NLAT) & 255);
            const bf16r* ks = prow + 3072 + kvh * 128 + a * 64 + f0;
            k1[r] = *(const u32x4*)ks; k2[r] = *(const u32x4*)(ks + 32); vv[r] = *(const u32x4*)(prow + 3328 + vj * 8);
            const int pos = (a == 0) ? (t >> 6) : (t & 63); const float* rpp = rope + (size_t)(pos * 32 + f0) * 2;
#pragma unroll
            for (int jj = 0; jj < 4; ++jj) rp[r][jj] = *(const f32x4*)(rpp + 4 * jj); }
#pragma unroll
        for (int r = 0; r < 2; ++r) { const int row = row0 + r;
            const bool lat = row < NLAT; const int b = lat ? (row >> 12) : ((row - NLAT) >> 8), t = lat ? (row & 4095) : ((row - NLAT) & 255);
            const int posk = lat ? CTX + t : t;
            u32x4 o1, o2;
            rms_rope_apply(k1[r], k2[r], gk1, gk2, rp[r], lat, o1, o2);
            if (lane < 16) { bf16r* dst = Kb + ((size_t)(b * 2 + kvh) * KVLEN + posk) * 128 + a * 64 + f0; *(u32x4*)dst = o1; *(u32x4*)(dst + 32) = o2; }
            if (lane < 32) *(u32x4*)(Vb + ((size_t)(b * 2 + (vj >> 4)) * KVLEN + posk) * 128 + (vj & 15) * 8) = vv[r]; }
    }
}

__device__ __forceinline__ void gmlp_ldw(const float* __restrict__ Wh, int wave, int lane, f32x4 (&w)[8]) {
    const float* p = Wh + (size_t)(16 * wave + (lane & 15)) * 128 + 8 * (lane >> 4);
#pragma unroll
    for (int ks = 0; ks < 4; ++ks) { w[2 * ks] = *(const f32x4*)(p + ks * 32); w[2 * ks + 1] = *(const f32x4*)(p + ks * 32 + 4); }
}
__device__ __forceinline__ void gmlp_item(LAS unsigned char* lds, const bf16r* __restrict__ P, bf16r* __restrict__ MIX, const float* __restrict__ lng, const float* __restrict__ lnb,
                                          const float* __restrict__ Ws  , const float* __restrict__ bs  , int ch, int tid, int wave, int lane) {
    constexpr int LDT = 136;
    LAS bf16r* vT = (LAS bf16r*)lds;
    const int r0 = ch * 128;
    f32x4 wreg[8]; gmlp_ldw(Ws, wave, lane, wreg);
    { float gl[8], bl[8];
#pragma unroll
      for (int j = 0; j < 8; ++j) { gl[j] = lng[lane * 8 + j]; bl[j] = lnb[lane * 8 + j]; }
#pragma unroll
      for (int hb = 0; hb < 2; ++hb) {
        u32x4 raw[8];
#pragma unroll
        for (int i = 0; i < 8; ++i) raw[i] = *(const u32x4*)(P + (size_t)(r0 + wave + 8 * (hb * 8 + i)) * INC + 512 + lane * 8);
#pragma unroll
        for (int i = 0; i < 8; ++i) { const int q = wave + 8 * (hb * 8 + i);
            float x[8]; unpack8(raw[i], x);
            float s = 0.f;
#pragma unroll
            for (int j = 0; j < 8; ++j) { x[j] = gelu_tanh(x[j]); s += x[j]; }
            const float mean = wave_sum(s) * (1.f / 512.f); float qq = 0.f;
#pragma unroll
            for (int j = 0; j < 8; ++j) { const float d = x[j] - mean; qq += d * d; }
            const float rstd = __builtin_amdgcn_rsqf(wave_sum(qq) * (1.f / 512.f) + LN_EPS);
#pragma unroll
            for (int j = 0; j < 8; ++j) { const float v = (x[j] - mean) * rstd * gl[j] + bl[j]; vT[(lane * 8 + j) * LDT + (((q >> 3) ^ (lane & 15)) << 3) + (q & 7)] = (bf16r)f2bf(v); } }
      } }
    __syncthreads();
    const int p = 16 * wave + (lane & 15); const size_t row = (size_t)(r0 + p);
#pragma unroll 1
    for (int h = 0; h < 4; ++h) {
        bf16x8 bfr[4];
#pragma unroll
        for (int ks = 0; ks < 4; ++ks) { u32x4 t; t.x = pk2(wreg[2 * ks].x, wreg[2 * ks].y); t.y = pk2(wreg[2 * ks].z, wreg[2 * ks].w); t.z = pk2(wreg[2 * ks + 1].x, wreg[2 * ks + 1].y); t.w = pk2(wreg[2 * ks + 1].z, wreg[2 * ks + 1].w);
            bfr[ks] = __builtin_bit_cast(bf16x8, t); }
        if (h < 3) gmlp_ldw(Ws + (size_t)(h + 1) * 128 * 128, wave, lane, wreg);
        const float bsv = bs[h * 128 + p];
        u32x2 uw[8];
#pragma unroll
        for (int dt = 0; dt < 8; ++dt) uw[dt] = *(const u32x2*)(P + row * INC + h * 128 + 16 * dt + 4 * (lane >> 4));
#pragma unroll
        for (int dt = 0; dt < 8; ++dt) {
            pg8::f32x4 acc = {0.f, 0.f, 0.f, 0.f};
#pragma unroll
            for (int ks = 0; ks < 4; ++ks) { const int c = h * 128 + 16 * dt + (lane & 15); const bf16x8 af = *(const LAS bf16x8*)(vT + c * LDT + (((ks * 4 + (lane >> 4)) ^ ((c >> 3) & 15)) << 3));
                acc = __builtin_amdgcn_mfma_f32_16x16x32_bf16(af, bfr[ks], acc, 0, 0, 0); }
            const float u0 = gelu_tanh(bflo(uw[dt].x)), u1 = gelu_tanh(bfhi(uw[dt].x)), u2 = gelu_tanh(bflo(uw[dt].y)), u3 = gelu_tanh(bfhi(uw[dt].y));
            u32x2 o; o.x = pk2(u0 * (acc[0] + bsv), u1 * (acc[1] + bsv)); o.y = pk2(u2 * (acc[2] + bsv), u3 * (acc[3] + bsv));
            *(u32x2*)(MIX + row * DM + h * 128 + 16 * dt + 4 * (lane >> 4)) = o;
        }
    }
    __syncthreads();
}

__device__ __forceinline__ void conv_item(LAS unsigned char* lds, const bf16r* __restrict__ P, bf16r* __restrict__ MIX, const float* __restrict__ wdw  , const float* __restrict__ bdw,
                                          const float* __restrict__ lng, const float* __restrict__ lnb, int item, int tid, int wave, int lane) {
    LAS float* z = (LAS float*)lds;
    const int row0 = item * 32;
    const int seq0 = row0 < NLAT ? (row0 & ~4095) : (NLAT + ((row0 - NLAT) & ~255)), seq1 = seq0 + (row0 < NLAT ? SEQ : CTX);
    float acc[32]; float w[31];
    { const float bv = bdw[tid];
#pragma unroll
      for (int t = 0; t < 32; ++t) acc[t] = bv;
#pragma unroll
      for (int j = 0; j < 31; ++j) w[j] = wdw[j * 512 + tid]; }
    { u32x4 ra[8], rb[8];
#pragma unroll
      for (int i = 0; i < 8; ++i) { const int rr = wave + 8 * i; int g = row0 - 15 + rr; const bool ok = rr < 62 && g >= seq0 && g < seq1; if (!ok) g = row0;
          ra[i] = *(const u32x4*)(P + (size_t)g * INC + 1024 + lane * 8); rb[i] = *(const u32x4*)(P + (size_t)g * INC + 1536 + lane * 8); }
#pragma unroll
      for (int i = 0; i < 8; ++i) { const int rr = wave + 8 * i; const int g = row0 - 15 + rr; const bool ok = g >= seq0 && g < seq1;
          if (rr < 62) { float a[8], b[8], zv[8]; unpack8(ra[i], a); unpack8(rb[i], b);
#pragma unroll
              for (int j = 0; j < 8; ++j) zv[j] = ok ? a[j] * sigmoidf_(b[j]) : 0.f;
              *(LAS f32x4*)(z + rr * 512 + lane * 8) = (f32x4){zv[0], zv[1], zv[2], zv[3]}; *(LAS f32x4*)(z + rr * 512 + lane * 8 + 4) = (f32x4){zv[4], zv[5], zv[6], zv[7]}; } } }
    __syncthreads();
#pragma unroll
    for (int rr = 0; rr < 62; ++rr) { const float zv = z[rr * 512 + tid];
#pragma unroll
        for (int t = 0; t < 32; ++t) { if (rr - t >= 0 && rr - t <= 30) acc[t] += w[rr - t] * zv; } }
    __syncthreads();
#pragma unroll
    for (int t = 0; t < 32; ++t) z[t * 512 + tid] = acc[t];
    __syncthreads();
    float gl[8], bl[8];
#pragma unroll
    for (int j = 0; j < 8; ++j) { gl[j] = lng[lane * 8 + j]; bl[j] = lnb[lane * 8 + j]; }
#pragma unroll
    for (int i = 0; i < 4; ++i) { const int t = wave * 4 + i;
        const f32x4 y0 = *(const LAS f32x4*)(z + t * 512 + lane * 8), y1 = *(const LAS f32x4*)(z + t * 512 + lane * 8 + 4);
        float x[8] = {y0.x, y0.y, y0.z, y0.w, y1.x, y1.y, y1.z, y1.w};
        float s = 0.f;
#pragma unroll
        for (int j = 0; j < 8; ++j) s += x[j];
        const float mean = wave_sum(s) * (1.f / 512.f); float qq = 0.f;
#pragma unroll
        for (int j = 0; j < 8; ++j) { const float d = x[j] - mean; qq += d * d; }
        const float rstd = __builtin_amdgcn_rsqf(wave_sum(qq) * (1.f / 512.f) + LN_EPS);
        float o[8];
#pragma unroll
        for (int j = 0; j < 8; ++j) { const float v = (x[j] - mean) * rstd * gl[j] + bl[j]; o[j] = v * sigmoidf_(v); }
        *(u32x4*)(MIX + (size_t)(row0 + t) * DM + 512 + lane * 8) = pack8(o);
    }
    __syncthreads();
}

#define XB_TMO      128
#define XB_XCNT(j)  (256  + 64 * (j))
#define XB_XSUB(j)  (1280 + 64 * (j))
#define XB_XGEN(j)  (2304 + 64 * (j))
#define XB_TOP      3328
#define XB_TOPGEN   3392
#define XCD_BAR_WORDS 3456
#define XB_SPIN_CAP (1u << 18)

__device__ __forceinline__ unsigned xb_ld(unsigned* p)              { return __hip_atomic_load(p, __ATOMIC_RELAXED, __HIP_MEMORY_SCOPE_AGENT); }
__device__ __forceinline__ unsigned xb_add(unsigned* p, unsigned v) { return __hip_atomic_fetch_add(p, v, __ATOMIC_RELAXED, __HIP_MEMORY_SCOPE_AGENT); }
__device__ __forceinline__ unsigned xb_xcc_id() { return (unsigned)__builtin_amdgcn_s_getreg((3 << 11) | 20) & 0xFu; }
#define XB_SPIN(cond, bar) do { unsigned _sp = 0; while (cond) { __builtin_amdgcn_s_sleep(1); \
    if ((++_sp & 255u) == 0u) { if (xb_ld(&(bar)[XB_TMO])) break; if (_sp > XB_SPIN_CAP) { atomicAdd(&(bar)[XB_TMO], 1u); break; } } } } while (0)

struct XcdBarrier {
    unsigned* bar; unsigned x;
    volatile LAS unsigned* st;
};

__device__ __forceinline__ XcdBarrier xcd_barrier_post(unsigned* bar, volatile LAS unsigned* st) {
    XcdBarrier b; b.bar = bar; b.x = xb_xcc_id(); b.st = st;
    if (threadIdx.x == 0) (void)xb_add(&bar[XB_XCNT(b.x)], 1u);
    return b;
}
__device__ __forceinline__ void xcd_barrier_complete(unsigned* bar, unsigned x, unsigned& nloc, unsigned& nx) {
    const unsigned G = gridDim.x * gridDim.y * gridDim.z;
    unsigned sum, cnt, mine, sp = 0u;
    for (;;) {
        sum = 0u; cnt = 0u; mine = 0u;
#pragma unroll
        for (unsigned j = 0; j < 16; ++j) { const unsigned c = xb_ld(&bar[XB_XCNT(j)]); sum += c; cnt += (c > 0u) ? 1u : 0u; mine = (j == x) ? c : mine; }
        if (sum == G) break;
        __builtin_amdgcn_s_sleep(1);
        if ((++sp & 255u) == 0u) { if (xb_ld(&bar[XB_TMO])) break; if (sp > XB_SPIN_CAP) { atomicAdd(&bar[XB_TMO], 1u); break; } }
    }
    nloc = mine > 0u ? mine : 1u; nx = cnt > 0u ? cnt : 1u;
}

__device__ __forceinline__ void xcd_barrier(const XcdBarrier& b) {
    asm volatile("s_waitcnt vmcnt(0)" ::: "memory");
    __syncthreads();
    if (threadIdx.x == 0) {
        unsigned* bar = b.bar;
        __builtin_amdgcn_s_waitcnt(0);
        unsigned nloc = b.st[0], nx = b.st[1];
        if (nloc == 0u) { xcd_barrier_complete(bar, b.x, nloc, nx); b.st[0] = nloc; b.st[1] = nx; }
        const unsigned old = xb_add(&bar[XB_XSUB(b.x)], 1u);
        const unsigned gen = old / nloc;
        if (old + 1u == (gen + 1u) * nloc) {
            __builtin_amdgcn_fence(__ATOMIC_RELEASE, "agent");
            asm volatile("s_waitcnt vmcnt(0)" ::: "memory");
            const unsigned og = xb_add(&bar[XB_TOP], 1u);
            const unsigned tg = og / nx;
            if (og + 1u == (tg + 1u) * nx) xb_add(&bar[XB_TOPGEN], 1u);
            else XB_SPIN(xb_ld(&bar[XB_TOPGEN]) == tg, bar);
            __builtin_amdgcn_fence(__ATOMIC_ACQUIRE, "agent");
            xb_add(&bar[XB_XGEN(b.x)], 1u);
            asm volatile("s_waitcnt vmcnt(0)" ::: "memory");
        } else {
            XB_SPIN(xb_ld(&bar[XB_XGEN(b.x)]) == gen, bar);
            __builtin_amdgcn_fence(__ATOMIC_ACQUIRE, "agent");
            asm volatile("s_waitcnt vmcnt(0)" ::: "memory");
        }
    }
    __syncthreads();
}

#ifndef REP_P0
#define REP_P0 0
#endif
#ifndef REP_RP
#define REP_RP 0
#endif
#ifndef REP_ATTN
#define REP_ATTN 0
#endif
#ifndef REP_PREP
#define REP_PREP 0
#endif
#ifndef REP_QKV
#define REP_QKV 0
#endif
#ifndef REP_GMLP
#define REP_GMLP 0
#endif
#ifndef REP_CONV
#define REP_CONV 0
#endif
#ifndef REP_G1
#define REP_G1 0
#endif
#ifndef REP_G3
#define REP_G3 0
#endif
#ifndef REP_G4
#define REP_G4 0
#endif
#ifndef REP_G2
#define REP_G2 0
#endif
#ifndef ALIGN_RG
#define ALIGN_RG true
#endif
#ifndef FF2_KREV
#define FF2_KREV 1
#endif
#define REPEAT(n) for (int rep_ = 0; rep_ < 1 + (n); ++rep_)
struct Args { const float* in[24]; float* out; unsigned char* ws; int ph_lo, ph_hi; };
constexpr int N_PHASES = 2 + 8 * NLAYER;
struct Ctx {
    LAS unsigned char* lds; unsigned char* lds_raw; int tid, lane, wave, G, bx, vcu, gw, NGW, lo, hi;
    const float *w_in, *w_out, *w_ff1, *w_ff2;
    const float *x_in, *ctx_in, *a_ln_g, *a_ln_b, *a_ws, *a_bs, *b_dw, *b_dwb, *b_ln_g, *b_ln_b, *q_gain, *k_gain, *ln1_g, *ln1_b, *ln2_g, *ln2_b;
    float *rope, *MOD, *X, *out, *STAT, *PART; bf16r *Wt_in, *Wt_out, *Wt_ff1, *Wt_ff2, *H, *P, *Qb, *Kb, *Vb, *MIX, *ACT;
};
#define RUN (pid >= C.lo && pid < C.hi)
#define SEAM() do { if (pid >= C.lo && pid + 1 < C.hi) xcd_barrier(bar); ++pid; } while (0)

__device__ __forceinline__ void tail_transposes(const Ctx& C, int nwg, const float* Wa, int Ka, int Na, bf16r* Ta, const float* Wb2, int Kb, int Nb, bf16r* Tb) {
    const int first = nwg % C.G;
    if (C.bx < first) return;
    LAS float* scr = (LAS float*)(C.lds + C.wave * 16640);
    const int ia = (Ka / 64) * (Na / 64), ib = Wb2 ? (Kb / 64) * (Nb / 64) : 0, stride = (C.G - first) * 8;
    for (int it = (C.bx - first) * 8 + C.wave; it < ia + ib; it += stride) {
        if (it < ia) p0_transpose_item(Wa, Ka, Na, Ta, scr, it, C.lane); else p0_transpose_item(Wb2, Kb, Nb, Tb, scr, it - ia, C.lane);
    }
}

#ifndef STG_OUT
#define STG_OUT 0
#endif
#ifndef STG_FF2
#define STG_FF2 0
#endif
#ifndef STG_FF1
#define STG_FF1 0
#endif
#ifndef STG_IN
#define STG_IN 0
#endif
__device__ __forceinline__ void stagger(int k, unsigned ticks) {
    if (ticks == 0u) return;
    const unsigned long long t0 = __builtin_amdgcn_s_memrealtime(), w = (unsigned long long)k * ticks;
    while (__builtin_amdgcn_s_memrealtime() - t0 < w) __builtin_amdgcn_s_sleep(4);
}

template <int l> __device__ __forceinline__ void layer_body(const Ctx& C, int& pid, const XcdBarrier& bar) {
    constexpr bool last = (l == NLAYER - 1);
    constexpr int Mrows = last ? NLAT : NROW;
    const float* modl = C.MOD + (size_t)l * 5 * NMODC;
    float* Xc = C.X + (size_t)NLAT * DM;
    if (RUN) {
#if !defined(DIS_GEMM) && !defined(DIS_G1)
        stagger((C.bx >> 3) & 7, STG_IN);
        pg8::Gemm g{C.H, C.Wt_in + (size_t)l * INC * DM, Mrows, INC, DM, DM / 64}; pg8::OrderX S; S.init(Mrows, INC, C.G, C.bx, 64, last ? 4 : 0, 12, 2);
        pg8::EpiBf16<0> E{C.P, INC};
        REPEAT(REP_G1) pg8::gemm_phase<pg8::EpiBf16<0>, pg8::OrderX, true, true>(C.lds, g, S, E);
        if (l == 0) tail_transposes(C, (Mrows / 256) * (INC / 256), C.w_in + (size_t)DM * INC, DM, INC, C.Wt_in + (size_t)INC * DM, nullptr, 0, 0, nullptr);
        else tail_transposes(C, (Mrows / 256) * (INC / 256) + 8, C.w_out + (size_t)DM * DM, DM, DM, C.Wt_out + (size_t)DM * DM, C.w_ff1 + (size_t)DM * DFF, DM, DFF, C.Wt_ff1 + (size_t)DFF * DM);
#endif
    }
    SEAM();
    if (RUN) {
        REPEAT(REP_PREP) {
#ifndef DIS_PREP
        REPEAT(REP_QKV) prep_qkv(C.P, C.Qb, C.Kb, C.Vb, C.q_gain + l * 128, C.k_gain + l * 128, C.rope, NROW, !last, C.gw, C.NGW, C.lane);
#endif
#ifndef DIS_GMLP
        constexpr int nch = Mrows / 128;
        REPEAT(REP_GMLP) for (int it = C.vcu; it < nch; it += C.G) gmlp_item(C.lds, C.P, C.MIX, C.a_ln_g + l * 512, C.a_ln_b + l * 512, C.a_ws + (size_t)l * 4 * 128 * 128, C.a_bs + l * 512, it, C.tid, C.wave, C.lane);
#endif
#ifndef DIS_CONV
        {
            constexpr int nconv = Mrows / 32, ngm = Mrows / 128;
            const bool split = C.G > ngm && ngm <= nconv;
            const int c0 = split ? (C.vcu < ngm ? C.vcu : ngm + (C.vcu - ngm)) : C.vcu;
            const int cs = split ? (C.vcu < ngm ? nconv : C.G - ngm) : C.G;
            REPEAT(REP_CONV) for (int it = c0; it < nconv; it += cs) conv_item(C.lds, C.P, C.MIX, C.b_dw + (size_t)l * 31 * 512, C.b_dwb + l * 512, C.b_ln_g + l * 512, C.b_ln_b + l * 512, it, C.tid, C.wave, C.lane);
        }
#endif
        }
    }
    SEAM();
    if (RUN) {
        constexpr int nunits = 512 + (last ? 0 : 32);
        REPEAT(REP_ATTN) for (int u = C.vcu; u < nunits; u += C.G) {
            int b, h, row0, seq;
            if (u < 512) { b = u >> 7; h = (u >> 4) & 7; row0 = b * SEQ + (u & 15) * 256; seq = KVLEN; }
            else { const int u2 = u - 512; b = u2 >> 3; h = u2 & 7; row0 = NLAT + b * CTX; seq = CTX; }
            const size_t kvoff = (size_t)(b * 2 + (h >> 2)) * KVLEN * 128;
#ifndef DIS_ATTN
            attn::attn_dense_body(C.P + (size_t)row0 * INC + 2048 + h * 128, C.q_gain + l * 128, C.rope, u < 512 ? (row0 & 4095) : -1, (const attn::bf16*)(C.Kb + kvoff), (const attn::bf16*)(C.Vb + kvoff),
                                  C.MIX + (size_t)row0 * DM + 1024 + h * 128, seq, (char*)C.lds_raw);
#endif
            __syncthreads();
        }
    }
    SEAM();
    if (RUN) {
#if !defined(DIS_GEMM) && !defined(DIS_G2)
        stagger((C.bx >> 3) & 7, STG_OUT);
        pg8::Gemm g{C.MIX, C.Wt_out + (size_t)l * DM * DM, NLAT, DM, DM, DM / 64}; pg8::OrderX S; S.init(NLAT, DM, C.G, C.bx, 0, 0, 0, 0);
        pg8::EpiBf16<0> E{C.H, DM};
        pg8::gemm_phase<pg8::EpiBf16<0>, pg8::OrderX, true, true>(C.lds, g, S, E);
        if (!last) {
            pg8::Gemm g2{C.MIX, C.Wt_out + (size_t)l * DM * DM, NROW, DM, DM, 4}; pg8::OrderSplit S2; S2.init(C.G, C.bx, 8, 4);
            pg8::EpiPart E2{C.PART, 4 * 128};
            pg8::gemm_phase<pg8::EpiPart, pg8::OrderSplit, true, true>(C.lds, g2, S2, E2);
        }
#endif
    }
    SEAM();
    if (RUN) {
        bf16r* XS = (bf16r*)C.X;
        if (l == 0) row_pass_res<true, false>(C.lds, C.x_in, nullptr, C.H, NLAT, modl, 2 * DM, C.ln1_g + l * DM, C.ln1_b + l * DM, XS, nullptr, modl, 3 * DM, 4 * DM, C.H, C.gw, C.NGW, C.lane);
        else row_pass_res<false, false>(C.lds, nullptr, XS, C.H, NLAT, modl, 2 * DM, C.ln1_g + l * DM, C.ln1_b + l * DM, XS, nullptr, modl, 3 * DM, 4 * DM, C.H, C.gw, C.NGW, C.lane);
        if (!last) row_pass_ctx_res<true>(C.ctx_in, XS, C.PART, modl + 4 * (size_t)NMODC + 2 * DM, C.ln1_g + l * DM, C.ln1_b + l * DM, true, modl, 3 * DM, 4 * DM, C.H, C.gw, C.NGW, C.lane);
    }
    SEAM();
    if (RUN) {
#if !defined(DIS_GEMM) && !defined(DIS_G3)
        stagger((C.bx >> 3) & 7, STG_FF1);
        pg8::Gemm g{C.H, C.Wt_ff1 + (size_t)l * DFF * DM, Mrows, DFF, DM, DM / 64}; pg8::OrderX S; S.init(Mrows, DFF, C.G, C.bx, 0, 0, 0, 0);
        pg8::EpiBf16<2> E{C.ACT, DFF};
        pg8::gemm_phase<pg8::EpiBf16<2>, pg8::OrderX, true, true>(C.lds, g, S, E);
        if (REP_G3) { pg8::gemm_phase<pg8::EpiBf16<2>, pg8::OrderX, true, true>(C.lds, g, S, E); }
        if (l == 0) tail_transposes(C, (Mrows / 256) * (DFF / 256), C.w_ff2 + (size_t)DFF * DM, DFF, DM, C.Wt_ff2 + (size_t)DM * DFF, nullptr, 0, 0, nullptr);
#endif
    }
    SEAM();
    if (RUN) {
#if !defined(DIS_GEMM) && !defined(DIS_G4)
        stagger((C.bx >> 3) & 7, STG_FF2);
        pg8::Gemm g{C.ACT, C.Wt_ff2 + (size_t)l * DM * DFF, NLAT, DM, DFF, DFF / 64, FF2_KREV  }; pg8::OrderX S; S.init(NLAT, DM, C.G, C.bx, 0, 0, 0, 0);
        pg8::EpiBf16<0> E{C.H, DM};
        pg8::gemm_phase<pg8::EpiBf16<0>, pg8::OrderX, true, true>(C.lds, g, S, E);
        if (!last) {
            pg8::Gemm g2{C.ACT, C.Wt_ff2 + (size_t)l * DM * DFF, NROW, DM, DFF, 16}; pg8::OrderSplit S2; S2.init(C.G, C.bx, 8, 16);
            pg8::EpiPart E2{C.PART, 16 * 128};
            pg8::gemm_phase<pg8::EpiPart, pg8::OrderSplit, true, true>(C.lds, g2, S2, E2);
        }
#endif
    }
    SEAM();
    if (RUN) {
        bf16r* XS = (bf16r*)C.X;
        if (last) row_pass_res<false, true>(C.lds, nullptr, XS, C.H, NLAT, modl, 5 * DM, C.ln2_g + l * DM, C.ln2_b + l * DM, nullptr, C.out, nullptr, 0, 0, nullptr, C.gw, C.NGW, C.lane);
        else {
            row_pass_res<false, false>(C.lds, nullptr, XS, C.H, NLAT, modl, 5 * DM, C.ln2_g + l * DM, C.ln2_b + l * DM, XS, nullptr, modl + 5 * NMODC, 0 * DM, 1 * DM, C.H, C.gw, C.NGW, C.lane);
            row_pass_ctx_res<false>(nullptr, XS, C.PART, modl + 4 * (size_t)NMODC + 5 * DM, C.ln2_g + l * DM, C.ln2_b + l * DM, false, modl + 5 * NMODC, 0 * DM, 1 * DM, C.H, C.gw, C.NGW, C.lane);
        }
    }
    SEAM();
}

__global__ void __launch_bounds__(512, 2) fwd_megakernel(Args args) {
    extern __shared__ __attribute__((aligned(16))) unsigned char lds_raw[];
    cg::grid_group grid = cg::this_grid();
    Ctx C;
    C.lds = (LAS unsigned char*)lds_raw; C.lds_raw = lds_raw;
    C.tid = threadIdx.x; C.lane = C.tid & 63; C.wave = __builtin_amdgcn_readfirstlane(C.tid >> 6);
    C.G = gridDim.x; C.bx = blockIdx.x; C.vcu = (C.G % 8 == 0) ? (C.bx % 8) * (C.G / 8) + C.bx / 8 : C.bx;
    C.gw = C.vcu * 8 + C.wave; C.NGW = C.G * 8; C.lo = args.ph_lo; C.hi = args.ph_hi;
    unsigned char* ws = args.ws;
    C.x_in = args.in[0]; C.ctx_in = args.in[2]; C.w_in = args.in[6]; C.w_out = args.in[17]; C.w_ff1 = args.in[20]; C.w_ff2 = args.in[21];
    C.a_ln_g = args.in[7]; C.a_ln_b = args.in[8]; C.a_ws = args.in[9]; C.a_bs = args.in[10];
    C.b_dw = args.in[11]; C.b_dwb = args.in[12]; C.b_ln_g = args.in[13]; C.b_ln_b = args.in[14];
    C.q_gain = args.in[15]; C.k_gain = args.in[16]; C.ln1_g = args.in[18]; C.ln1_b = args.in[19]; C.ln2_g = args.in[22]; C.ln2_b = args.in[23];
    C.STAT = (float*)(ws + WS_STAT); C.PART = (float*)(ws + WS_PART); C.rope = (float*)(ws + WS_ROPE); C.MOD = (float*)(ws + WS_MOD); C.X = (float*)(ws + WS_X); C.out = args.out;
    C.Wt_in = (bf16r*)(ws + WS_WIN); C.Wt_out = (bf16r*)(ws + WS_WOUT); C.Wt_ff1 = (bf16r*)(ws + WS_WFF1); C.Wt_ff2 = (bf16r*)(ws + WS_WFF2);
    C.H = (bf16r*)(ws + WS_H); C.P = (bf16r*)(ws + WS_P); C.Qb = (bf16r*)(ws + WS_Q);
    C.Kb = (bf16r*)(ws + WS_K); C.Vb = (bf16r*)(ws + WS_V); C.MIX = (bf16r*)(ws + WS_MIX); C.ACT = (bf16r*)(ws + WS_ACT);
    int pid = 0;
    volatile LAS unsigned* bst = (volatile LAS unsigned*)(C.lds + LDS_BYTES - 64);
    if (C.tid < 2) bst[C.tid] = 0u;
    __syncthreads();
    const XcdBarrier bar = xcd_barrier_post((unsigned*)(ws + WS_BAR), bst);
    if (C.hi < 0) grid.sync();

    if (RUN) REPEAT(REP_P0) {
        const float* c_in = args.in[1]; const float* cctx_in = args.in[3]; const float* w_mod = args.in[4]; const float* b_mod = args.in[5];
        const float* w_in = args.in[6]; const float* w_out = args.in[17]; const float* w_ff1 = args.in[20]; const float* w_ff2 = args.in[21];
        p0_rope(C.rope, C.bx * 512 + C.tid, C.G * 512);
        p0_mod(C.lds, c_in, cctx_in, w_mod, b_mod, C.MOD, 0, NLAYER * (NMODC / 128), C.bx, C.G, C.tid);
        __syncthreads();
        LAS float* scr = (LAS float*)(C.lds + C.wave * 16640);
        constexpr int I_IN = (DM / 64) * (INC / 64), I_OUT = (DM / 64) * (DM / 64), I_F1 = (DM / 64) * (DFF / 64), I_F2 = (DFF / 64) * (DM / 64), I_L = I_IN + I_OUT + I_F1 + I_F2;
        for (int it = C.gw; it < I_L; it += C.NGW) {
            const int l = 0; int r = it;
            if (r < I_IN) { p0_transpose_item(w_in + (size_t)l * DM * INC, DM, INC, C.Wt_in + (size_t)l * INC * DM, scr, r, C.lane); continue; } r -= I_IN;
            if (r < I_OUT) { p0_transpose_item(w_out + (size_t)l * DM * DM, DM, DM, C.Wt_out + (size_t)l * DM * DM, scr, r, C.lane); continue; } r -= I_OUT;
            if (r < I_F1) { p0_transpose_item(w_ff1 + (size_t)l * DM * DFF, DM, DFF, C.Wt_ff1 + (size_t)l * DFF * DM, scr, r, C.lane); continue; } r -= I_F1;
            p0_transpose_item(w_ff2 + (size_t)l * DFF * DM, DFF, DM, C.Wt_ff2 + (size_t)l * DM * DFF, scr, r, C.lane);
        }
        if (REP_P0) __syncthreads();
    }
    SEAM();
    if (RUN) row_pass0(C.lds, C.x_in, C.ctx_in, C.MOD, C.H, C.gw, C.NGW, C.lane);
    SEAM();
    layer_body<0>(C, pid, bar);
    layer_body<1>(C, pid, bar);
#ifdef EXTRA_SYNCS
    if (C.hi - C.lo > 1) { for (int i = 0; i < EXTRA_SYNCS; ++i) {
#ifdef EXTRA_DIRTY
        { f32x4* sp = (f32x4*)(ws + WS_PART) + (size_t)C.bx * 512 * EXTRA_DIRTY + C.tid;
          for (int k = 0; k < EXTRA_DIRTY; ++k) sp[k * 512] = (f32x4){(float)i, 1.f, 2.f, 3.f}; }
#endif
        xcd_barrier(bar); } }
#endif
}
#undef RUN
#undef SEAM

#ifndef MK_PER_PHASE
#define MK_PER_PHASE 0
#endif
extern "C" void kernel_launch(void* const* d_in, const int* in_sizes, int n_in, void* d_out, int out_size, void* d_ws, size_t ws_size, hipStream_t stream) {
    static int grid = 0;
    if (grid == 0) {
        if (n_in != 24 || out_size != NLAT * DM || ws_size < WS_END) { fprintf(stderr, "kernel_launch: unexpected shapes (n_in %d out %d ws %zu, need ws >= %zu)\n", n_in, out_size, ws_size, (size_t)WS_END); grid = -1; return; }
        int dev = 0, cus = 0, per_cu = 0;
        (void)hipGetDevice(&dev); (void)hipDeviceGetAttribute(&cus, hipDeviceAttributeMultiprocessorCount, dev);
        if (hipFuncSetAttribute((const void*)fwd_megakernel, hipFuncAttributeMaxDynamicSharedMemorySize, LDS_BYTES) != hipSuccess) { fprintf(stderr, "kernel_launch: hipFuncSetAttribute failed\n"); grid = -1; return; }
        if (hipOccupancyMaxActiveBlocksPerMultiprocessor(&per_cu, (const void*)fwd_megakernel, 512, LDS_BYTES) != hipSuccess || per_cu < 1) { fprintf(stderr, "kernel_launch: occupancy query says %d\n", per_cu); per_cu = 1; }
        (void)hipGetLastError();
        grid = cus;
    }
    if (grid < 0) return;
#ifndef PROBE_TWICE
#define PROBE_TWICE 0
#endif
    for (int rep_launch = 0; rep_launch <= PROBE_TWICE; ++rep_launch) {
    if (hipMemsetAsync((char*)d_ws + WS_BAR, 0, WS_BAR_BYTES, stream) != hipSuccess) { fprintf(stderr, "kernel_launch: memset failed\n"); return; }
    Args a{};
    for (int i = 0; i < 24; ++i) a.in[i] = (const float*)d_in[i];
    a.out = (float*)d_out; a.ws = (unsigned char*)d_ws;
#if MK_PER_PHASE
    for (int p = 0; p < N_PHASES; ++p) { a.ph_lo = p; a.ph_hi = p + 1; hipLaunchKernelGGL(fwd_megakernel, dim3(grid), dim3(512), LDS_BYTES, stream, a); }
#else
    a.ph_lo = 0; a.ph_hi = N_PHASES;
    void* kargs[] = {&a};
    hipError_t e = hipLaunchCooperativeKernel((const void*)fwd_megakernel, dim3(grid), dim3(512), kargs, LDS_BYTES, stream);
    if (e != hipSuccess) fprintf(stderr, "kernel_launch: cooperative launch failed: %s (grid %d)\n", hipGetErrorString(e), grid);
#endif
    }
}
```

```cpp
#include <hip/hip_runtime.h>
#include <hip/hip_cooperative_groups.h>
#include <hip/hip_bf16.h>
#include <cstdio>
#include <cstdint>
namespace cg = cooperative_groups;
namespace pg8 {
#define PG8_LAS __attribute__((address_space(3)))
typedef unsigned short bf16_t;
typedef short bf16x8 __attribute__((ext_vector_type(8)));
typedef float f32x4 __attribute__((ext_vector_type(4)));
typedef unsigned u32x4 __attribute__((ext_vector_type(4)));
constexpr int BM = 256, BK = 64, HALF = 128, HTB = HALF * BK * 2  , STAGE_BYTES = 8 * HTB, NXCD = 8, WGM = 8;

__host__ __device__ __forceinline__ int lds_byte(int r, int c) { const int st = (r >> 4) * 2 + (c >> 5), rr = r & 15, cc = c & 31, ob = rr * 64 + cc * 2; return st * 1024 + (ob ^ (((ob >> 9) & 1) << 5)); }
__host__ __device__ __forceinline__ void stage_rc(int b, int& R, int& C) { const int st = b / 1024, sb = b % 1024, swz = sb ^ (((sb >> 9) & 1) << 5); R = (st >> 1) * 16 + swz / 64; C = (st & 1) * 32 + (swz % 64) / 2; }
__host__ __device__ __forceinline__ int perm32(int rho) { const int n = rho >> 4, i = rho & 15; return 8 * (i >> 2) + 4 * n + (i & 3); }

struct Unit { int pm, pn, ko; };
struct Gemm { const bf16_t* A; const bf16_t* Bt; int M, N, K, nt, krev; };

struct StaticOrder {
    int nM, nN, nwg, G, c;
    __host__ __device__ void init(int M, int N, int G_, int c_) { nM = M / BM; nN = N / BM; nwg = nM * nN; G = G_; c = c_; }
    __host__ __device__ bool next(int i, Unit& u) const {
        const long L = (long)i * G + c; if (L >= nwg) return false;
        int wgid = (int)L; { const int q = nwg / NXCD, r = nwg % NXCD, xcd = wgid % NXCD, off = wgid / NXCD; wgid = (xcd < r ? xcd * (q + 1) : r * (q + 1) + (xcd - r) * q) + off; }
        const int nig = WGM * nN, gid = wgid / nig, fm = gid * WGM, gsz = (nM - fm) < WGM ? (nM - fm) : WGM;
        u.pm = fm + ((wgid % nig) % gsz); u.pn = (wgid % nig) / gsz; u.ko = 0; return true;
    }
    __device__ __forceinline__ void a_ready(const Unit&) const {}
    __device__ __forceinline__ void done(const Unit&) const {}
};

__device__ __forceinline__ unsigned cvt_pk_bf16(float lo, float hi) { unsigned r; asm volatile("v_cvt_pk_bf16_f32 %0, %1, %2" : "=v"(r) : "v"(lo), "v"(hi)); return r; }
typedef float f32x2 __attribute__((ext_vector_type(2)));
#ifndef WT_STORES
#define WT_STORES 0
#endif
__device__ __forceinline__ void st16_wt(void* p, u32x4 v) {
#if WT_STORES
    asm volatile("global_store_dwordx4 %0, %1, off sc1\n\ts_nop 1" :: "v"(p), "v"(v) : "memory");
#else
    *(u32x4*)p = v;
#endif
}
template <int ACT  > struct EpiBf16 {
    static constexpr bool PERM = true, AFTER_DRAIN = false;
    bf16_t* O; int ldc;
    __device__ __forceinline__ void operator()(const f32x4 (&acc)[2][2][4][2], const Unit& u, int wr, int wc, int fr, int fq) const {
        const int row0 = u.pm * BM + wr * 64 + fr; const int col0 = u.pn * BM + wc * 32 + 8 * fq;
#pragma unroll
        for (int ai = 0; ai < 2; ++ai)
#pragma unroll
            for (int m = 0; m < 4; ++m) { bf16_t* rowp = O + (size_t)(row0 + ai * HALF + m * 16) * ldc + col0;
#pragma unroll
                for (int bj = 0; bj < 2; ++bj) { f32x4 v0 = acc[ai][bj][m][0], v1 = acc[ai][bj][m][1];
                    if (ACT == 2) {
#pragma unroll
                        for (int e = 0; e < 4; ++e) { float a = fmaxf(v0[e], 0.f), b = fmaxf(v1[e], 0.f); v0[e] = a * a; v1[e] = b * b; } }
                    u32x4 w; w.x = cvt_pk_bf16(v0[0], v0[1]); w.y = cvt_pk_bf16(v0[2], v0[3]); w.z = cvt_pk_bf16(v1[0], v1[1]); w.w = cvt_pk_bf16(v1[2], v1[3]);
                    st16_wt(rowp + bj * HALF, w); } }
    }
};
template <bool NORM> struct EpiResGate {
    static constexpr bool PERM = false, AFTER_DRAIN = false;
    const float* res_lat; const float* res_ctx; float* out; const float* gate; float alpha; const float* stat; const float* lg; const float* lb;
    __device__ __forceinline__ void operator()(const f32x4 (&acc)[2][2][4][2], const Unit& u, int wr, int wc, int fr, int fq) const {
        typedef float f32x2v __attribute__((ext_vector_type(2)));
        const int mrow = u.pm < 64 ? (u.pm >> 4) : 4;
        const float* g = gate + (size_t)mrow * 12288;
        const int col0 = u.pn * BM + wc * 32 + 4 * fq;
        f32x4 gv[2][2], gg[2][2], bb[2][2];
#pragma unroll
        for (int bj = 0; bj < 2; ++bj)
#pragma unroll
            for (int n = 0; n < 2; ++n) { gv[bj][n] = *(const f32x4*)(g + col0 + bj * HALF + n * 16);
                if (NORM) { gg[bj][n] = *(const f32x4*)(lg + col0 + bj * HALF + n * 16); bb[bj][n] = *(const f32x4*)(lb + col0 + bj * HALF + n * 16); } }
#pragma unroll
        for (int ai = 0; ai < 2; ++ai)
#pragma unroll
            for (int mp = 0; mp < 2; ++mp) {
                f32x4 r[2][2][2]; f32x2v st[2];
#pragma unroll
                for (int mm = 0; mm < 2; ++mm) { const int row = u.pm * BM + ai * HALF + wr * 64 + (mp * 2 + mm) * 16 + fr;
                    const float* rp = (row < 16384) ? res_lat + (size_t)row * 2048 : res_ctx + (size_t)(row - 16384) * 2048;
                    st[mm] = (f32x2v){0.f, 1.f}; if (NORM) st[mm] = *(const f32x2v*)(stat + 2 * (size_t)row);
#pragma unroll
                    for (int bj = 0; bj < 2; ++bj)
#pragma unroll
                        for (int n = 0; n < 2; ++n) r[mm][bj][n] = *(const f32x4*)(rp + col0 + bj * HALF + n * 16); }
#pragma unroll
                for (int mm = 0; mm < 2; ++mm) { const int m = mp * 2 + mm; const int row = u.pm * BM + ai * HALF + wr * 64 + m * 16 + fr;
                    float* op = out + (size_t)row * 2048;
#pragma unroll
                    for (int bj = 0; bj < 2; ++bj)
#pragma unroll
                        for (int n = 0; n < 2; ++n) { f32x4 x = r[mm][bj][n];
                            if (NORM) x = (x - st[mm].x) * st[mm].y * gg[bj][n] + bb[bj][n];
                            const f32x4 o = x * alpha + gv[bj][n] * acc[ai][bj][m][n]; st16_wt(op + col0 + bj * HALF + n * 16, __builtin_bit_cast(u32x4, o)); } }
                asm volatile("" ::: "memory");
            }
    }
};
template <int MODE> struct EpiProbe {
    static constexpr bool PERM = false, AFTER_DRAIN = false;
    const float* res; float* out;
    __device__ __forceinline__ void operator()(const f32x4 (&acc)[2][2][4][2], const Unit& u, int wr, int wc, int fr, int fq) const {
        const int col0 = u.pn * BM + wc * 32 + 4 * fq; f32x4 s = {0.f, 0.f, 0.f, 0.f};
#pragma unroll
        for (int ai = 0; ai < 2; ++ai)
#pragma unroll
            for (int m = 0; m < 4; ++m) { const int row = u.pm * BM + ai * HALF + wr * 64 + m * 16 + fr;
#pragma unroll
                for (int bj = 0; bj < 2; ++bj)
#pragma unroll
                    for (int n = 0; n < 2; ++n) { const int c = col0 + bj * HALF + n * 16;
                        if (MODE == 1) *(f32x4*)(out + (size_t)row * 2048 + c) = acc[ai][bj][m][n];
                        else s += *(const f32x4*)(res + (size_t)row * 2048 + c) * acc[ai][bj][m][n]; } }
        if (MODE == 2) *(f32x4*)(out + (size_t)(u.pm * BM + wr * 64 + fr) * 2048 + col0) = s;
    }
};
struct OrderX {
    StaticOrder base; int xm0, xnm, xn0, xnn;
    __device__ void init(int M, int N, int G_, int c_, int xm0_, int xnm_, int xn0_, int xnn_) { base.init(M, N, G_, c_); xm0 = xm0_; xnm = xnm_; xn0 = xn0_; xnn = xnn_; }
    __device__ bool next(int i, Unit& u) const {
        long L = (long)i * base.G + base.c; if (L < base.nwg) return base.next(i, u);
        L -= base.nwg; if (L >= (long)xnm * xnn) return false;
        u.pm = xm0 + (int)(L % xnm); u.pn = xn0 + (int)(L / xnm); u.ko = 0; return true;
    }
    __device__ __forceinline__ void a_ready(const Unit&) const {}
    __device__ __forceinline__ void done(const Unit&) const {}
};
struct OrderSplit {
    int G, c, nsub, kbytes;
    __device__ void init(int G_, int c_, int ns, int nt) { G = G_; c = c_; nsub = 32 * ns; kbytes = nt * 128; }
    __device__ bool next(int i, Unit& u) const { const long L = (long)i * G + c; if (L >= nsub) return false; const int idx = (int)L; u.pm = 64 + (idx & 3); u.pn = (idx >> 2) & 7; u.ko = (idx >> 5) * kbytes; return true; }
    __device__ __forceinline__ void a_ready(const Unit&) const {}
    __device__ __forceinline__ void done(const Unit&) const {}
};
struct EpiPart {
    static constexpr bool PERM = false, AFTER_DRAIN = false;
    float* part; int kbytes;
    __device__ __forceinline__ void operator()(const f32x4 (&acc)[2][2][4][2], const Unit& u, int wr, int wc, int fr, int fq) const {
        const int ks = u.ko / kbytes; const int col0 = u.pn * BM + wc * 32 + 4 * fq;
        float* base = part + ((size_t)ks * 1024 + (size_t)(u.pm - 64) * BM) * 2048;
#pragma unroll
        for (int ai = 0; ai < 2; ++ai)
#pragma unroll
            for (int m = 0; m < 4; ++m) { float* op = base + (size_t)(ai * HALF + wr * 64 + m * 16 + fr) * 2048;
#pragma unroll
                for (int bj = 0; bj < 2; ++bj)
#pragma unroll
                    for (int n = 0; n < 2; ++n) st16_wt(op + col0 + bj * HALF + n * 16, __builtin_bit_cast(u32x4, acc[ai][bj][m][n])); }
    }
};
template <class Epi, class Sched, bool ALIGN_EPI = false, bool SP2 = false>
__device__ __forceinline__ void gemm_phase(PG8_LAS unsigned char* lds, const Gemm g, const Sched& S, const Epi& E) {
    const int tid = threadIdx.x, wid = __builtin_amdgcn_readfirstlane(tid >> 6), lane = tid & 63, wr = wid >> 2, wc = wid & 3, fr = lane & 15, fq = lane >> 4;
    const int K = g.K, nt = g.nt;
    unsigned voffA[2], voffB[2];
#pragma unroll
    for (int i = 0; i < 2; ++i) { int R, C; stage_rc(tid * 16 + i * 8192, R, C); const int Rb = Epi::PERM ? ((R & ~31) + perm32(R & 31)) : R;
        voffA[i] = (unsigned)(R * K + C) * 2u; voffB[i] = (unsigned)(Rb * K + C) * 2u; }
    const ptrdiff_t kstep = g.krev ? -(ptrdiff_t)(BK * 2) : (ptrdiff_t)(BK * 2);
    const size_t krev0 = g.krev ? (size_t)(nt - 1) * (BK * 2) : 0;
    const size_t hstep = (size_t)HALF * K * 2;
    const size_t tstep = 2 * hstep;
    const unsigned ldsw = (unsigned)wid * 1024u;
    const int aoff = lds_byte(wr * 64 + fr, fq * 8), boff = lds_byte(wc * 32 + fr, fq * 8);
#define PG8_SA(b, h) (((b) * 2 + (h)) * HTB)
#define PG8_SB(b, h) ((4 + (b) * 2 + (h)) * HTB)
#define PG8_STAGE(bufoff, gbase, voff) do { _Pragma("unroll") for (int _i = 0; _i < 2; ++_i) \
        __builtin_amdgcn_global_load_lds((const unsigned*)((const char*)(gbase) + (voff)[_i]), (PG8_LAS unsigned*)(lds + (bufoff) + ldsw + _i * 8192), 16, 0, 0); } while (0)
#define PG8_LDA(dst, b, h) do { _Pragma("unroll") for (int m = 0; m < 4; ++m) _Pragma("unroll") for (int k = 0; k < 2; ++k) dst[m][k] = *(const PG8_LAS bf16x8*)(lds + PG8_SA(b, h) + aoff + m * 2048 + k * 1024); } while (0)
#define PG8_LDB(dst, b, h) do { _Pragma("unroll") for (int n = 0; n < 2; ++n) _Pragma("unroll") for (int k = 0; k < 2; ++k) dst[n][k] = *(const PG8_LAS bf16x8*)(lds + PG8_SB(b, h) + boff + n * 2048 + k * 1024); } while (0)
#define PG8_MMA(ai, bj, At, Bt) do { __builtin_amdgcn_s_setprio(1); _Pragma("unroll") for (int m = 0; m < 4; ++m) _Pragma("unroll") for (int n = 0; n < 2; ++n) _Pragma("unroll") for (int k = 0; k < 2; ++k) \
        acc[ai][bj][m][n] = __builtin_amdgcn_mfma_f32_16x16x32_bf16(Bt[n][k], At[m][k], acc[ai][bj][m][n], 0, 0, 0); __builtin_amdgcn_s_setprio(0); } while (0)
#define PG8_WAIT_V(n) asm volatile("s_waitcnt vmcnt(" #n ")" ::: "memory")
#define PG8_WAIT_L(n) asm volatile("s_waitcnt lgkmcnt(" #n ")" ::: "memory")
#define PG8_BAR __builtin_amdgcn_s_barrier()
#define PG8_SCHED __builtin_amdgcn_sched_barrier(0)
    Unit cur, nxt; int ui = 0;
    if (!S.next(0, cur)) return;
    f32x4 acc[2][2][4][2];
#pragma unroll
    for (int a = 0; a < 2; ++a)
#pragma unroll
        for (int b = 0; b < 2; ++b)
#pragma unroll
            for (int m = 0; m < 4; ++m)
#pragma unroll
                for (int n = 0; n < 2; ++n) acc[a][b][m][n] = (f32x4){0.f, 0.f, 0.f, 0.f};
    bf16x8 At[4][2], B0[2][2], B1[2][2];
    const char* cA = (const char*)g.A + (size_t)cur.pm * tstep + cur.ko + krev0; const char* cB = (const char*)g.Bt + (size_t)cur.pn * tstep + cur.ko + krev0;
    S.a_ready(cur);
    if constexpr (SP2) {
        PG8_STAGE(PG8_SB(0, 0), cB, voffB); PG8_STAGE(PG8_SB(0, 1), cB + hstep, voffB); PG8_STAGE(PG8_SA(0, 0), cA, voffA); PG8_STAGE(PG8_SA(0, 1), cA + hstep, voffA);
        if (wr == 1) PG8_BAR;
        PG8_WAIT_V(2); PG8_BAR;
        PG8_STAGE(PG8_SB(1, 0), cB + kstep, voffB); PG8_STAGE(PG8_SA(1, 0), cA + kstep, voffA); PG8_STAGE(PG8_SB(1, 1), cB + hstep + kstep, voffB);
        PG8_WAIT_V(6); PG8_BAR;
    } else {
        PG8_STAGE(PG8_SB(0, 0), cB, voffB); PG8_STAGE(PG8_SA(0, 0), cA, voffA); PG8_STAGE(PG8_SB(0, 1), cB + hstep, voffB); PG8_STAGE(PG8_SA(0, 1), cA + hstep, voffA);
        if (wr == 1) PG8_BAR;
        PG8_WAIT_V(4); PG8_BAR;
        PG8_STAGE(PG8_SB(1, 0), cB + kstep, voffB); PG8_STAGE(PG8_SA(1, 0), cA + kstep, voffA); PG8_STAGE(PG8_SB(1, 1), cB + hstep + kstep, voffB);
        PG8_WAIT_V(6); PG8_BAR;
    }
    for (;;) {
        const bool has_next = S.next(ui + 1, nxt);
        const char* nA = has_next ? (const char*)g.A + (size_t)nxt.pm * tstep + nxt.ko + krev0 : cA; const char* nB = has_next ? (const char*)g.Bt + (size_t)nxt.pn * tstep + nxt.ko + krev0 : cB;
        for (int t = 0; t < nt; t += 2) {
            const bool last = (t == nt - 2);
            const char* a1 = cA + (ptrdiff_t)(t + 1) * kstep;
            const char* a2 = last ? nA : cA + (ptrdiff_t)(t + 2) * kstep; const char* b2 = last ? nB : cB + (ptrdiff_t)(t + 2) * kstep;
            const char* a3 = a2 + kstep; const char* b3 = b2 + kstep;
            if (last && has_next) S.a_ready(nxt);
            if constexpr (SP2) {
            PG8_LDB(B0, 0, 0); PG8_LDB(B1, 0, 1); PG8_SCHED; PG8_LDA(At, 0, 0); PG8_STAGE(PG8_SA(1, 1), a1 + hstep, voffA);
            PG8_WAIT_V(8); PG8_WAIT_L(0); PG8_BAR; PG8_MMA(0, 0, At, B0); PG8_MMA(0, 1, At, B1); PG8_BAR; PG8_SCHED;
            PG8_LDA(At, 0, 1); PG8_STAGE(PG8_SB(0, 0), b2, voffB); PG8_STAGE(PG8_SB(0, 1), b2 + hstep, voffB); PG8_STAGE(PG8_SA(0, 0), a2, voffA);
            PG8_WAIT_V(8); PG8_WAIT_L(0); PG8_BAR; PG8_MMA(1, 0, At, B0); PG8_MMA(1, 1, At, B1); PG8_BAR; PG8_SCHED;
            PG8_LDB(B0, 1, 0); PG8_LDB(B1, 1, 1); PG8_SCHED; PG8_LDA(At, 1, 0); PG8_STAGE(PG8_SA(0, 1), a2 + hstep, voffA);
            PG8_WAIT_V(8); PG8_WAIT_L(0); PG8_BAR; PG8_MMA(0, 0, At, B0); PG8_MMA(0, 1, At, B1); PG8_BAR; PG8_SCHED;
            PG8_LDA(At, 1, 1); PG8_STAGE(PG8_SB(1, 0), b3, voffB); PG8_STAGE(PG8_SB(1, 1), b3 + hstep, voffB); PG8_STAGE(PG8_SA(1, 0), a3, voffA);
            PG8_WAIT_V(8); PG8_WAIT_L(0); PG8_BAR; PG8_MMA(1, 0, At, B0); PG8_MMA(1, 1, At, B1); PG8_BAR; PG8_SCHED;
            } else {
            PG8_LDB(B0, 0, 0); PG8_SCHED; PG8_LDA(At, 0, 0); PG8_STAGE(PG8_SA(1, 1), a1 + hstep, voffA);
            PG8_WAIT_L(8); PG8_BAR; PG8_WAIT_L(0); PG8_MMA(0, 0, At, B0); PG8_BAR; PG8_SCHED;
            PG8_LDB(B1, 0, 1); PG8_STAGE(PG8_SB(0, 0), b2, voffB);
            PG8_BAR; PG8_WAIT_L(0); PG8_MMA(0, 1, At, B1); PG8_BAR;
            PG8_LDA(At, 0, 1); PG8_STAGE(PG8_SA(0, 0), a2, voffA);
            PG8_BAR; PG8_WAIT_L(0); PG8_MMA(1, 0, At, B0); PG8_BAR; PG8_SCHED;
            PG8_STAGE(PG8_SB(0, 1), b2 + hstep, voffB);
            PG8_WAIT_V(6); PG8_BAR; PG8_MMA(1, 1, At, B1); PG8_BAR;
            PG8_LDB(B0, 1, 0); PG8_SCHED; PG8_LDA(At, 1, 0); PG8_STAGE(PG8_SA(0, 1), a2 + hstep, voffA);
            PG8_WAIT_L(8); PG8_BAR; PG8_WAIT_L(0); PG8_MMA(0, 0, At, B0); PG8_BAR; PG8_SCHED;
            PG8_LDB(B1, 1, 1); PG8_STAGE(PG8_SB(1, 0), b3, voffB);
            PG8_BAR; PG8_WAIT_L(0); PG8_MMA(0, 1, At, B1); PG8_BAR;
            PG8_LDA(At, 1, 1); PG8_STAGE(PG8_SA(1, 0), a3, voffA);
            PG8_BAR; PG8_WAIT_L(0); PG8_MMA(1, 0, At, B0); PG8_BAR; PG8_SCHED;
            PG8_STAGE(PG8_SB(1, 1), b3 + hstep, voffB);
            PG8_WAIT_V(6); PG8_BAR; PG8_MMA(1, 1, At, B1); PG8_BAR;
            }
        }
        if constexpr (ALIGN_EPI) { if (wr == 0) PG8_BAR; }
        if constexpr (!Epi::AFTER_DRAIN) { E(acc, cur, wr, wc, fr, fq); S.done(cur); }
        if (!has_next) break;
#pragma unroll
        for (int a = 0; a < 2; ++a)
#pragma unroll
            for (int b = 0; b < 2; ++b)
#pragma unroll
                for (int m = 0; m < 4; ++m)
#pragma unroll
                    for (int n = 0; n < 2; ++n) acc[a][b][m][n] = (f32x4){0.f, 0.f, 0.f, 0.f};
        cur = nxt; cA = nA; cB = nB; ++ui;
        if constexpr (ALIGN_EPI) { if (wr == 1) PG8_BAR; }
    }
    PG8_WAIT_V(0);
    if constexpr (!ALIGN_EPI) { if (wr == 0) PG8_BAR; }
    PG8_BAR;
    if constexpr (Epi::AFTER_DRAIN) { E.fused(acc, cur, wr, wc, fr, fq, lds, wid, lane); S.done(cur); }
#undef PG8_SA
#undef PG8_SB
#undef PG8_STAGE
#undef PG8_LDA
#undef PG8_LDB
#undef PG8_MMA
#undef PG8_WAIT_V
#undef PG8_WAIT_L
#undef PG8_BAR
#undef PG8_SCHED
}
}
namespace attn {
using bf16 = __hip_bfloat16;
constexpr int   D = 128, NW = 8, QBLK = 32, KVBLK = 64;
constexpr float SCALE = 0.088388347648318440f;
#ifndef ATTN_THR
#define ATTN_THR 8.f
#endif
constexpr float THR = ATTN_THR;
constexpr int SDEPTH = 2;
constexpr int LDQ = 3584, LDK = 128, LDO = 2048;
constexpr size_t SHM_V = KVBLK * D * 2, SHM_K = KVBLK * D * 2, SHM_ATTN = 2 * SHM_V + 2 * SHM_K + NW * 64 * 4;
__device__ __forceinline__ unsigned short f2bf16(float f) { unsigned u = __builtin_bit_cast(unsigned, f); return (unsigned short)((u + 0x7fffu + ((u >> 16) & 1u)) >> 16); }
using bf16x8 = __attribute__((ext_vector_type(8))) short;
using s16x4  = __attribute__((ext_vector_type(4))) short;
using f32x16 = __attribute__((ext_vector_type(16))) float;
using f32x8  = __attribute__((ext_vector_type(8))) float;
using u32x4  = __attribute__((ext_vector_type(4))) unsigned;
#define KSWZ(row, colB) ((row) * 256 + ((colB) ^ (((row) & 7) << 4)))
#define SBAR() __builtin_amdgcn_sched_barrier(0)
__device__ __forceinline__ int crow(int r, int hi) { return (r & 3) + 8 * (r >> 2) + 4 * hi; }
__device__ __forceinline__ unsigned cvtpk(float lo, float hi) {
  unsigned r; asm volatile("v_cvt_pk_bf16_f32 %0, %1, %2" : "=v"(r) : "v"(lo), "v"(hi)); return r;
}
template <typename TIn> struct Stage;
template <> struct Stage<bf16>  { using T = bf16x8;
  __device__ static __forceinline__ T ld8(const bf16* p) { return *reinterpret_cast<const bf16x8*>(p); }
  __device__ static __forceinline__ bf16x8 tobf(T x) { return x; } };
template <> struct Stage<float> { using T = f32x8;
  __device__ static __forceinline__ T ld8(const float* p) { return *reinterpret_cast<const f32x8*>(p); }
  __device__ static __forceinline__ bf16x8 tobf(T x) {
    u32x4 w = {cvtpk(x[0], x[1]), cvtpk(x[2], x[3]), cvtpk(x[4], x[5]), cvtpk(x[6], x[7])}; return *reinterpret_cast<bf16x8*>(&w); } };

__device__ __forceinline__ void partialSM(f32x16& p0, f32x16& p1, float& m_reg, float& mn, float& alpha) {
  constexpr float C = SCALE * 1.4426950408889634f;
  float pmax = p0[0]; for (int r = 1; r < 16; ++r) pmax = fmaxf(pmax, p0[r]); for (int r = 0; r < 16; ++r) pmax = fmaxf(pmax, p1[r]);
  { auto rr = __builtin_amdgcn_permlane32_swap(__float_as_uint(pmax), __float_as_uint(pmax), false, false);
    pmax = fmaxf(__uint_as_float(rr[0]), __uint_as_float(rr[1])); }
  if (__builtin_expect(__all(pmax - m_reg <= THR / SCALE), 1)) { mn = m_reg; alpha = 1.f; }
  else { mn = fmaxf(m_reg, pmax); alpha = __builtin_amdgcn_exp2f((m_reg - mn) * C); m_reg = mn; }
  float mnC = -mn * C;
  for (int r = 0; r < 16; ++r) p0[r] = fmaf(p0[r], C, mnC); for (int r = 0; r < 16; ++r) p1[r] = fmaf(p1[r], C, mnC);
  for (int r = 0; r < 16; ++r) p0[r] = __builtin_amdgcn_exp2f(p0[r]);
}
__device__ __forceinline__ void finishSM(f32x16& p0, f32x16& p1, float alpha, float& l_reg, bf16x8& pa0, bf16x8& pa1, bf16x8& pa2, bf16x8& pa3) {
  for (int r = 0; r < 16; ++r) p1[r] = __builtin_amdgcn_exp2f(p1[r]);
  float ps = 0; for (int r = 0; r < 16; ++r) ps += p0[r]; for (int r = 0; r < 16; ++r) ps += p1[r];
  { auto rr = __builtin_amdgcn_permlane32_swap(__float_as_uint(ps), __float_as_uint(ps), false, false);
    ps = __uint_as_float(rr[0]) + __uint_as_float(rr[1]); }
  l_reg = l_reg * alpha + ps;
#define PK4(P, BASE, OUT) do { unsigned a0 = cvtpk(P[BASE + 0], P[BASE + 1]), a1 = cvtpk(P[BASE + 2], P[BASE + 3]);   \
    unsigned b0 = cvtpk(P[BASE + 4], P[BASE + 5]), b1 = cvtpk(P[BASE + 6], P[BASE + 7]);                              \
    auto r0 = __builtin_amdgcn_permlane32_swap(a0, b0, false, false); auto r1 = __builtin_amdgcn_permlane32_swap(a1, b1, false, false); \
    u32x4 w = {r0[0], r1[0], r0[1], r1[1]}; OUT = *reinterpret_cast<bf16x8*>(&w); } while (0)
  PK4(p0, 0, pa0); PK4(p0, 8, pa1); PK4(p1, 0, pa2); PK4(p1, 8, pa3);
#undef PK4
}
__device__ __forceinline__ void qkt(f32x16& p0, f32x16& p1, const bf16* Ks, const bf16x8* qr, int r32, int hi) {
  p0 = f32x16{}; p1 = f32x16{};
  for (int d0 = 0; d0 < 8; ++d0) { int cb = (d0 * 16 + hi * 8) * 2;
    bf16x8 b0 = *reinterpret_cast<const bf16x8*>((const char*)Ks + KSWZ(r32, cb));
    bf16x8 b1 = *reinterpret_cast<const bf16x8*>((const char*)Ks + KSWZ(32 + r32, cb));
    p0 = __builtin_amdgcn_mfma_f32_32x32x16_bf16(b0, qr[d0], p0, 0, 0, 0);
    p1 = __builtin_amdgcn_mfma_f32_32x32x16_bf16(b1, qr[d0], p1, 0, 0, 0); }
}
__device__ __forceinline__ int v_st(int k, int c) { const int kk = (k & ~0xC) | ((k & 4) << 1) | ((k & 8) >> 1); return ((kk >> 3) * 4 + (c >> 5)) * 512 + ((kk & 7) * 32 + (c & 31)) * 2; }
__device__ __forceinline__ int v_rd_base(int lane) { return ((lane & 3) << 3) | (((lane >> 2) & 3) << 6) | (((lane >> 4) & 1) << 5) | (((lane >> 5) & 1) << 8); }
constexpr int v_rd_off(int d0, int ks, int half) { return d0 * 512 + ks * 4096 + half * 2048; }
template <int OFF> __device__ __forceinline__ s16x4 tr_read(int vb) {
  s16x4 r; asm volatile("ds_read_b64_tr_b16 %0, %1 offset:%2" : "=&v"(r) : "v"(vb), "i"(OFF) : "memory"); return r;
}
template <int D0> __device__ __forceinline__ void pv_one(f32x16& od, int vb, bf16x8 pa0, bf16x8 pa1, bf16x8 pa2, bf16x8 pa3) {
  const s16x4 l0 = tr_read<v_rd_off(D0, 0, 0)>(vb), h0 = tr_read<v_rd_off(D0, 0, 1)>(vb), l1 = tr_read<v_rd_off(D0, 1, 0)>(vb), h1 = tr_read<v_rd_off(D0, 1, 1)>(vb);
  const s16x4 l2 = tr_read<v_rd_off(D0, 2, 0)>(vb), h2 = tr_read<v_rd_off(D0, 2, 1)>(vb), l3 = tr_read<v_rd_off(D0, 3, 0)>(vb), h3 = tr_read<v_rd_off(D0, 3, 1)>(vb);
  asm volatile("s_waitcnt lgkmcnt(0)" ::: "memory"); SBAR();
#define PK(L, H) (bf16x8){L[0], L[1], L[2], L[3], H[0], H[1], H[2], H[3]}
  od = __builtin_amdgcn_mfma_f32_32x32x16_bf16(pa0, PK(l0, h0), od, 0, 0, 0);
  od = __builtin_amdgcn_mfma_f32_32x32x16_bf16(pa1, PK(l1, h1), od, 0, 0, 0);
  od = __builtin_amdgcn_mfma_f32_32x32x16_bf16(pa2, PK(l2, h2), od, 0, 0, 0);
  od = __builtin_amdgcn_mfma_f32_32x32x16_bf16(pa3, PK(l3, h3), od, 0, 0, 0);
#undef PK
}
__device__ __forceinline__ void pv_d0(f32x16* o, int vb, bf16x8 pa0, bf16x8 pa1, bf16x8 pa2, bf16x8 pa3) {
  pv_one<0>(o[0], vb, pa0, pa1, pa2, pa3); pv_one<1>(o[1], vb, pa0, pa1, pa2, pa3); pv_one<2>(o[2], vb, pa0, pa1, pa2, pa3); pv_one<3>(o[3], vb, pa0, pa1, pa2, pa3);
}
__device__ __forceinline__ void attn_dense_body(const unsigned short* __restrict__ Qraw, const float* __restrict__ qgain, const float* __restrict__ rope, int t0,
                                                const bf16* __restrict__ Kh, const bf16* __restrict__ Vh, unsigned short* __restrict__ Ob, int seq, char* lds) {
  using St = Stage<bf16>;
  const int tid = threadIdx.x, wid = tid >> 6, lane = tid & 63, r32 = lane & 31, hi = lane >> 5;
  bf16* V_lds = (bf16*)lds; bf16* K_lds = (bf16*)(lds + 2 * SHM_V);
  float* ws = (float*)(lds + 2 * SHM_V + 2 * SHM_K) + wid * 64; float* li_l = ws; float* al_l = ws + 32;
  float m_reg = -1e30f, l_reg = 0; f32x16 o[4] = {}; bf16x8 qr[8];
  { const unsigned short* Qw = Qraw + (long)(wid * QBLK + r32) * LDQ + hi * 8;
    float xf[8][8]; float ss = 0.f;
#pragma unroll
    for (int d0 = 0; d0 < 8; ++d0) { const u32x4 w = *reinterpret_cast<const u32x4*>(Qw + d0 * 16);
#pragma unroll
      for (int j = 0; j < 4; ++j) { xf[d0][2 * j] = __uint_as_float(w[j] << 16); xf[d0][2 * j + 1] = __uint_as_float(w[j] & 0xffff0000u); }
#pragma unroll
      for (int j = 0; j < 8; ++j) ss += xf[d0][j] * xf[d0][j]; }
    { auto rr = __builtin_amdgcn_permlane32_swap(__float_as_uint(ss), __float_as_uint(ss), false, false); ss = __uint_as_float(rr[0]) + __uint_as_float(rr[1]); }
    const float rn = 1.f / sqrtf(ss * (1.f / 128.f) + 1e-6f);
#pragma unroll
    for (int d0 = 0; d0 < 8; ++d0) { const float4 g0 = *reinterpret_cast<const float4*>(qgain + d0 * 16 + hi * 8), g1 = *reinterpret_cast<const float4*>(qgain + d0 * 16 + hi * 8 + 4);
      xf[d0][0] *= rn * g0.x; xf[d0][1] *= rn * g0.y; xf[d0][2] *= rn * g0.z; xf[d0][3] *= rn * g0.w; xf[d0][4] *= rn * g1.x; xf[d0][5] *= rn * g1.y; xf[d0][6] *= rn * g1.z; xf[d0][7] *= rn * g1.w; }
    if (t0 >= 0) { const int t = t0 + wid * QBLK + r32;
#pragma unroll
      for (int a = 0; a < 2; ++a) { const int pos = a ? (t & 63) : (t >> 6);
#pragma unroll
        for (int hh = 0; hh < 2; ++hh) { const int d1 = 4 * a + hh, d2 = d1 + 2; const float* rp = rope + (long)(pos * 32 + hh * 16 + hi * 8) * 2;
#pragma unroll
          for (int jj = 0; jj < 4; ++jj) { const float4 cs = *reinterpret_cast<const float4*>(rp + 4 * jj);
            { const float y1 = xf[d1][2 * jj], y2 = xf[d2][2 * jj]; xf[d1][2 * jj] = y1 * cs.x - y2 * cs.y; xf[d2][2 * jj] = y1 * cs.y + y2 * cs.x; }
            { const float y1 = xf[d1][2 * jj + 1], y2 = xf[d2][2 * jj + 1]; xf[d1][2 * jj + 1] = y1 * cs.z - y2 * cs.w; xf[d2][2 * jj + 1] = y1 * cs.w + y2 * cs.z; } } } } }
#pragma unroll
    for (int d0 = 0; d0 < 8; ++d0) { u32x4 w = {cvtpk(xf[d0][0], xf[d0][1]), cvtpk(xf[d0][2], xf[d0][3]), cvtpk(xf[d0][4], xf[d0][5]), cvtpk(xf[d0][6], xf[d0][7])}; qr[d0] = *reinterpret_cast<bf16x8*>(&w); } }
  const int sr = tid >> 4, sc = (tid & 15) * 8, vst0 = v_st(sr, sc), vst1 = v_st(32 + sr, sc);
  const int vb0 = (int)(uintptr_t)V_lds + v_rd_base(lane);
  struct { typename St::T vs0, vs1, ks0, ks1; } sr_[SDEPTH];
#define SLOAD(i, k0) do { sr_[i].vs0 = St::ld8(&Vh[(long)((k0) + sr) * LDK + sc]); sr_[i].vs1 = St::ld8(&Vh[(long)((k0) + 32 + sr) * LDK + sc]); \
    sr_[i].ks0 = St::ld8(&Kh[(long)((k0) + sr) * LDK + sc]); sr_[i].ks1 = St::ld8(&Kh[(long)((k0) + 32 + sr) * LDK + sc]); } while (0)
#define SWRITE(b, i) do { *(bf16x8*)((char*)V_lds + (b) * SHM_V + vst0) = St::tobf(sr_[i].vs0);          \
    *(bf16x8*)((char*)V_lds + (b) * SHM_V + vst1) = St::tobf(sr_[i].vs1); int kc = sc * 2;               \
    *(bf16x8*)((char*)K_lds + (b) * SHM_K + KSWZ(sr, kc)) = St::tobf(sr_[i].ks0);                       \
    *(bf16x8*)((char*)K_lds + (b) * SHM_K + KSWZ(32 + sr, kc)) = St::tobf(sr_[i].ks1); } while (0)
#define SWAIT() do { if constexpr (SDEPTH == 2) asm volatile("s_waitcnt vmcnt(4)" ::: "memory"); else asm volatile("s_waitcnt vmcnt(0)" ::: "memory"); } while (0)
#define RESC(a) do { if (__any((a) < 1.f)) { if (hi == 0) al_l[r32] = (a); asm volatile("s_waitcnt lgkmcnt(0)" ::: "memory"); \
    for (int d = 0; d < 4; ++d) for (int r = 0; r < 16; ++r) o[d][r] *= al_l[crow(r, hi)]; } } while (0)
  f32x16 pA0, pA1, pB0, pB1; float mnA, mnB, alA, alB; bf16x8 pa0, pa1, pa2, pa3; const int NT = seq / KVBLK;
  constexpr int SE = 0, SO = SDEPTH - 1;
  SLOAD(SE, 0); asm volatile("s_waitcnt vmcnt(0)" ::: "memory"); SWRITE(0, SE); __syncthreads();
  qkt(pA0, pA1, K_lds, qr, r32, hi); partialSM(pA0, pA1, m_reg, mnA, alA);
  SLOAD(SO, KVBLK); if constexpr (SDEPTH == 2) { if (2 < NT) SLOAD(SE, 2 * KVBLK); }
  SWAIT(); SWRITE(1, SO); __syncthreads();
  for (int j = 1; j + 1 < NT; j += 2) {
    SBAR(); qkt(pB0, pB1, (bf16*)((char*)K_lds + SHM_K), qr, r32, hi);
    finishSM(pA0, pA1, alA, l_reg, pa0, pa1, pa2, pa3); SBAR();
    SLOAD(SO, (j + SDEPTH) * KVBLK); SBAR();
    pv_d0(o, vb0, pa0, pa1, pa2, pa3); partialSM(pB0, pB1, m_reg, mnB, alB);
    __syncthreads(); SWAIT(); SWRITE(0, SE);
    RESC(alB); __syncthreads();
    SBAR(); qkt(pA0, pA1, K_lds, qr, r32, hi);
    finishSM(pB0, pB1, alB, l_reg, pa0, pa1, pa2, pa3); SBAR();
    if (SDEPTH == 1 || j + 3 < NT) SLOAD(SE, (j + 1 + SDEPTH) * KVBLK); SBAR();
    pv_d0(o, vb0 + (int)SHM_V, pa0, pa1, pa2, pa3); partialSM(pA0, pA1, m_reg, mnA, alA);
    __syncthreads(); SWAIT(); SWRITE(1, SO);
    RESC(alA); __syncthreads();
  }
  SBAR(); qkt(pB0, pB1, (bf16*)((char*)K_lds + SHM_K), qr, r32, hi);
  finishSM(pA0, pA1, alA, l_reg, pa0, pa1, pa2, pa3); SBAR();
  pv_d0(o, vb0, pa0, pa1, pa2, pa3); partialSM(pB0, pB1, m_reg, mnB, alB);
  __syncthreads(); RESC(alB);
  finishSM(pB0, pB1, alB, l_reg, pa0, pa1, pa2, pa3); SBAR();
  pv_d0(o, vb0 + (int)SHM_V, pa0, pa1, pa2, pa3);
  if (hi == 0) li_l[r32] = l_reg; asm volatile("s_waitcnt lgkmcnt(0)" ::: "memory");
  float rli[16];
#pragma unroll
  for (int r = 0; r < 16; ++r) rli[r] = __builtin_amdgcn_rcpf(li_l[crow(r, hi)]);
  unsigned short* Ow = Ob + (long)(wid * QBLK) * LDO;
#pragma unroll
  for (int r = 0; r < 16; ++r) { int orow = crow(r, hi);
    for (int d0 = 0; d0 < 4; ++d0) Ow[(long)orow * LDO + d0 * 32 + r32] = f2bf16(o[d0][r] * rli[r]); }
#undef SLOAD
#undef SWRITE
#undef SWAIT
#undef RESC
}
}
#define GAS __attribute__((address_space(1)))
#define LAS __attribute__((address_space(3)))
typedef unsigned short bf16r;
typedef float f32x4 __attribute__((ext_vector_type(4)));
typedef unsigned u32x4 __attribute__((ext_vector_type(4)));
typedef unsigned u32x2 __attribute__((ext_vector_type(2)));
typedef short bf16x8 __attribute__((ext_vector_type(8)));

constexpr int DM = 2048, NB = 4, SEQ = 4096, CTX = 256, NLAT = NB * SEQ, NCTX = NB * CTX, NROW = NLAT + NCTX;
constexpr int INC = 3584, DFF = 8192, NMODC = 6 * DM, KVLEN = CTX + SEQ;
constexpr int NLAYER = 2;
constexpr float LN_EPS = 1e-6f, RMS_EPS = 1e-6f, DN_ALPHA = 1.4142135623730951f;
constexpr size_t MiB = 1u << 20;
constexpr size_t WS_ROPE = 0, WS_BAR = 768 * 1024, WS_BAR_BYTES = 16384, WS_STAT = 576 * 1024, WS_MOD = 64 * 1024, WS_WIN = 1 * MiB, WS_WOUT = 29 * MiB, WS_WFF1 = 45 * MiB, WS_WFF2 = 109 * MiB;
constexpr size_t WS_X = 173 * MiB, WS_H = 309 * MiB, WS_S = 377 * MiB;
constexpr size_t WS_P = WS_S, WS_Q = 496 * MiB, WS_K = 530 * MiB, WS_V = 539 * MiB, WS_MIX = 548 * MiB, WS_ACT = WS_S, WS_PART = 649 * MiB, WS_END = 713 * MiB;
static_assert(WS_WIN + 2ull * INC * DM * 2 <= WS_WOUT && WS_WOUT + 2ull * DM * DM * 2 <= WS_WFF1 && WS_WFF1 + 2ull * DFF * DM * 2 <= WS_WFF2 && WS_WFF2 + 2ull * DFF * DM * 2 <= WS_X, "ws weights");
static_assert(WS_X + (size_t)NROW * DM * 4 <= WS_H && WS_H + (size_t)NROW * DM * 2 <= WS_S && WS_P + (size_t)NROW * INC * 2 <= WS_Q && WS_Q + (size_t)NROW * 1024 * 2 <= WS_K, "ws act 1");
static_assert(WS_K + (size_t)NB * 2 * KVLEN * 128 * 2 <= WS_V && WS_V + (size_t)NB * 2 * KVLEN * 128 * 2 <= WS_MIX && WS_MIX + (size_t)NROW * DM * 2 <= WS_PART && WS_ACT + (size_t)NROW * DFF * 2 <= WS_PART && WS_PART + 8ull * NCTX * DM * 4 <= WS_END, "ws act 2");
static_assert(WS_MOD + 2ull * 5 * NMODC * 4 <= WS_STAT && WS_STAT + (size_t)NROW * 8 <= WS_BAR && WS_BAR + WS_BAR_BYTES <= WS_WIN, "ws mod");
constexpr int LDS_BYTES = 147456;

__device__ __forceinline__ unsigned f2bf(float f) { unsigned u = __builtin_bit_cast(unsigned, f); return (u + 0x7fffu + ((u >> 16) & 1u)) >> 16; }
__device__ __forceinline__ unsigned pk2(float lo, float hi) { return f2bf(lo) | (f2bf(hi) << 16); }
__device__ __forceinline__ float bflo(unsigned w) { return __builtin_bit_cast(float, w << 16); }
__device__ __forceinline__ float bfhi(unsigned w) { return __builtin_bit_cast(float, w & 0xffff0000u); }
__device__ __forceinline__ void unpack8(const u32x4 w, float (&x)[8]) { x[0] = bflo(w.x); x[1] = bfhi(w.x); x[2] = bflo(w.y); x[3] = bfhi(w.y); x[4] = bflo(w.z); x[5] = bfhi(w.z); x[6] = bflo(w.w); x[7] = bfhi(w.w); }
__device__ __forceinline__ u32x4 pack8(const float (&x)[8]) { u32x4 w; w.x = pk2(x[0], x[1]); w.y = pk2(x[2], x[3]); w.z = pk2(x[4], x[5]); w.w = pk2(x[6], x[7]); return w; }
__device__ __forceinline__ float wave_sum(float v) {
#pragma unroll
    for (int o = 1; o < 64; o <<= 1) v += __shfl_xor(v, o);
    return v;
}
__device__ __forceinline__ float gelu_tanh(float x) {
    const float u = 0.7978845608028654f * (x + 0.044715f * x * x * x);
    const float e = __expf(2.f * u);
    const float t = 1.f - 2.f * __builtin_amdgcn_rcpf(e + 1.f);
    return 0.5f * x * (1.f + t);
}
__device__ __forceinline__ float sigmoidf_(float x) { return __builtin_amdgcn_rcpf(1.f + __expf(-x)); }
#define LDS_WAIT() asm volatile("s_waitcnt lgkmcnt(0)" ::: "memory")

static __device__ const double ROPE_FREQ[32] = {1.0, 0.7498942093324559, 0.5623413251903491, 0.4216965034285822, 0.31622776601683794, 0.23713737056616552, 0.1778279410038923, 0.1333521432163324, 0.1, 0.07498942093324558, 0.05623413251903491, 0.042169650342858224, 0.03162277660168379, 0.023713737056616554, 0.01778279410038923, 0.01333521432163324, 0.01, 0.007498942093324558, 0.005623413251903491, 0.004216965034285823, 0.0031622776601683794, 0.0023713737056616554, 0.0017782794100389228, 0.001333521432163324, 0.001, 0.0007498942093324559, 0.0005623413251903491, 0.00042169650342858224, 0.00031622776601683794, 0.00023713737056616554, 0.00017782794100389227, 0.0001333521432163324};

__device__ __forceinline__ void p0_rope(float* rope, int gtid, int gthreads) {
    for (int idx = gtid; idx < 64 * 32; idx += gthreads) {
        const int p = idx >> 5, f = idx & 31;
        const double ang = (double)p * ROPE_FREQ[f];
        const double k = __builtin_rint(ang * 0.15915494309189535);
        const double r = ang - k * 6.283185307179586;
        const double r2 = r * r; double tc = 1.0, ts = 1.0, cc = 1.0, ss = 1.0;
#pragma unroll
        for (int n = 1; n <= 14; ++n) { tc *= -r2 * (1.0 / (double)((2 * n - 1) * (2 * n))); cc += tc; ts *= -r2 * (1.0 / (double)((2 * n) * (2 * n + 1))); ss += ts; }
        rope[2 * idx] = (float)cc; rope[2 * idx + 1] = (float)(r * ss);
    }
}
__device__ __forceinline__ void p0_mod(LAS unsigned char* lds, const float* c, const float* c_ctx, const float* w_mod, const float* b_mod, float* MOD, int item0, int nitem, int bid, int G, int tid) {
    const int NITEM = item0 + nitem;
    if (bid < 0 || bid >= nitem) return;
    LAS float* condS = (LAS float*)lds;
    LAS float* red = (LAS float*)(lds + 5 * 2048 * 4);
    for (int i = tid; i < 5 * 2048; i += 512) { const int r = i >> 11, k = i & 2047; const float cv = (r < 4) ? c[r * 2048 + k] : c_ctx[k]; condS[i] = cv / (1.f + __expf(-cv)); }
    __syncthreads();
    const int kr = tid >> 5, cl = tid & 31;
    for (int item = item0 + bid; item < NITEM; item += G) {
        const int l = item / (NMODC / 128), n0 = (item % (NMODC / 128)) * 128;
        const float* wp = w_mod + ((size_t)l * 2048 + kr) * NMODC + n0 + 4 * cl;
        float acc[5][4];
#pragma unroll
        for (int r = 0; r < 5; ++r)
#pragma unroll
            for (int j = 0; j < 4; ++j) acc[r][j] = 0.f;
#pragma unroll 4
        for (int ks = 0; ks < 128; ++ks) {
            const f32x4 w = *(const f32x4*)(wp + (size_t)ks * 16 * NMODC); const int k = ks * 16 + kr;
#pragma unroll
            for (int r = 0; r < 5; ++r) { const float s = condS[r * 2048 + k];
#pragma unroll
                for (int j = 0; j < 4; ++j) acc[r][j] += s * w[j]; }
        }
#pragma unroll
        for (int r = 0; r < 5; ++r)
#pragma unroll
            for (int j = 0; j < 4; ++j) red[(kr * 32 + cl) * 20 + r * 4 + j] = acc[r][j];
        __syncthreads();
        for (int o = tid; o < 5 * 128; o += 512) { const int r = o >> 7, col = o & 127; float s = 0.f;
#pragma unroll
            for (int k2 = 0; k2 < 16; ++k2) s += red[(k2 * 32 + (col >> 2)) * 20 + r * 4 + (col & 3)];
            MOD[((size_t)l * 5 + r) * NMODC + n0 + col] = s + b_mod[(size_t)l * NMODC + n0 + col]; }
        __syncthreads();
    }
}
__device__ __forceinline__ void p0_transpose_item(const float* W, int K, int N, bf16r* WT, LAS float* scr, int item, int lane) {
    const int nblk = N / 64, kb = item / nblk, nb = item % nblk, k0 = 64 * kb, n0 = 64 * nb;
    const int r4 = lane >> 4, c4 = (lane & 15) * 4;
    f32x4 v[16];
#pragma unroll
    for (int i = 0; i < 16; ++i) v[i] = *(const f32x4*)(W + (size_t)(k0 + 4 * i + r4) * N + n0 + c4);
#pragma unroll
    for (int i = 0; i < 16; ++i) { LAS float* d = scr + (4 * i + r4) * 65 + c4; d[0] = v[i].x; d[1] = v[i].y; d[2] = v[i].z; d[3] = v[i].w; }
    LDS_WAIT(); asm volatile("" ::: "memory");
    const int c = lane & 7;
#pragma unroll
    for (int j = 0; j < 8; ++j) { const int n = (lane >> 3) + 8 * j; const LAS float* s = scr + (8 * c) * 65 + n;
        u32x4 o; o.x = pk2(s[0 * 65], s[1 * 65]); o.y = pk2(s[2 * 65], s[3 * 65]); o.z = pk2(s[4 * 65], s[5 * 65]); o.w = pk2(s[6 * 65], s[7 * 65]);
        *(u32x4*)(WT + (size_t)(n0 + n) * K + k0 + 8 * c) = o; }
    LDS_WAIT(); asm volatile("" ::: "memory");
}

__device__ __forceinline__ void row_stats(const f32x4 (&v)[8], float& mean, float& rstd) {
    float s = 0.f;
#pragma unroll
    for (int j = 0; j < 8; ++j) s += (v[j].x + v[j].y) + (v[j].z + v[j].w);
    mean = wave_sum(s) * (1.f / DM); float q = 0.f;
#pragma unroll
    for (int j = 0; j < 8; ++j) { const f32x4 d = v[j] - mean; q += (d.x * d.x + d.y * d.y) + (d.z * d.z + d.w * d.w); }
    rstd = 1.f / sqrtf(wave_sum(q) * (1.f / DM) + LN_EPS);
}
__device__ __forceinline__ void row_pass(const float* src_lat, const float* src_ctx, int nrows, const float* lng, const float* lnb, float* dst_lat, float* dst_ctx, float* stat,
                                         const float* modl  , int shift_off, int scale_off, bf16r* H, int gw, int NGW, int lane) {
    f32x4 v[8], vn[8];
    if (gw < nrows) { const float* sp = gw < NLAT ? src_lat + (size_t)gw * DM : src_ctx + (size_t)(gw - NLAT) * DM;
#pragma unroll
        for (int j = 0; j < 8; ++j) v[j] = *((const f32x4*)sp + 64 * j + lane); }
    for (int row = gw; row < nrows; row += NGW) {
        const bool lat = row < NLAT;
        const int rown = row + NGW;
        if (rown < nrows) { const float* sp = rown < NLAT ? src_lat + (size_t)rown * DM : src_ctx + (size_t)(rown - NLAT) * DM;
#pragma unroll
            for (int j = 0; j < 8; ++j) vn[j] = *((const f32x4*)sp + 64 * j + lane); }
        float mean, rstd;
        if (lng) {
            row_stats(v, mean, rstd);
            if (stat && lane == 0) { stat[2 * (size_t)row] = mean; stat[2 * (size_t)row + 1] = rstd; }
            float* dp = lat ? (dst_lat ? dst_lat + (size_t)row * DM : nullptr) : (dst_ctx ? dst_ctx + (size_t)(row - NLAT) * DM : nullptr);
#pragma unroll
            for (int j = 0; j < 8; ++j) { const f32x4 g = *((const f32x4*)lng + 64 * j + lane), b = *((const f32x4*)lnb + 64 * j + lane);
                v[j] = (v[j] - mean) * rstd * g + b; if (dp) *((f32x4*)dp + 64 * j + lane) = v[j]; }
        }
        if (modl) {
            row_stats(v, mean, rstd);
            const float* mr = modl + (size_t)(lat ? (row >> 12) : 4) * NMODC;
            bf16r* hp = H + (size_t)row * DM;
#pragma unroll
            for (int j = 0; j < 8; ++j) { const f32x4 sh = *((const f32x4*)(mr + shift_off) + 64 * j + lane), sc = *((const f32x4*)(mr + scale_off) + 64 * j + lane);
                const f32x4 o = (v[j] - mean) * rstd * (sc + 1.f) + sh; u32x2 w; w.x = pk2(o.x, o.y); w.y = pk2(o.z, o.w);
                *((u32x2*)hp + 64 * j + lane) = w; }
        }
#pragma unroll
        for (int j = 0; j < 8; ++j) v[j] = vn[j];
    }
}
__device__ __forceinline__ void row_pass_ctx(const float* src, const float* bstat, const float* bg, const float* bb, const float* part, const float* gate  , float* xdst,
                                             const float* lng, const float* lnb, float* stat, const float* modl, int shift_off, int scale_off, bf16r* H, int gw, int NGW, int lane) {
    for (int r = gw; r < NCTX; r += NGW) {
        const int row = NLAT + r;
        f32x4 v[8];
        float bm = 0.f, brs = 1.f; if (bstat) { bm = bstat[2 * (size_t)row]; brs = bstat[2 * (size_t)row + 1]; }
#pragma unroll
        for (int j = 0; j < 8; ++j) { f32x4 x = *((const f32x4*)(src + (size_t)r * DM) + 64 * j + lane);
            if (bstat) x = (x - bm) * brs * *((const f32x4*)bg + 64 * j + lane) + *((const f32x4*)bb + 64 * j + lane);
            f32x4 s = *((const f32x4*)(part + (size_t)r * DM) + 64 * j + lane);
#pragma unroll
            for (int k = 1; k < 8; ++k) s += *((const f32x4*)(part + ((size_t)k * NCTX + r) * DM) + 64 * j + lane);
            v[j] = x * DN_ALPHA + *((const f32x4*)gate + 64 * j + lane) * s;
            if (xdst) *((f32x4*)(xdst + (size_t)r * DM) + 64 * j + lane) = v[j]; }
        float mean, rstd;
        row_stats(v, mean, rstd);
        if (lane == 0) { stat[2 * (size_t)row] = mean; stat[2 * (size_t)row + 1] = rstd; }
#pragma unroll
        for (int j = 0; j < 8; ++j) v[j] = (v[j] - mean) * rstd * *((const f32x4*)lng + 64 * j + lane) + *((const f32x4*)lnb + 64 * j + lane);
        row_stats(v, mean, rstd);
        const float* mr = modl + (size_t)4 * NMODC;
        bf16r* hp = H + (size_t)row * DM;
#pragma unroll
        for (int j = 0; j < 8; ++j) { const f32x4 sh = *((const f32x4*)(mr + shift_off) + 64 * j + lane), sc = *((const f32x4*)(mr + scale_off) + 64 * j + lane);
            const f32x4 o = (v[j] - mean) * rstd * (sc + 1.f) + sh; u32x2 w; w.x = pk2(o.x, o.y); w.y = pk2(o.z, o.w);
            *((u32x2*)hp + 64 * j + lane) = w; }
    }
}

__device__ __forceinline__ f32x4 ld4_bf(const bf16r* p) { const u32x2 w = *(const u32x2*)p; return (f32x4){bflo(w.x), bfhi(w.x), bflo(w.y), bfhi(w.y)}; }
__device__ __forceinline__ void st4_bf(bf16r* p, const f32x4 o) { u32x2 w; w.x = pk2(o.x, o.y); w.y = pk2(o.z, o.w); *(u32x2*)p = w; }
typedef _Float16 h16x4 __attribute__((ext_vector_type(4)));
__device__ __forceinline__ f32x4 ld4_h(const bf16r* p) { const h16x4 h = *(const h16x4*)p; return __builtin_convertvector(h, f32x4); }
__device__ __forceinline__ void st4_h(bf16r* p, const f32x4 o) { *(h16x4*)p = __builtin_convertvector(o, h16x4); }
typedef _Float16 h16x8 __attribute__((ext_vector_type(8)));
typedef float f32x8v __attribute__((ext_vector_type(8)));
__device__ __forceinline__ void ld8_h(const bf16r* p, f32x4& a, f32x4& b) { const h16x8 h = *(const h16x8*)p; const f32x8v f = __builtin_convertvector(h, f32x8v); a = (f32x4){f[0], f[1], f[2], f[3]}; b = (f32x4){f[4], f[5], f[6], f[7]}; }
__device__ __forceinline__ void st8_h(bf16r* p, const f32x4 a, const f32x4 b) { const f32x8v f = {a.x, a.y, a.z, a.w, b.x, b.y, b.z, b.w}; *(h16x8*)p = __builtin_convertvector(f, h16x8); }
__device__ __forceinline__ void ld8_bf(const bf16r* p, f32x4& a, f32x4& b) { const u32x4 w = *(const u32x4*)p; a = (f32x4){bflo(w.x), bfhi(w.x), bflo(w.y), bfhi(w.y)}; b = (f32x4){bflo(w.z), bfhi(w.z), bflo(w.w), bfhi(w.w)}; }
__device__ __forceinline__ void st8_bf(bf16r* p, const f32x4 a, const f32x4 b) { u32x4 w; w.x = pk2(a.x, a.y); w.y = pk2(a.z, a.w); w.z = pk2(b.x, b.y); w.w = pk2(b.z, b.w); *(u32x4*)p = w; }
template <bool SRC_F32, bool OUT_F32>
__device__ __forceinline__ void row_pass_res(LAS unsigned char* lds, const float* srcf, const bf16r* XSi, const bf16r* Y, int nrows, const float* modl_cur, int gate_off, const float* lng, const float* lnb,
                                             bf16r* XSo, float* outf, const float* modl_next, int shift_off, int scale_off, bf16r* H, int gw, int NGW, int lane) {
    constexpr int wpb = 512;
    if (NGW != wpb * NB || nrows != NLAT) return;
    const int b = gw >> 9, w0 = gw & 511;
    LAS f32x4* V = (LAS f32x4*)lds;
    { const float* gp = modl_cur + (size_t)b * NMODC + gate_off; const float* mr = modl_next ? modl_next + (size_t)b * NMODC : modl_cur;
      const int t = threadIdx.x;
      V[t] = *(const f32x4*)(gp + 4 * t); V[512 + t] = *(const f32x4*)(lng + 4 * t); V[1024 + t] = *(const f32x4*)(lnb + 4 * t);
      if (modl_next) { V[1536 + t] = *(const f32x4*)(mr + scale_off + 4 * t) + 1.f; V[2048 + t] = *(const f32x4*)(mr + shift_off + 4 * t); } }
    __syncthreads();
#pragma unroll 1
    for (int rr = w0; rr < SEQ; rr += wpb) {
        const int row = b * SEQ + rr;
        f32x4 v[8];
#pragma unroll
        for (int j = 0; j < 4; ++j) { const int q = 2 * (64 * j + lane), e = 4 * q;
            f32x4 x0, x1, y0, y1;
            if (SRC_F32) { x0 = *(const f32x4*)(srcf + (size_t)row * DM + e); x1 = *(const f32x4*)(srcf + (size_t)row * DM + e + 4); } else ld8_h(XSi + (size_t)row * DM + e, x0, x1);
            ld8_bf(Y + (size_t)row * DM + e, y0, y1);
            v[2 * j] = x0 * DN_ALPHA + V[q] * y0; v[2 * j + 1] = x1 * DN_ALPHA + V[q + 1] * y1; }
        float mean, rstd; row_stats(v, mean, rstd);
#pragma unroll
        for (int j = 0; j < 4; ++j) { const int q = 2 * (64 * j + lane), e = 4 * q;
            v[2 * j] = (v[2 * j] - mean) * rstd * V[512 + q] + V[1024 + q]; v[2 * j + 1] = (v[2 * j + 1] - mean) * rstd * V[512 + q + 1] + V[1024 + q + 1];
            if (OUT_F32) { *(f32x4*)(outf + (size_t)row * DM + e) = v[2 * j]; *(f32x4*)(outf + (size_t)row * DM + e + 4) = v[2 * j + 1]; } else st8_h(XSo + (size_t)row * DM + e, v[2 * j], v[2 * j + 1]); }
        if (modl_next) { row_stats(v, mean, rstd);
#pragma unroll
            for (int j = 0; j < 4; ++j) { const int q = 2 * (64 * j + lane), e = 4 * q;
                const f32x4 o0 = (v[2 * j] - mean) * rstd * V[1536 + q] + V[2048 + q], o1 = (v[2 * j + 1] - mean) * rstd * V[1536 + q + 1] + V[2048 + q + 1];
                st8_bf(H + (size_t)row * DM + e, o0, o1); } }
    }
    __syncthreads();
}
template <bool SRC_F32>
__device__ __forceinline__ void row_pass_ctx_res(const float* srcf, bf16r* XS, const float* part, const float* gate, const float* lng, const float* lnb, bool write_xs,
                                                 const float* modl_next, int shift_off, int scale_off, bf16r* H, int gw, int NGW, int lane) {
    for (int r = gw; r < NCTX; r += NGW) {
        const int row = NLAT + r; f32x4 v[8];
#pragma unroll
        for (int j = 0; j < 8; ++j) { const int e = 4 * (64 * j + lane);
            f32x4 xp; if (SRC_F32) xp = *(const f32x4*)(srcf + (size_t)r * DM + e); else xp = ld4_h(XS + (size_t)row * DM + e);
            f32x4 s = *(const f32x4*)(part + (size_t)r * DM + e);
#pragma unroll
            for (int k = 1; k < 8; ++k) s += *(const f32x4*)(part + ((size_t)k * NCTX + r) * DM + e);
            v[j] = xp * DN_ALPHA + *(const f32x4*)(gate + e) * s; }
        float mean, rstd; row_stats(v, mean, rstd);
#pragma unroll
        for (int j = 0; j < 8; ++j) { const int e = 4 * (64 * j + lane);
            v[j] = (v[j] - mean) * rstd * *(const f32x4*)(lng + e) + *(const f32x4*)(lnb + e);
            if (write_xs) st4_h(XS + (size_t)row * DM + e, v[j]); }
        row_stats(v, mean, rstd); const float* mr = modl_next + (size_t)4 * NMODC;
#pragma unroll
        for (int j = 0; j < 8; ++j) { const int e = 4 * (64 * j + lane);
            const f32x4 o = (v[j] - mean) * rstd * (*(const f32x4*)(mr + scale_off + e) + 1.f) + *(const f32x4*)(mr + shift_off + e);
            st4_bf(H + (size_t)row * DM + e, o); }
    }
}

__device__ __forceinline__ void row_pass0(LAS unsigned char* lds, const float* x_in, const float* ctx_in, const float* mod0  , bf16r* H, int gw, int NGW, int lane) {
    constexpr int wpb = 512;
    if (NGW != wpb * NB) { row_pass(x_in, ctx_in, NROW, nullptr, nullptr, nullptr, nullptr, nullptr, mod0, 0 * DM, 1 * DM, H, gw, NGW, lane); return; }
    const int b = gw >> 9, w0 = gw & 511;
    LAS f32x4* V = (LAS f32x4*)lds;
    { const float* mr = mod0 + (size_t)b * NMODC; const int t = threadIdx.x;
      V[t] = *(const f32x4*)(mr + 1 * DM + 4 * t) + 1.f; V[512 + t] = *(const f32x4*)(mr + 0 * DM + 4 * t); }
    __syncthreads();
#pragma unroll 1
    for (int rr = w0; rr < SEQ; rr += wpb) {
        const int row = b * SEQ + rr; f32x4 v[8];
#pragma unroll
        for (int j = 0; j < 8; ++j) v[j] = *(const f32x4*)(x_in + (size_t)row * DM + 4 * (64 * j + lane));
        float mean, rstd; row_stats(v, mean, rstd);
#pragma unroll
        for (int j = 0; j < 8; ++j) { const f32x4 o = (v[j] - mean) * rstd * V[64 * j + lane] + V[512 + 64 * j + lane]; st4_bf(H + (size_t)row * DM + 4 * (64 * j + lane), o); }
    }
    __syncthreads();
    const float* mr = mod0 + (size_t)4 * NMODC;
    for (int r = gw; r < NCTX; r += NGW) {
        const int row = NLAT + r; f32x4 v[8];
#pragma unroll
        for (int j = 0; j < 8; ++j) v[j] = *(const f32x4*)(ctx_in + (size_t)r * DM + 4 * (64 * j + lane));
        float mean, rstd; row_stats(v, mean, rstd);
#pragma unroll
        for (int j = 0; j < 8; ++j) { const int e = 4 * (64 * j + lane);
            const f32x4 o = (v[j] - mean) * rstd * (*(const f32x4*)(mr + 1 * DM + e) + 1.f) + *(const f32x4*)(mr + 0 * DM + e); st4_bf(H + (size_t)row * DM + e, o); }
    }
}

__device__ __forceinline__ void rms_rope_apply(const u32x4 w1, const u32x4 w2, const float (&g1)[8], const float (&g2)[8], const f32x4 (&rp)[4], bool rope_on, u32x4& o1w, u32x4& o2w) {
    float x1[8], x2[8]; unpack8(w1, x1); unpack8(w2, x2);
    float ss = 0.f;
#pragma unroll
    for (int j = 0; j < 8; ++j) ss += x1[j] * x1[j] + x2[j] * x2[j];
    ss += __shfl_xor(ss, 1); ss += __shfl_xor(ss, 2); ss += __shfl_xor(ss, 4);
    const float rn = 1.f / sqrtf(ss * (1.f / 128.f) + RMS_EPS);
    float o1[8], o2[8];
#pragma unroll
    for (int j = 0; j < 8; ++j) { const float y1 = x1[j] * rn * g1[j], y2 = x2[j] * rn * g2[j];
        float c = 1.f, s = 0.f; if (rope_on) { c = rp[j >> 1][(j & 1) * 2]; s = rp[j >> 1][(j & 1) * 2 + 1]; }
        o1[j] = y1 * c - y2 * s; o2[j] = y1 * s + y2 * c; }
    o1w = pack8(o1); o2w = pack8(o2);
}
__device__ __forceinline__ void prep_qkv(const bf16r* __restrict__ P, bf16r* __restrict__ Qb, bf16r* __restrict__ Kb, bf16r* __restrict__ Vb, const float* __restrict__ qg, const float* __restrict__ kg,
                                         const float* __restrict__ rope, int nrows, bool ctx_q, int gw, int NGW, int lane) {
    const int i = lane & 7, a = i >> 2, f0 = (i & 3) * 8, head = lane >> 3, kvh = (lane & 15) >> 3, vj = lane & 31;
    float gq1[8], gq2[8], gk1[8], gk2[8];
#pragma unroll
    for (int j = 0; j < 8; ++j) { gq1[j] = qg[a * 64 + f0 + j]; gq2[j] = qg[a * 64 + 32 + f0 + j]; gk1[j] = kg[a * 64 + f0 + j]; gk2[j] = kg[a * 64 + 32 + f0 + j]; }
    for (int row0 = gw * 2; row0 < nrows; row0 += NGW * 2) {
        u32x4 k1[2], k2[2], vv[2]; f32x4 rp[2][4];
#pragma unroll
        for (int r = 0; r < 2; ++r) { const int row = row0 + r; const bf16r* prow = P + (size_t)row * INC;
            const bool lat = row < NLAT; const int t = lat ? (row & 4095) : ((row - NLAT) & 255);
            const bf16r* ks = prow + 3072 + kvh * 128 + a * 64 + f0;
            k1[r] = *(const u32x4*)ks; k2[r] = *(const u32x4*)(ks + 32); vv[r] = *(const u32x4*)(prow + 3328 + vj * 8);
            const int pos = (a == 0) ? (t >> 6) : (t & 63); const float* rpp = rope + (size_t)(pos * 32 + f0) * 2;
#pragma unroll
            for (int jj = 0; jj < 4; ++jj) rp[r][jj] = *(const f32x4*)(rpp + 4 * jj); }
#pragma unroll
        for (int r = 0; r < 2; ++r) { const int row = row0 + r;
            const bool lat = row < NLAT; const int b = lat ? (row >> 12) : ((row - NLAT) >> 8), t = lat ? (row & 4095) : ((row - NLAT) & 255);
            const int posk = lat ? CTX + t : t;
            u32x4 o1, o2;
            rms_rope_apply(k1[r], k2[r], gk1, gk2, rp[r], lat, o1, o2);
            if (lane < 16) { bf16r* dst = Kb + ((size_t)(b * 2 + kvh) * KVLEN + posk) * 128 + a * 64 + f0; *(u32x4*)dst = o1; *(u32x4*)(dst + 32) = o2; }
            if (lane < 32) *(u32x4*)(Vb + ((size_t)(b * 2 + (vj >> 4)) * KVLEN + posk) * 128 + (vj & 15) * 8) = vv[r]; }
    }
}

__device__ __forceinline__ void gmlp_ldw(const float* __restrict__ Wh, int wave, int lane, f32x4 (&w)[8]) {
    const float* p = Wh + (size_t)(16 * wave + (lane & 15)) * 128 + 8 * (lane >> 4);
#pragma unroll
    for (int ks = 0; ks < 4; ++ks) { w[2 * ks] = *(const f32x4*)(p + ks * 32); w[2 * ks + 1] = *(const f32x4*)(p + ks * 32 + 4); }
}
__device__ __forceinline__ void gmlp_item(LAS unsigned char* lds, const bf16r* __restrict__ P, bf16r* __restrict__ MIX, const float* __restrict__ lng, const float* __restrict__ lnb,
                                          const float* __restrict__ Ws  , const float* __restrict__ bs  , int ch, int tid, int wave, int lane) {
    constexpr int LDT = 136;
    LAS bf16r* vT = (LAS bf16r*)lds;
    const int r0 = ch * 128;
    f32x4 wreg[8]; gmlp_ldw(Ws, wave, lane, wreg);
    { float gl[8], bl[8];
#pragma unroll
      for (int j = 0; j < 8; ++j) { gl[j] = lng[lane * 8 + j]; bl[j] = lnb[lane * 8 + j]; }
#pragma unroll
      for (int hb = 0; hb < 2; ++hb) {
        u32x4 raw[8];
#pragma unroll
        for (int i = 0; i < 8; ++i) raw[i] = *(const u32x4*)(P + (size_t)(r0 + wave + 8 * (hb * 8 + i)) * INC + 512 + lane * 8);
#pragma unroll
        for (int i = 0; i < 8; ++i) { const int q = wave + 8 * (hb * 8 + i);
            float x[8]; unpack8(raw[i], x);
            float s = 0.f;
#pragma unroll
            for (int j = 0; j < 8; ++j) { x[j] = gelu_tanh(x[j]); s += x[j]; }
            const float mean = wave_sum(s) * (1.f / 512.f); float qq = 0.f;
#pragma unroll
            for (int j = 0; j < 8; ++j) { const float d = x[j] - mean; qq += d * d; }
            const float rstd = __builtin_amdgcn_rsqf(wave_sum(qq) * (1.f / 512.f) + LN_EPS);
#pragma unroll
            for (int j = 0; j < 8; ++j) { const float v = (x[j] - mean) * rstd * gl[j] + bl[j]; vT[(lane * 8 + j) * LDT + (((q >> 3) ^ (lane & 15)) << 3) + (q & 7)] = (bf16r)f2bf(v); } }
      } }
    __syncthreads();
    const int p = 16 * wave + (lane & 15); const size_t row = (size_t)(r0 + p);
#pragma unroll 1
    for (int h = 0; h < 4; ++h) {
        bf16x8 bfr[4];
#pragma unroll
        for (int ks = 0; ks < 4; ++ks) { u32x4 t; t.x = pk2(wreg[2 * ks].x, wreg[2 * ks].y); t.y = pk2(wreg[2 * ks].z, wreg[2 * ks].w); t.z = pk2(wreg[2 * ks + 1].x, wreg[2 * ks + 1].y); t.w = pk2(wreg[2 * ks + 1].z, wreg[2 * ks + 1].w);
            bfr[ks] = __builtin_bit_cast(bf16x8, t); }
        if (h < 3) gmlp_ldw(Ws + (size_t)(h + 1) * 128 * 128, wave, lane, wreg);
        const float bsv = bs[h * 128 + p];
        u32x2 uw[8];
#pragma unroll
        for (int dt = 0; dt < 8; ++dt) uw[dt] = *(const u32x2*)(P + row * INC + h * 128 + 16 * dt + 4 * (lane >> 4));
#pragma unroll
        for (int dt = 0; dt < 8; ++dt) {
            pg8::f32x4 acc = {0.f, 0.f, 0.f, 0.f};
#pragma unroll
            for (int ks = 0; ks < 4; ++ks) { const int c = h * 128 + 16 * dt + (lane & 15); const bf16x8 af = *(const LAS bf16x8*)(vT + c * LDT + (((ks * 4 + (lane >> 4)) ^ ((c >> 3) & 15)) << 3));
                acc = __builtin_amdgcn_mfma_f32_16x16x32_bf16(af, bfr[ks], acc, 0, 0, 0); }
            const float u0 = gelu_tanh(bflo(uw[dt].x)), u1 = gelu_tanh(bfhi(uw[dt].x)), u2 = gelu_tanh(bflo(uw[dt].y)), u3 = gelu_tanh(bfhi(uw[dt].y));
            u32x2 o; o.x = pk2(u0 * (acc[0] + bsv), u1 * (acc[1] + bsv)); o.y = pk2(u2 * (acc[2] + bsv), u3 * (acc[3] + bsv));
            *(u32x2*)(MIX + row * DM + h * 128 + 16 * dt + 4 * (lane >> 4)) = o;
        }
    }
    __syncthreads();
}

__device__ __forceinline__ void conv_item(LAS unsigned char* lds, const bf16r* __restrict__ P, bf16r* __restrict__ MIX, const float* __restrict__ wdw  , const float* __restrict__ bdw,
                                          const float* __restrict__ lng, const float* __restrict__ lnb, int item, int tid, int wave, int lane) {
    LAS float* z = (LAS float*)lds;
    const int row0 = item * 32;
    const int seq0 = row0 < NLAT ? (row0 & ~4095) : (NLAT + ((row0 - NLAT) & ~255)), seq1 = seq0 + (row0 < NLAT ? SEQ : CTX);
    float acc[32]; float w[31];
    { const float bv = bdw[tid];
#pragma unroll
      for (int t = 0; t < 32; ++t) acc[t] = bv;
#pragma unroll
      for (int j = 0; j < 31; ++j) w[j] = wdw[j * 512 + tid]; }
    { u32x4 ra[8], rb[8];
#pragma unroll
      for (int i = 0; i < 8; ++i) { const int rr = wave + 8 * i; int g = row0 - 15 + rr; const bool ok = rr < 62 && g >= seq0 && g < seq1; if (!ok) g = row0;
          ra[i] = *(const u32x4*)(P + (size_t)g * INC + 1024 + lane * 8); rb[i] = *(const u32x4*)(P + (size_t)g * INC + 1536 + lane * 8); }
#pragma unroll
      for (int i = 0; i < 8; ++i) { const int rr = wave + 8 * i; const int g = row0 - 15 + rr; const bool ok = g >= seq0 && g < seq1;
          if (rr < 62) { float a[8], b[8], zv[8]; unpack8(ra[i], a); unpack8(rb[i], b);
#pragma unroll
              for (int j = 0; j < 8; ++j) zv[j] = ok ? a[j] * sigmoidf_(b[j]) : 0.f;
              *(LAS f32x4*)(z + rr * 512 + lane * 8) = (f32x4){zv[0], zv[1], zv[2], zv[3]}; *(LAS f32x4*)(z + rr * 512 + lane * 8 + 4) = (f32x4){zv[4], zv[5], zv[6], zv[7]}; } } }
    __syncthreads();
#pragma unroll
    for (int rr = 0; rr < 62; ++rr) { const float zv = z[rr * 512 + tid];
#pragma unroll
        for (int t = 0; t < 32; ++t) { if (rr - t >= 0 && rr - t <= 30) acc[t] += w[rr - t] * zv; } }
    __syncthreads();
#pragma unroll
    for (int t = 0; t < 32; ++t) z[t * 512 + tid] = acc[t];
    __syncthreads();
    float gl[8], bl[8];
#pragma unroll
    for (int j = 0; j < 8; ++j) { gl[j] = lng[lane * 8 + j]; bl[j] = lnb[lane * 8 + j]; }
#pragma unroll
    for (int i = 0; i < 4; ++i) { const int t = wave * 4 + i;
        const f32x4 y0 = *(const LAS f32x4*)(z + t * 512 + lane * 8), y1 = *(const LAS f32x4*)(z + t * 512 + lane * 8 + 4);
        float x[8] = {y0.x, y0.y, y0.z, y0.w, y1.x, y1.y, y1.z, y1.w};
        float s = 0.f;
#pragma unroll
        for (int j = 0; j < 8; ++j) s += x[j];
        const float mean = wave_sum(s) * (1.f / 512.f); float qq = 0.f;
#pragma unroll
        for (int j = 0; j < 8; ++j) { const float d = x[j] - mean; qq += d * d; }
        const float rstd = __builtin_amdgcn_rsqf(wave_sum(qq) * (1.f / 512.f) + LN_EPS);
        float o[8];
#pragma unroll
        for (int j = 0; j < 8; ++j) { const float v = (x[j] - mean) * rstd * gl[j] + bl[j]; o[j] = v * sigmoidf_(v); }
        *(u32x4*)(MIX + (size_t)(row0 + t) * DM + 512 + lane * 8) = pack8(o);
    }
    __syncthreads();
}

#define XB_TMO      128
#define XB_XCNT(j)  (256  + 64 * (j))
#define XB_XSUB(j)  (1280 + 64 * (j))
#define XB_XGEN(j)  (2304 + 64 * (j))
#define XB_TOP      3328
#define XB_TOPGEN   3392
#define XCD_BAR_WORDS 3456
#define XB_SPIN_CAP (1u << 18)

__device__ __forceinline__ unsigned xb_ld(unsigned* p)              { return __hip_atomic_load(p, __ATOMIC_RELAXED, __HIP_MEMORY_SCOPE_AGENT); }
__device__ __forceinline__ unsigned xb_add(unsigned* p, unsigned v) { return __hip_atomic_fetch_add(p, v, __ATOMIC_RELAXED, __HIP_MEMORY_SCOPE_AGENT); }
__device__ __forceinline__ unsigned xb_xcc_id() { return (unsigned)__builtin_amdgcn_s_getreg((3 << 11) | 20) & 0xFu; }
#define XB_SPIN(cond, bar) do { unsigned _sp = 0; while (cond) { __builtin_amdgcn_s_sleep(1); \
    if ((++_sp & 255u) == 0u) { if (xb_ld(&(bar)[XB_TMO])) break; if (_sp > XB_SPIN_CAP) { atomicAdd(&(bar)[XB_TMO], 1u); break; } } } } while (0)

struct XcdBarrier {
    unsigned* bar; unsigned x;
    volatile LAS unsigned* st;
};

__device__ __forceinline__ XcdBarrier xcd_barrier_post(unsigned* bar, volatile LAS unsigned* st) {
    XcdBarrier b; b.bar = bar; b.x = xb_xcc_id(); b.st = st;
    if (threadIdx.x == 0) (void)xb_add(&bar[XB_XCNT(b.x)], 1u);
    return b;
}
__device__ __forceinline__ void xcd_barrier_complete(unsigned* bar, unsigned x, unsigned& nloc, unsigned& nx) {
    const unsigned G = gridDim.x * gridDim.y * gridDim.z;
    unsigned sum, cnt, mine, sp = 0u;
    for (;;) {
        sum = 0u; cnt = 0u; mine = 0u;
#pragma unroll
        for (unsigned j = 0; j < 16; ++j) { const unsigned c = xb_ld(&bar[XB_XCNT(j)]); sum += c; cnt += (c > 0u) ? 1u : 0u; mine = (j == x) ? c : mine; }
        if (sum == G) break;
        __builtin_amdgcn_s_sleep(1);
        if ((++sp & 255u) == 0u) { if (xb_ld(&bar[XB_TMO])) break; if (sp > XB_SPIN_CAP) { atomicAdd(&bar[XB_TMO], 1u); break; } }
    }
    nloc = mine > 0u ? mine : 1u; nx = cnt > 0u ? cnt : 1u;
}

__device__ __forceinline__ void xcd_barrier(const XcdBarrier& b) {
    asm volatile("s_waitcnt vmcnt(0)" ::: "memory");
    __syncthreads();
    if (threadIdx.x == 0) {
        unsigned* bar = b.bar;
        __builtin_amdgcn_s_waitcnt(0);
        unsigned nloc = b.st[0], nx = b.st[1];
        if (nloc == 0u) { xcd_barrier_complete(bar, b.x, nloc, nx); b.st[0] = nloc; b.st[1] = nx; }
        const unsigned old = xb_add(&bar[XB_XSUB(b.x)], 1u);
        const unsigned gen = old / nloc;
        if (old + 1u == (gen + 1u) * nloc) {
            __builtin_amdgcn_fence(__ATOMIC_RELEASE, "agent");
            asm volatile("s_waitcnt vmcnt(0)" ::: "memory");
            const unsigned og = xb_add(&bar[XB_TOP], 1u);
            const unsigned tg = og / nx;
            if (og + 1u == (tg + 1u) * nx) xb_add(&bar[XB_TOPGEN], 1u);
            else XB_SPIN(xb_ld(&bar[XB_TOPGEN]) == tg, bar);
            __builtin_amdgcn_fence(__ATOMIC_ACQUIRE, "agent");
            xb_add(&bar[XB_XGEN(b.x)], 1u);
            asm volatile("s_waitcnt vmcnt(0)" ::: "memory");
        } else {
            XB_SPIN(xb_ld(&bar[XB_XGEN(b.x)]) == gen, bar);
            __builtin_amdgcn_fence(__ATOMIC_ACQUIRE, "agent");
            asm volatile("s_waitcnt vmcnt(0)" ::: "memory");
        }
    }
    __syncthreads();
}

#ifndef REP_P0
#define REP_P0 0
#endif
#ifndef REP_RP
#define REP_RP 0
#endif
#ifndef REP_ATTN
#define REP_ATTN 0
#endif
#ifndef REP_PREP
#define REP_PREP 0
#endif
#ifndef REP_QKV
#define REP_QKV 0
#endif
#ifndef REP_GMLP
#define REP_GMLP 0
#endif
#ifndef REP_CONV
#define REP_CONV 0
#endif
#ifndef REP_G1
#define REP_G1 0
#endif
#ifndef REP_G3
#define REP_G3 0
#endif
#ifndef REP_G4
#define REP_G4 0
#endif
#ifndef REP_G2
#define REP_G2 0
#endif
#ifndef ALIGN_RG
#define ALIGN_RG true
#endif
#ifndef FF2_KREV
#define FF2_KREV 1
#endif
#define REPEAT(n) for (int rep_ = 0; rep_ < 1 + (n); ++rep_)
struct Args { const float* in[24]; float* out; unsigned char* ws; int ph_lo, ph_hi; };
constexpr int N_PHASES = 2 + 8 * NLAYER;
struct Ctx {
    LAS unsigned char* lds; unsigned char* lds_raw; int tid, lane, wave, G, bx, vcu, gw, NGW, lo, hi;
    const float *w_in, *w_out, *w_ff1, *w_ff2;
    const float *x_in, *ctx_in, *a_ln_g, *a_ln_b, *a_ws, *a_bs, *b_dw, *b_dwb, *b_ln_g, *b_ln_b, *q_gain, *k_gain, *ln1_g, *ln1_b, *ln2_g, *ln2_b;
    float *rope, *MOD, *X, *out, *STAT, *PART; bf16r *Wt_in, *Wt_out, *Wt_ff1, *Wt_ff2, *H, *P, *Qb, *Kb, *Vb, *MIX, *ACT;
};
#define RUN (pid >= C.lo && pid < C.hi)
#define SEAM() do { if (pid >= C.lo && pid + 1 < C.hi) xcd_barrier(bar); ++pid; } while (0)

__device__ __forceinline__ void tail_transposes(const Ctx& C, int nwg, const float* Wa, int Ka, int Na, bf16r* Ta, const float* Wb2, int Kb, int Nb, bf16r* Tb) {
    const int first = nwg % C.G;
    if (C.bx < first) return;
    LAS float* scr = (LAS float*)(C.lds + C.wave * 16640);
    const int ia = (Ka / 64) * (Na / 64), ib = Wb2 ? (Kb / 64) * (Nb / 64) : 0, stride = (C.G - first) * 8;
    for (int it = (C.bx - first) * 8 + C.wave; it < ia + ib; it += stride) {
        if (it < ia) p0_transpose_item(Wa, Ka, Na, Ta, scr, it, C.lane); else p0_transpose_item(Wb2, Kb, Nb, Tb, scr, it - ia, C.lane);
    }
}

#ifndef STG_OUT
#define STG_OUT 0
#endif
#ifndef STG_FF2
#define STG_FF2 0
#endif
#ifndef STG_FF1
#define STG_FF1 0
#endif
#ifndef STG_IN
#define STG_IN 0
#endif
__device__ __forceinline__ void stagger(int k, unsigned ticks) {
    if (ticks == 0u) return;
    const unsigned long long t0 = __builtin_amdgcn_s_memrealtime(), w = (unsigned long long)k * ticks;
    while (__builtin_amdgcn_s_memrealtime() - t0 < w) __builtin_amdgcn_s_sleep(4);
}

template <int l> __device__ __forceinline__ void layer_body(const Ctx& C, int& pid, const XcdBarrier& bar) {
    constexpr bool last = (l == NLAYER - 1);
    constexpr int Mrows = last ? NLAT : NROW;
    const float* modl = C.MOD + (size_t)l * 5 * NMODC;
    float* Xc = C.X + (size_t)NLAT * DM;
    if (RUN) {
#if !defined(DIS_GEMM) && !defined(DIS_G1)
        stagger((C.bx >> 3) & 7, STG_IN);
        pg8::Gemm g{C.H, C.Wt_in + (size_t)l * INC * DM, Mrows, INC, DM, DM / 64}; pg8::OrderX S; S.init(Mrows, INC, C.G, C.bx, 64, last ? 4 : 0, 12, 2);
        pg8::EpiBf16<0> E{C.P, INC};
        REPEAT(REP_G1) pg8::gemm_phase<pg8::EpiBf16<0>, pg8::OrderX, true, true>(C.lds, g, S, E);
        if (l == 0) tail_transposes(C, (Mrows / 256) * (INC / 256), C.w_in + (size_t)DM * INC, DM, INC, C.Wt_in + (size_t)INC * DM, nullptr, 0, 0, nullptr);
        else tail_transposes(C, (Mrows / 256) * (INC / 256) + 8, C.w_out + (size_t)DM * DM, DM, DM, C.Wt_out + (size_t)DM * DM, C.w_ff1 + (size_t)DM * DFF, DM, DFF, C.Wt_ff1 + (size_t)DFF * DM);
#endif
    }
    SEAM();
    if (RUN) {
        REPEAT(REP_PREP) {
#ifndef DIS_PREP
        REPEAT(REP_QKV) prep_qkv(C.P, C.Qb, C.Kb, C.Vb, C.q_gain + l * 128, C.k_gain + l * 128, C.rope, NROW, !last, C.gw, C.NGW, C.lane);
#endif
#ifndef DIS_GMLP
        constexpr int nch = Mrows / 128;
        REPEAT(REP_GMLP) for (int it = C.vcu; it < nch; it += C.G) gmlp_item(C.lds, C.P, C.MIX, C.a_ln_g + l * 512, C.a_ln_b + l * 512, C.a_ws + (size_t)l * 4 * 128 * 128, C.a_bs + l * 512, it, C.tid, C.wave, C.lane);
#endif
#ifndef DIS_CONV
        {
            constexpr int nconv = Mrows / 32, ngm = Mrows / 128;
            const bool split = C.G > ngm && ngm <= nconv;
            const int c0 = split ? (C.vcu < ngm ? C.vcu : ngm + (C.vcu - ngm)) : C.vcu;
            const int cs = split ? (C.vcu < ngm ? nconv : C.G - ngm) : C.G;
            REPEAT(REP_CONV) for (int it = c0; it < nconv; it += cs) conv_item(C.lds, C.P, C.MIX, C.b_dw + (size_t)l * 31 * 512, C.b_dwb + l * 512, C.b_ln_g + l * 512, C.b_ln_b + l * 512, it, C.tid, C.wave, C.lane);
        }
#endif
        }
    }
    SEAM();
    if (RUN) {
        constexpr int nunits = 512 + (last ? 0 : 32);
        REPEAT(REP_ATTN) for (int u = C.vcu; u < nunits; u += C.G) {
            int b, h, row0, seq;
            if (u < 512) { b = u >> 7; h = (u >> 4) & 7; row0 = b * SEQ + (u & 15) * 256; seq = KVLEN; }
            else { const int u2 = u - 512; b = u2 >> 3; h = u2 & 7; row0 = NLAT + b * CTX; seq = CTX; }
            const size_t kvoff = (size_t)(b * 2 + (h >> 2)) * KVLEN * 128;
#ifndef DIS_ATTN
            attn::attn_dense_body(C.P + (size_t)row0 * INC + 2048 + h * 128, C.q_gain + l * 128, C.rope, u < 512 ? (row0 & 4095) : -1, (const attn::bf16*)(C.Kb + kvoff), (const attn::bf16*)(C.Vb + kvoff),
                                  C.MIX + (size_t)row0 * DM + 1024 + h * 128, seq, (char*)C.lds_raw);
#endif
            __syncthreads();
        }
    }
    SEAM();
    if (RUN) {
#if !defined(DIS_GEMM) && !defined(DIS_G2)
        stagger((C.bx >> 3) & 7, STG_OUT);
        pg8::Gemm g{C.MIX, C.Wt_out + (size_t)l * DM * DM, NLAT, DM, DM, DM / 64}; pg8::OrderX S; S.init(NLAT, DM, C.G, C.bx, 0, 0, 0, 0);
        pg8::EpiBf16<0> E{C.H, DM};
        pg8::gemm_phase<pg8::EpiBf16<0>, pg8::OrderX, true, true>(C.lds, g, S, E);
        if (!last) {
            pg8::Gemm g2{C.MIX, C.Wt_out + (size_t)l * DM * DM, NROW, DM, DM, 4}; pg8::OrderSplit S2; S2.init(C.G, C.bx, 8, 4);
            pg8::EpiPart E2{C.PART, 4 * 128};
            pg8::gemm_phase<pg8::EpiPart, pg8::OrderSplit, true, true>(C.lds, g2, S2, E2);
        }
#endif
    }
    SEAM();
    if (RUN) {
        bf16r* XS = (bf16r*)C.X;
        if (l == 0) row_pass_res<true, false>(C.lds, C.x_in, nullptr, C.H, NLAT, modl, 2 * DM, C.ln1_g + l * DM, C.ln1_b + l * DM, XS, nullptr, modl, 3 * DM, 4 * DM, C.H, C.gw, C.NGW, C.lane);
        else row_pass_res<false, false>(C.lds, nullptr, XS, C.H, NLAT, modl, 2 * DM, C.ln1_g + l * DM, C.ln1_b + l * DM, XS, nullptr, modl, 3 * DM, 4 * DM, C.H, C.gw, C.NGW, C.lane);
        if (!last) row_pass_ctx_res<true>(C.ctx_in, XS, C.PART, modl + 4 * (size_t)NMODC + 2 * DM, C.ln1_g + l * DM, C.ln1_b + l * DM, true, modl, 3 * DM, 4 * DM, C.H, C.gw, C.NGW, C.lane);
    }
    SEAM();
    if (RUN) {
#if !defined(DIS_GEMM) && !defined(DIS_G3)
        stagger((C.bx >> 3) & 7, STG_FF1);
        pg8::Gemm g{C.H, C.Wt_ff1 + (size_t)l * DFF * DM, Mrows, DFF, DM, DM / 64}; pg8::OrderX S; S.init(Mrows, DFF, C.G, C.bx, 0, 0, 0, 0);
        pg8::EpiBf16<2> E{C.ACT, DFF};
        pg8::gemm_phase<pg8::EpiBf16<2>, pg8::OrderX, true, true>(C.lds, g, S, E);
        if (REP_G3) { pg8::gemm_phase<pg8::EpiBf16<2>, pg8::OrderX, true, true>(C.lds, g, S, E); }
        if (l == 0) tail_transposes(C, (Mrows / 256) * (DFF / 256), C.w_ff2 + (size_t)DFF * DM, DFF, DM, C.Wt_ff2 + (size_t)DM * DFF, nullptr, 0, 0, nullptr);
#endif
    }
    SEAM();
    if (RUN) {
#if !defined(DIS_GEMM) && !defined(DIS_G4)
        stagger((C.bx >> 3) & 7, STG_FF2);
        pg8::Gemm g{C.ACT, C.Wt_ff2 + (size_t)l * DM * DFF, NLAT, DM, DFF, DFF / 64, FF2_KREV  }; pg8::OrderX S; S.init(NLAT, DM, C.G, C.bx, 0, 0, 0, 0);
        pg8::EpiBf16<0> E{C.H, DM};
        pg8::gemm_phase<pg8::EpiBf16<0>, pg8::OrderX, true, true>(C.lds, g, S, E);
        if (!last) {
            pg8::Gemm g2{C.ACT, C.Wt_ff2 + (size_t)l * DM * DFF, NROW, DM, DFF, 16}; pg8::OrderSplit S2; S2.init(C.G, C.bx, 8, 16);
            pg8::EpiPart E2{C.PART, 16 * 128};
            pg8::gemm_phase<pg8::EpiPart, pg8::OrderSplit, true, true>(C.lds, g2, S2, E2);
        }
#endif
    }
    SEAM();
    if (RUN) {
        bf16r* XS = (bf16r*)C.X;
        if (last) row_pass_res<false, true>(C.lds, nullptr, XS, C.H, NLAT, modl, 5 * DM, C.ln2_g + l * DM, C.ln2_b + l * DM, nullptr, C.out, nullptr, 0, 0, nullptr, C.gw, C.NGW, C.lane);
        else {
            row_pass_res<false, false>(C.lds, nullptr, XS, C.H, NLAT, modl, 5 * DM, C.ln2_g + l * DM, C.ln2_b + l * DM, XS, nullptr, modl + 5 * NMODC, 0 * DM, 1 * DM, C.H, C.gw, C.NGW, C.lane);
            row_pass_ctx_res<false>(nullptr, XS, C.PART, modl + 4 * (size_t)NMODC + 5 * DM, C.ln2_g + l * DM, C.ln2_b + l * DM, false, modl + 5 * NMODC, 0 * DM, 1 * DM, C.H, C.gw, C.NGW, C.lane);
        }
    }
    SEAM();
}

__global__ void __launch_bounds__(512, 2) fwd_megakernel(Args args) {
    extern __shared__ __attribute__((aligned(16))) unsigned char lds_raw[];
    cg::grid_group grid = cg::this_grid();
    Ctx C;
    C.lds = (LAS unsigned char*)lds_raw; C.lds_raw = lds_raw;
    C.tid = threadIdx.x; C.lane = C.tid & 63; C.wave = __builtin_amdgcn_readfirstlane(C.tid >> 6);
    C.G = gridDim.x; C.bx = blockIdx.x; C.vcu = (C.G % 8 == 0) ? (C.bx % 8) * (C.G / 8) + C.bx / 8 : C.bx;
    C.gw = C.vcu * 8 + C.wave; C.NGW = C.G * 8; C.lo = args.ph_lo; C.hi = args.ph_hi;
    unsigned char* ws = args.ws;
    C.x_in = args.in[0]; C.ctx_in = args.in[2]; C.w_in = args.in[6]; C.w_out = args.in[17]; C.w_ff1 = args.in[20]; C.w_ff2 = args.in[21];
    C.a_ln_g = args.in[7]; C.a_ln_b = args.in[8]; C.a_ws = args.in[9]; C.a_bs = args.in[10];
    C.b_dw = args.in[11]; C.b_dwb = args.in[12]; C.b_ln_g = args.in[13]; C.b_ln_b = args.in[14];
    C.q_gain = args.in[15]; C.k_gain = args.in[16]; C.ln1_g = args.in[18]; C.ln1_b = args.in[19]; C.ln2_g = args.in[22]; C.ln2_b = args.in[23];
    C.STAT = (float*)(ws + WS_STAT); C.PART = (float*)(ws + WS_PART); C.rope = (float*)(ws + WS_ROPE); C.MOD = (float*)(ws + WS_MOD); C.X = (float*)(ws + WS_X); C.out = args.out;
    C.Wt_in = (bf16r*)(ws + WS_WIN); C.Wt_out = (bf16r*)(ws + WS_WOUT); C.Wt_ff1 = (bf16r*)(ws + WS_WFF1); C.Wt_ff2 = (bf16r*)(ws + WS_WFF2);
    C.H = (bf16r*)(ws + WS_H); C.P = (bf16r*)(ws + WS_P); C.Qb = (bf16r*)(ws + WS_Q);
    C.Kb = (bf16r*)(ws + WS_K); C.Vb = (bf16r*)(ws + WS_V); C.MIX = (bf16r*)(ws + WS_MIX); C.ACT = (bf16r*)(ws + WS_ACT);
    int pid = 0;
    volatile LAS unsigned* bst = (volatile LAS unsigned*)(C.lds + LDS_BYTES - 64);
    if (C.tid < 2) bst[C.tid] = 0u;
    __syncthreads();
    const XcdBarrier bar = xcd_barrier_post((unsigned*)(ws + WS_BAR), bst);
    if (C.hi < 0) grid.sync();

    if (RUN) REPEAT(REP_P0) {
        const float* c_in = args.in[1]; const float* cctx_in = args.in[3]; const float* w_mod = args.in[4]; const float* b_mod = args.in[5];
        const float* w_in = args.in[6]; const float* w_out = args.in[17]; const float* w_ff1 = args.in[20]; const float* w_ff2 = args.in[21];
        p0_rope(C.rope, C.bx * 512 + C.tid, C.G * 512);
        p0_mod(C.lds, c_in, cctx_in, w_mod, b_mod, C.MOD, 0, NLAYER * (NMODC / 128), C.bx, C.G, C.tid);
        __syncthreads();
        LAS float* scr = (LAS float*)(C.lds + C.wave * 16640);
        constexpr int I_IN = (DM / 64) * (INC / 64), I_OUT = (DM / 64) * (DM / 64), I_F1 = (DM / 64) * (DFF / 64), I_F2 = (DFF / 64) * (DM / 64), I_L = I_IN + I_OUT + I_F1 + I_F2;
        constexpr int NMODI = NLAYER * (NMODC / 128), P0_EXTRA = 6;
        const int nfree = C.G > NMODI ? C.G - NMODI : 0;
        const int n1 = nfree * 8 * P0_EXTRA < I_L ? nfree * 8 * P0_EXTRA : I_L;
#pragma unroll 1
        for (int ph = 0; ph < 2; ++ph) {
            int it, stride, end;
            if (ph == 0) { end = n1; stride = nfree > 0 ? nfree * 8 : 1; it = (C.bx >= NMODI) ? (C.bx - NMODI) * 8 + C.wave : end; }
            else { it = n1 + C.gw; stride = C.NGW; end = I_L; }
            for (; it < end; it += stride) {
                int r = it;
                if (r < I_IN) { p0_transpose_item(w_in, DM, INC, C.Wt_in, scr, r, C.lane); continue; } r -= I_IN;
                if (r < I_OUT) { p0_transpose_item(w_out, DM, DM, C.Wt_out, scr, r, C.lane); continue; } r -= I_OUT;
                if (r < I_F1) { p0_transpose_item(w_ff1, DM, DFF, C.Wt_ff1, scr, r, C.lane); continue; } r -= I_F1;
                p0_transpose_item(w_ff2, DFF, DM, C.Wt_ff2, scr, r, C.lane);
            }
        }
        if (REP_P0) __syncthreads();
    }
    SEAM();
    if (RUN) row_pass0(C.lds, C.x_in, C.ctx_in, C.MOD, C.H, C.gw, C.NGW, C.lane);
    SEAM();
    layer_body<0>(C, pid, bar);
    layer_body<1>(C, pid, bar);
#ifdef EXTRA_SYNCS
    if (C.hi - C.lo > 1) { for (int i = 0; i < EXTRA_SYNCS; ++i) {
#ifdef EXTRA_DIRTY
        { f32x4* sp = (f32x4*)(ws + WS_PART) + (size_t)C.bx * 512 * EXTRA_DIRTY + C.tid;
          for (int k = 0; k < EXTRA_DIRTY; ++k) sp[k * 512] = (f32x4){(float)i, 1.f, 2.f, 3.f}; }
#endif
        xcd_barrier(bar); } }
#endif
}
#undef RUN
#undef SEAM

#ifndef MK_PER_PHASE
#define MK_PER_PHASE 0
#endif
extern "C" void kernel_launch(void* const* d_in, const int* in_sizes, int n_in, void* d_out, int out_size, void* d_ws, size_t ws_size, hipStream_t stream) {
    static int grid = 0;
    if (grid == 0) {
        if (n_in != 24 || out_size != NLAT * DM || ws_size < WS_END) { fprintf(stderr, "kernel_launch: unexpected shapes (n_in %d out %d ws %zu, need ws >= %zu)\n", n_in, out_size, ws_size, (size_t)WS_END); grid = -1; return; }
        int dev = 0, cus = 0, per_cu = 0;
        (void)hipGetDevice(&dev); (void)hipDeviceGetAttribute(&cus, hipDeviceAttributeMultiprocessorCount, dev);
        if (hipFuncSetAttribute((const void*)fwd_megakernel, hipFuncAttributeMaxDynamicSharedMemorySize, LDS_BYTES) != hipSuccess) { fprintf(stderr, "kernel_launch: hipFuncSetAttribute failed\n"); grid = -1; return; }
        if (hipOccupancyMaxActiveBlocksPerMultiprocessor(&per_cu, (const void*)fwd_megakernel, 512, LDS_BYTES) != hipSuccess || per_cu < 1) { fprintf(stderr, "kernel_launch: occupancy query says %d\n", per_cu); per_cu = 1; }
        (void)hipGetLastError();
        grid = cus;
    }
    if (grid < 0) return;
#ifndef PROBE_TWICE
#define PROBE_TWICE 0
#endif
    for (int rep_launch = 0; rep_launch <= PROBE_TWICE; ++rep_launch) {
    if (hipMemsetAsync((char*)d_ws + WS_BAR, 0, WS_BAR_BYTES, stream) != hipSuccess) { fprintf(stderr, "kernel_launch: memset failed\n"); return; }
    Args a{};
    for (int i = 0; i < 24; ++i) a.in[i] = (const float*)d_in[i];
    a.out = (float*)d_out; a.ws = (unsigned char*)d_ws;
#if MK_PER_PHASE
    for (int p = 0; p < N_PHASES; ++p) { a.ph_lo = p; a.ph_hi = p + 1; hipLaunchKernelGGL(fwd_megakernel, dim3(grid), dim3(512), LDS_BYTES, stream, a); }
#else
    a.ph_lo = 0; a.ph_hi = N_PHASES;
    void* kargs[] = {&a};
    hipError_t e = hipLaunchCooperativeKernel((const void*)fwd_megakernel, dim3(grid), dim3(512), kargs, LDS_BYTES, stream);
    if (e != hipSuccess) fprintf(stderr, "kernel_launch: cooperative launch failed: %s (grid %d)\n", hipGetErrorString(e), grid);
#endif
    }
}
```

```cpp
#include <hip/hip_runtime.h>
#include <hip/hip_cooperative_groups.h>
#include <hip/hip_bf16.h>
#include <cstdio>
#include <cstdint>
namespace cg = cooperative_groups;
namespace pg8 {
#define PG8_LAS __attribute__((address_space(3)))
typedef unsigned short bf16_t;
typedef short bf16x8 __attribute__((ext_vector_type(8)));
typedef float f32x4 __attribute__((ext_vector_type(4)));
typedef unsigned u32x4 __attribute__((ext_vector_type(4)));
constexpr int BM = 256, BK = 64, HALF = 128, HTB = HALF * BK * 2  , STAGE_BYTES = 8 * HTB, NXCD = 8, WGM = 8;

__host__ __device__ __forceinline__ int lds_byte(int r, int c) { const int st = (r >> 4) * 2 + (c >> 5), rr = r & 15, cc = c & 31, ob = rr * 64 + cc * 2; return st * 1024 + (ob ^ (((ob >> 9) & 1) << 5)); }
__host__ __device__ __forceinline__ void stage_rc(int b, int& R, int& C) { const int st = b / 1024, sb = b % 1024, swz = sb ^ (((sb >> 9) & 1) << 5); R = (st >> 1) * 16 + swz / 64; C = (st & 1) * 32 + (swz % 64) / 2; }
__host__ __device__ __forceinline__ int perm32(int rho) { const int n = rho >> 4, i = rho & 15; return 8 * (i >> 2) + 4 * n + (i & 3); }

struct Unit { int pm, pn, ko; };
struct Gemm { const bf16_t* A; const bf16_t* Bt; int M, N, K, nt, krev; };

struct StaticOrder {
    int nM, nN, nwg, G, c;
    __host__ __device__ void init(int M, int N, int G_, int c_) { nM = M / BM; nN = N / BM; nwg = nM * nN; G = G_; c = c_; }
    __host__ __device__ bool next(int i, Unit& u) const {
        const long L = (long)i * G + c; if (L >= nwg) return false;
        int wgid = (int)L; { const int q = nwg / NXCD, r = nwg % NXCD, xcd = wgid % NXCD, off = wgid / NXCD; wgid = (xcd < r ? xcd * (q + 1) : r * (q + 1) + (xcd - r) * q) + off; }
        const int nig = WGM * nN, gid = wgid / nig, fm = gid * WGM, gsz = (nM - fm) < WGM ? (nM - fm) : WGM;
        u.pm = fm + ((wgid % nig) % gsz); u.pn = (wgid % nig) / gsz; u.ko = 0; return true;
    }
    __device__ __forceinline__ void a_ready(const Unit&) const {}
    __device__ __forceinline__ void done(const Unit&) const {}
};

__device__ __forceinline__ unsigned cvt_pk_bf16(float lo, float hi) { unsigned r; asm volatile("v_cvt_pk_bf16_f32 %0, %1, %2" : "=v"(r) : "v"(lo), "v"(hi)); return r; }
typedef float f32x2 __attribute__((ext_vector_type(2)));
#ifndef WT_STORES
#define WT_STORES 0
#endif
__device__ __forceinline__ void st16_wt(void* p, u32x4 v) {
#if WT_STORES
    asm volatile("global_store_dwordx4 %0, %1, off sc1\n\ts_nop 1" :: "v"(p), "v"(v) : "memory");
#else
    *(u32x4*)p = v;
#endif
}
template <int ACT  > struct EpiBf16 {
    static constexpr bool PERM = true, AFTER_DRAIN = false;
    bf16_t* O; int ldc;
    __device__ __forceinline__ void operator()(const f32x4 (&acc)[2][2][4][2], const Unit& u, int wr, int wc, int fr, int fq) const {
        const int row0 = u.pm * BM + wr * 64 + fr; const int col0 = u.pn * BM + wc * 32 + 8 * fq;
#pragma unroll
        for (int ai = 0; ai < 2; ++ai)
#pragma unroll
            for (int m = 0; m < 4; ++m) { bf16_t* rowp = O + (size_t)(row0 + ai * HALF + m * 16) * ldc + col0;
#pragma unroll
                for (int bj = 0; bj < 2; ++bj) { f32x4 v0 = acc[ai][bj][m][0], v1 = acc[ai][bj][m][1];
                    if (ACT == 2) {
#pragma unroll
                        for (int e = 0; e < 4; ++e) { float a = fmaxf(v0[e], 0.f), b = fmaxf(v1[e], 0.f); v0[e] = a * a; v1[e] = b * b; } }
                    u32x4 w; w.x = cvt_pk_bf16(v0[0], v0[1]); w.y = cvt_pk_bf16(v0[2], v0[3]); w.z = cvt_pk_bf16(v1[0], v1[1]); w.w = cvt_pk_bf16(v1[2], v1[3]);
                    st16_wt(rowp + bj * HALF, w); } }
    }
};
template <bool NORM> struct EpiResGate {
    static constexpr bool PERM = false, AFTER_DRAIN = false;
    const float* res_lat; const float* res_ctx; float* out; const float* gate; float alpha; const float* stat; const float* lg; const float* lb;
    __device__ __forceinline__ void operator()(const f32x4 (&acc)[2][2][4][2], const Unit& u, int wr, int wc, int fr, int fq) const {
        typedef float f32x2v __attribute__((ext_vector_type(2)));
        const int mrow = u.pm < 64 ? (u.pm >> 4) : 4;
        const float* g = gate + (size_t)mrow * 12288;
        const int col0 = u.pn * BM + wc * 32 + 4 * fq;
        f32x4 gv[2][2], gg[2][2], bb[2][2];
#pragma unroll
        for (int bj = 0; bj < 2; ++bj)
#pragma unroll
            for (int n = 0; n < 2; ++n) { gv[bj][n] = *(const f32x4*)(g + col0 + bj * HALF + n * 16);
                if (NORM) { gg[bj][n] = *(const f32x4*)(lg + col0 + bj * HALF + n * 16); bb[bj][n] = *(const f32x4*)(lb + col0 + bj * HALF + n * 16); } }
#pragma unroll
        for (int ai = 0; ai < 2; ++ai)
#pragma unroll
            for (int mp = 0; mp < 2; ++mp) {
                f32x4 r[2][2][2]; f32x2v st[2];
#pragma unroll
                for (int mm = 0; mm < 2; ++mm) { const int row = u.pm * BM + ai * HALF + wr * 64 + (mp * 2 + mm) * 16 + fr;
                    const float* rp = (row < 16384) ? res_lat + (size_t)row * 2048 : res_ctx + (size_t)(row - 16384) * 2048;
                    st[mm] = (f32x2v){0.f, 1.f}; if (NORM) st[mm] = *(const f32x2v*)(stat + 2 * (size_t)row);
#pragma unroll
                    for (int bj = 0; bj < 2; ++bj)
#pragma unroll
                        for (int n = 0; n < 2; ++n) r[mm][bj][n] = *(const f32x4*)(rp + col0 + bj * HALF + n * 16); }
#pragma unroll
                for (int mm = 0; mm < 2; ++mm) { const int m = mp * 2 + mm; const int row = u.pm * BM + ai * HALF + wr * 64 + m * 16 + fr;
                    float* op = out + (size_t)row * 2048;
#pragma unroll
                    for (int bj = 0; bj < 2; ++bj)
#pragma unroll
                        for (int n = 0; n < 2; ++n) { f32x4 x = r[mm][bj][n];
                            if (NORM) x = (x - st[mm].x) * st[mm].y * gg[bj][n] + bb[bj][n];
                            const f32x4 o = x * alpha + gv[bj][n] * acc[ai][bj][m][n]; st16_wt(op + col0 + bj * HALF + n * 16, __builtin_bit_cast(u32x4, o)); } }
                asm volatile("" ::: "memory");
            }
    }
};
template <int MODE> struct EpiProbe {
    static constexpr bool PERM = false, AFTER_DRAIN = false;
    const float* res; float* out;
    __device__ __forceinline__ void operator()(const f32x4 (&acc)[2][2][4][2], const Unit& u, int wr, int wc, int fr, int fq) const {
        const int col0 = u.pn * BM + wc * 32 + 4 * fq; f32x4 s = {0.f, 0.f, 0.f, 0.f};
#pragma unroll
        for (int ai = 0; ai < 2; ++ai)
#pragma unroll
            for (int m = 0; m < 4; ++m) { const int row = u.pm * BM + ai * HALF + wr * 64 + m * 16 + fr;
#pragma unroll
                for (int bj = 0; bj < 2; ++bj)
#pragma unroll
                    for (int n = 0; n < 2; ++n) { const int c = col0 + bj * HALF + n * 16;
                        if (MODE == 1) *(f32x4*)(out + (size_t)row * 2048 + c) = acc[ai][bj][m][n];
                        else s += *(const f32x4*)(res + (size_t)row * 2048 + c) * acc[ai][bj][m][n]; } }
        if (MODE == 2) *(f32x4*)(out + (size_t)(u.pm * BM + wr * 64 + fr) * 2048 + col0) = s;
    }
};
struct OrderX {
    StaticOrder base; int xm0, xnm, xn0, xnn;
    __device__ void init(int M, int N, int G_, int c_, int xm0_, int xnm_, int xn0_, int xnn_) { base.init(M, N, G_, c_); xm0 = xm0_; xnm = xnm_; xn0 = xn0_; xnn = xnn_; }
    __device__ bool next(int i, Unit& u) const {
        long L = (long)i * base.G + base.c; if (L < base.nwg) return base.next(i, u);
        L -= base.nwg; if (L >= (long)xnm * xnn) return false;
        u.pm = xm0 + (int)(L % xnm); u.pn = xn0 + (int)(L / xnm); u.ko = 0; return true;
    }
    __device__ __forceinline__ void a_ready(const Unit&) const {}
    __device__ __forceinline__ void done(const Unit&) const {}
};
struct OrderSplit {
    int G, c, nsub, kbytes;
    __device__ void init(int G_, int c_, int ns, int nt) { G = G_; c = c_; nsub = 32 * ns; kbytes = nt * 128; }
    __device__ bool next(int i, Unit& u) const { const long L = (long)i * G + c; if (L >= nsub) return false; const int idx = (int)L; u.pm = 64 + (idx & 3); u.pn = (idx >> 2) & 7; u.ko = (idx >> 5) * kbytes; return true; }
    __device__ __forceinline__ void a_ready(const Unit&) const {}
    __device__ __forceinline__ void done(const Unit&) const {}
};
struct EpiPart {
    static constexpr bool PERM = false, AFTER_DRAIN = false;
    float* part; int kbytes;
    __device__ __forceinline__ void operator()(const f32x4 (&acc)[2][2][4][2], const Unit& u, int wr, int wc, int fr, int fq) const {
        const int ks = u.ko / kbytes; const int col0 = u.pn * BM + wc * 32 + 4 * fq;
        float* base = part + ((size_t)ks * 1024 + (size_t)(u.pm - 64) * BM) * 2048;
#pragma unroll
        for (int ai = 0; ai < 2; ++ai)
#pragma unroll
            for (int m = 0; m < 4; ++m) { float* op = base + (size_t)(ai * HALF + wr * 64 + m * 16 + fr) * 2048;
#pragma unroll
                for (int bj = 0; bj < 2; ++bj)
#pragma unroll
                    for (int n = 0; n < 2; ++n) st16_wt(op + col0 + bj * HALF + n * 16, __builtin_bit_cast(u32x4, acc[ai][bj][m][n])); }
    }
};
template <class Epi, class Sched, bool ALIGN_EPI = false, bool SP2 = false>
__device__ __forceinline__ void gemm_phase(PG8_LAS unsigned char* lds, const Gemm g, const Sched& S, const Epi& E) {
    const int tid = threadIdx.x, wid = __builtin_amdgcn_readfirstlane(tid >> 6), lane = tid & 63, wr = wid >> 2, wc = wid & 3, fr = lane & 15, fq = lane >> 4;
    const int K = g.K, nt = g.nt;
    unsigned voffA[2], voffB[2];
#pragma unroll
    for (int i = 0; i < 2; ++i) { int R, C; stage_rc(tid * 16 + i * 8192, R, C); const int Rb = Epi::PERM ? ((R & ~31) + perm32(R & 31)) : R;
        voffA[i] = (unsigned)(R * K + C) * 2u; voffB[i] = (unsigned)(Rb * K + C) * 2u; }
    const ptrdiff_t kstep = g.krev ? -(ptrdiff_t)(BK * 2) : (ptrdiff_t)(BK * 2);
    const size_t krev0 = g.krev ? (size_t)(nt - 1) * (BK * 2) : 0;
    const size_t hstep = (size_t)HALF * K * 2;
    const size_t tstep = 2 * hstep;
    const unsigned ldsw = (unsigned)wid * 1024u;
    const int aoff = lds_byte(wr * 64 + fr, fq * 8), boff = lds_byte(wc * 32 + fr, fq * 8);
#define PG8_SA(b, h) (((b) * 2 + (h)) * HTB)
#define PG8_SB(b, h) ((4 + (b) * 2 + (h)) * HTB)
#define PG8_STAGE(bufoff, gbase, voff) do { _Pragma("unroll") for (int _i = 0; _i < 2; ++_i) \
        __builtin_amdgcn_global_load_lds((const unsigned*)((const char*)(gbase) + (voff)[_i]), (PG8_LAS unsigned*)(lds + (bufoff) + ldsw + _i * 8192), 16, 0, 0); } while (0)
#define PG8_LDA(dst, b, h) do { _Pragma("unroll") for (int m = 0; m < 4; ++m) _Pragma("unroll") for (int k = 0; k < 2; ++k) dst[m][k] = *(const PG8_LAS bf16x8*)(lds + PG8_SA(b, h) + aoff + m * 2048 + k * 1024); } while (0)
#define PG8_LDB(dst, b, h) do { _Pragma("unroll") for (int n = 0; n < 2; ++n) _Pragma("unroll") for (int k = 0; k < 2; ++k) dst[n][k] = *(const PG8_LAS bf16x8*)(lds + PG8_SB(b, h) + boff + n * 2048 + k * 1024); } while (0)
#define PG8_MMA(ai, bj, At, Bt) do { __builtin_amdgcn_s_setprio(1); _Pragma("unroll") for (int m = 0; m < 4; ++m) _Pragma("unroll") for (int n = 0; n < 2; ++n) _Pragma("unroll") for (int k = 0; k < 2; ++k) \
        acc[ai][bj][m][n] = __builtin_amdgcn_mfma_f32_16x16x32_bf16(Bt[n][k], At[m][k], acc[ai][bj][m][n], 0, 0, 0); __builtin_amdgcn_s_setprio(0); } while (0)
#define PG8_WAIT_V(n) asm volatile("s_waitcnt vmcnt(" #n ")" ::: "memory")
#define PG8_WAIT_L(n) asm volatile("s_waitcnt lgkmcnt(" #n ")" ::: "memory")
#define PG8_BAR __builtin_amdgcn_s_barrier()
#define PG8_SCHED __builtin_amdgcn_sched_barrier(0)
    Unit cur, nxt; int ui = 0;
    if (!S.next(0, cur)) return;
    f32x4 acc[2][2][4][2];
#pragma unroll
    for (int a = 0; a < 2; ++a)
#pragma unroll
        for (int b = 0; b < 2; ++b)
#pragma unroll
            for (int m = 0; m < 4; ++m)
#pragma unroll
                for (int n = 0; n < 2; ++n) acc[a][b][m][n] = (f32x4){0.f, 0.f, 0.f, 0.f};
    bf16x8 At[4][2], B0[2][2], B1[2][2];
    const char* cA = (const char*)g.A + (size_t)cur.pm * tstep + cur.ko + krev0; const char* cB = (const char*)g.Bt + (size_t)cur.pn * tstep + cur.ko + krev0;
    S.a_ready(cur);
    if constexpr (SP2) {
        PG8_STAGE(PG8_SB(0, 0), cB, voffB); PG8_STAGE(PG8_SB(0, 1), cB + hstep, voffB); PG8_STAGE(PG8_SA(0, 0), cA, voffA); PG8_STAGE(PG8_SA(0, 1), cA + hstep, voffA);
        if (wr == 1) PG8_BAR;
        PG8_WAIT_V(2); PG8_BAR;
        PG8_STAGE(PG8_SB(1, 0), cB + kstep, voffB); PG8_STAGE(PG8_SA(1, 0), cA + kstep, voffA); PG8_STAGE(PG8_SB(1, 1), cB + hstep + kstep, voffB);
        PG8_WAIT_V(6); PG8_BAR;
    } else {
        PG8_STAGE(PG8_SB(0, 0), cB, voffB); PG8_STAGE(PG8_SA(0, 0), cA, voffA); PG8_STAGE(PG8_SB(0, 1), cB + hstep, voffB); PG8_STAGE(PG8_SA(0, 1), cA + hstep, voffA);
        if (wr == 1) PG8_BAR;
        PG8_WAIT_V(4); PG8_BAR;
        PG8_STAGE(PG8_SB(1, 0), cB + kstep, voffB); PG8_STAGE(PG8_SA(1, 0), cA + kstep, voffA); PG8_STAGE(PG8_SB(1, 1), cB + hstep + kstep, voffB);
        PG8_WAIT_V(6); PG8_BAR;
    }
    for (;;) {
        const bool has_next = S.next(ui + 1, nxt);
        const char* nA = has_next ? (const char*)g.A + (size_t)nxt.pm * tstep + nxt.ko + krev0 : cA; const char* nB = has_next ? (const char*)g.Bt + (size_t)nxt.pn * tstep + nxt.ko + krev0 : cB;
        for (int t = 0; t < nt; t += 2) {
            const bool last = (t == nt - 2);
            const char* a1 = cA + (ptrdiff_t)(t + 1) * kstep;
            const char* a2 = last ? nA : cA + (ptrdiff_t)(t + 2) * kstep; const char* b2 = last ? nB : cB + (ptrdiff_t)(t + 2) * kstep;
            const char* a3 = a2 + kstep; const char* b3 = b2 + kstep;
            if (last && has_next) S.a_ready(nxt);
            if constexpr (SP2) {
            PG8_LDB(B0, 0, 0); PG8_LDB(B1, 0, 1); PG8_SCHED; PG8_LDA(At, 0, 0); PG8_STAGE(PG8_SA(1, 1), a1 + hstep, voffA);
            PG8_WAIT_V(8); PG8_WAIT_L(0); PG8_BAR; PG8_MMA(0, 0, At, B0); PG8_MMA(0, 1, At, B1); PG8_BAR; PG8_SCHED;
            PG8_LDA(At, 0, 1); PG8_STAGE(PG8_SB(0, 0), b2, voffB); PG8_STAGE(PG8_SB(0, 1), b2 + hstep, voffB); PG8_STAGE(PG8_SA(0, 0), a2, voffA);
            PG8_WAIT_V(8); PG8_WAIT_L(0); PG8_BAR; PG8_MMA(1, 0, At, B0); PG8_MMA(1, 1, At, B1); PG8_BAR; PG8_SCHED;
            PG8_LDB(B0, 1, 0); PG8_LDB(B1, 1, 1); PG8_SCHED; PG8_LDA(At, 1, 0); PG8_STAGE(PG8_SA(0, 1), a2 + hstep, voffA);
            PG8_WAIT_V(8); PG8_WAIT_L(0); PG8_BAR; PG8_MMA(0, 0, At, B0); PG8_MMA(0, 1, At, B1); PG8_BAR; PG8_SCHED;
            PG8_LDA(At, 1, 1); PG8_STAGE(PG8_SB(1, 0), b3, voffB); PG8_STAGE(PG8_SB(1, 1), b3 + hstep, voffB); PG8_STAGE(PG8_SA(1, 0), a3, voffA);
            PG8_WAIT_V(8); PG8_WAIT_L(0); PG8_BAR; PG8_MMA(1, 0, At, B0); PG8_MMA(1, 1, At, B1); PG8_BAR; PG8_SCHED;
            } else {
            PG8_LDB(B0, 0, 0); PG8_SCHED; PG8_LDA(At, 0, 0); PG8_STAGE(PG8_SA(1, 1), a1 + hstep, voffA);
            PG8_WAIT_L(8); PG8_BAR; PG8_WAIT_L(0); PG8_MMA(0, 0, At, B0); PG8_BAR; PG8_SCHED;
            PG8_LDB(B1, 0, 1); PG8_STAGE(PG8_SB(0, 0), b2, voffB);
            PG8_BAR; PG8_WAIT_L(0); PG8_MMA(0, 1, At, B1); PG8_BAR;
            PG8_LDA(At, 0, 1); PG8_STAGE(PG8_SA(0, 0), a2, voffA);
            PG8_BAR; PG8_WAIT_L(0); PG8_MMA(1, 0, At, B0); PG8_BAR; PG8_SCHED;
            PG8_STAGE(PG8_SB(0, 1), b2 + hstep, voffB);
            PG8_WAIT_V(6); PG8_BAR; PG8_MMA(1, 1, At, B1); PG8_BAR;
            PG8_LDB(B0, 1, 0); PG8_SCHED; PG8_LDA(At, 1, 0); PG8_STAGE(PG8_SA(0, 1), a2 + hstep, voffA);
            PG8_WAIT_L(8); PG8_BAR; PG8_WAIT_L(0); PG8_MMA(0, 0, At, B0); PG8_BAR; PG8_SCHED;
            PG8_LDB(B1, 1, 1); PG8_STAGE(PG8_SB(1, 0), b3, voffB);
            PG8_BAR; PG8_WAIT_L(0); PG8_MMA(0, 1, At, B1); PG8_BAR;
            PG8_LDA(At, 1, 1); PG8_STAGE(PG8_SA(1, 0), a3, voffA);
            PG8_BAR; PG8_WAIT_L(0); PG8_MMA(1, 0, At, B0); PG8_BAR; PG8_SCHED;
            PG8_STAGE(PG8_SB(1, 1), b3 + hstep, voffB);
            PG8_WAIT_V(6); PG8_BAR; PG8_MMA(1, 1, At, B1); PG8_BAR;
            }
        }
        if constexpr (ALIGN_EPI) { if (wr == 0) PG8_BAR; }
        if constexpr (!Epi::AFTER_DRAIN) { E(acc, cur, wr, wc, fr, fq); S.done(cur); }
        if (!has_next) break;
#pragma unroll
        for (int a = 0; a < 2; ++a)
#pragma unroll
            for (int b = 0; b < 2; ++b)
#pragma unroll
                for (int m = 0; m < 4; ++m)
#pragma unroll
                    for (int n = 0; n < 2; ++n) acc[a][b][m][n] = (f32x4){0.f, 0.f, 0.f, 0.f};
        cur = nxt; cA = nA; cB = nB; ++ui;
        if constexpr (ALIGN_EPI) { if (wr == 1) PG8_BAR; }
    }
    PG8_WAIT_V(0);
    if constexpr (!ALIGN_EPI) { if (wr == 0) PG8_BAR; }
    PG8_BAR;
    if constexpr (Epi::AFTER_DRAIN) { E.fused(acc, cur, wr, wc, fr, fq, lds, wid, lane); S.done(cur); }
#undef PG8_SA
#undef PG8_SB
#undef PG8_STAGE
#undef PG8_LDA
#undef PG8_LDB
#undef PG8_MMA
#undef PG8_WAIT_V
#undef PG8_WAIT_L
#undef PG8_BAR
#undef PG8_SCHED
}
}
namespace attn {
using bf16 = __hip_bfloat16;
constexpr int   D = 128, NW = 8, QBLK = 32, KVBLK = 64;
constexpr float SCALE = 0.088388347648318440f;
#ifndef ATTN_THR
#define ATTN_THR 8.f
#endif
constexpr float THR = ATTN_THR;
constexpr int SDEPTH = 2;
constexpr int LDQ = 3584, LDK = 128, LDO = 2048;
constexpr size_t SHM_V = KVBLK * D * 2, SHM_K = KVBLK * D * 2, SHM_ATTN = 2 * SHM_V + 2 * SHM_K + NW * 64 * 4;
__device__ __forceinline__ unsigned short f2bf16(float f) { unsigned u = __builtin_bit_cast(unsigned, f); return (unsigned short)((u + 0x7fffu + ((u >> 16) & 1u)) >> 16); }
using bf16x8 = __attribute__((ext_vector_type(8))) short;
using s16x4  = __attribute__((ext_vector_type(4))) short;
using f32x16 = __attribute__((ext_vector_type(16))) float;
using f32x8  = __attribute__((ext_vector_type(8))) float;
using u32x4  = __attribute__((ext_vector_type(4))) unsigned;
#define KSWZ(row, colB) ((row) * 256 + ((colB) ^ (((row) & 7) << 4)))
#define SBAR() __builtin_amdgcn_sched_barrier(0)
__device__ __forceinline__ int crow(int r, int hi) { return (r & 3) + 8 * (r >> 2) + 4 * hi; }
__device__ __forceinline__ unsigned cvtpk(float lo, float hi) {
  unsigned r; asm volatile("v_cvt_pk_bf16_f32 %0, %1, %2" : "=v"(r) : "v"(lo), "v"(hi)); return r;
}
template <typename TIn> struct Stage;
template <> struct Stage<bf16>  { using T = bf16x8;
  __device__ static __forceinline__ T ld8(const bf16* p) { return *reinterpret_cast<const bf16x8*>(p); }
  __device__ static __forceinline__ bf16x8 tobf(T x) { return x; } };
template <> struct Stage<float> { using T = f32x8;
  __device__ static __forceinline__ T ld8(const float* p) { return *reinterpret_cast<const f32x8*>(p); }
  __device__ static __forceinline__ bf16x8 tobf(T x) {
    u32x4 w = {cvtpk(x[0], x[1]), cvtpk(x[2], x[3]), cvtpk(x[4], x[5]), cvtpk(x[6], x[7])}; return *reinterpret_cast<bf16x8*>(&w); } };

__device__ __forceinline__ void partialSM(f32x16& p0, f32x16& p1, float& m_reg, float& mn, float& alpha) {
  constexpr float C = SCALE * 1.4426950408889634f;
  float pmax = p0[0]; for (int r = 1; r < 16; ++r) pmax = fmaxf(pmax, p0[r]); for (int r = 0; r < 16; ++r) pmax = fmaxf(pmax, p1[r]);
  { auto rr = __builtin_amdgcn_permlane32_swap(__float_as_uint(pmax), __float_as_uint(pmax), false, false);
    pmax = fmaxf(__uint_as_float(rr[0]), __uint_as_float(rr[1])); }
  if (__builtin_expect(__all(pmax - m_reg <= THR / SCALE), 1)) { mn = m_reg; alpha = 1.f; }
  else { mn = fmaxf(m_reg, pmax); alpha = __builtin_amdgcn_exp2f((m_reg - mn) * C); m_reg = mn; }
  float mnC = -mn * C;
  for (int r = 0; r < 16; ++r) p0[r] = fmaf(p0[r], C, mnC); for (int r = 0; r < 16; ++r) p1[r] = fmaf(p1[r], C, mnC);
  for (int r = 0; r < 16; ++r) p0[r] = __builtin_amdgcn_exp2f(p0[r]);
}
__device__ __forceinline__ void finishSM(f32x16& p0, f32x16& p1, float alpha, float& l_reg, bf16x8& pa0, bf16x8& pa1, bf16x8& pa2, bf16x8& pa3) {
  for (int r = 0; r < 16; ++r) p1[r] = __builtin_amdgcn_exp2f(p1[r]);
  float ps = 0; for (int r = 0; r < 16; ++r) ps += p0[r]; for (int r = 0; r < 16; ++r) ps += p1[r];
  { auto rr = __builtin_amdgcn_permlane32_swap(__float_as_uint(ps), __float_as_uint(ps), false, false);
    ps = __uint_as_float(rr[0]) + __uint_as_float(rr[1]); }
  l_reg = l_reg * alpha + ps;
#define PK4(P, BASE, OUT) do { unsigned a0 = cvtpk(P[BASE + 0], P[BASE + 1]), a1 = cvtpk(P[BASE + 2], P[BASE + 3]);   \
    unsigned b0 = cvtpk(P[BASE + 4], P[BASE + 5]), b1 = cvtpk(P[BASE + 6], P[BASE + 7]);                              \
    auto r0 = __builtin_amdgcn_permlane32_swap(a0, b0, false, false); auto r1 = __builtin_amdgcn_permlane32_swap(a1, b1, false, false); \
    u32x4 w = {r0[0], r1[0], r0[1], r1[1]}; OUT = *reinterpret_cast<bf16x8*>(&w); } while (0)
  PK4(p0, 0, pa0); PK4(p0, 8, pa1); PK4(p1, 0, pa2); PK4(p1, 8, pa3);
#undef PK4
}
__device__ __forceinline__ void qkt(f32x16& p0, f32x16& p1, const bf16* Ks, const bf16x8* qr, int r32, int hi) {
  p0 = f32x16{}; p1 = f32x16{};
  for (int d0 = 0; d0 < 8; ++d0) { int cb = (d0 * 16 + hi * 8) * 2;
    bf16x8 b0 = *reinterpret_cast<const bf16x8*>((const char*)Ks + KSWZ(r32, cb));
    bf16x8 b1 = *reinterpret_cast<const bf16x8*>((const char*)Ks + KSWZ(32 + r32, cb));
    p0 = __builtin_amdgcn_mfma_f32_32x32x16_bf16(b0, qr[d0], p0, 0, 0, 0);
    p1 = __builtin_amdgcn_mfma_f32_32x32x16_bf16(b1, qr[d0], p1, 0, 0, 0); }
}
__device__ __forceinline__ int v_st(int k, int c) { const int kk = (k & ~0xC) | ((k & 4) << 1) | ((k & 8) >> 1); return ((kk >> 3) * 4 + (c >> 5)) * 512 + ((kk & 7) * 32 + (c & 31)) * 2; }
__device__ __forceinline__ int v_rd_base(int lane) { return ((lane & 3) << 3) | (((lane >> 2) & 3) << 6) | (((lane >> 4) & 1) << 5) | (((lane >> 5) & 1) << 8); }
constexpr int v_rd_off(int d0, int ks, int half) { return d0 * 512 + ks * 4096 + half * 2048; }
template <int OFF> __device__ __forceinline__ s16x4 tr_read(int vb) {
  s16x4 r; asm volatile("ds_read_b64_tr_b16 %0, %1 offset:%2" : "=&v"(r) : "v"(vb), "i"(OFF) : "memory"); return r;
}
template <int D0> __device__ __forceinline__ void pv_one(f32x16& od, int vb, bf16x8 pa0, bf16x8 pa1, bf16x8 pa2, bf16x8 pa3) {
  const s16x4 l0 = tr_read<v_rd_off(D0, 0, 0)>(vb), h0 = tr_read<v_rd_off(D0, 0, 1)>(vb), l1 = tr_read<v_rd_off(D0, 1, 0)>(vb), h1 = tr_read<v_rd_off(D0, 1, 1)>(vb);
  const s16x4 l2 = tr_read<v_rd_off(D0, 2, 0)>(vb), h2 = tr_read<v_rd_off(D0, 2, 1)>(vb), l3 = tr_read<v_rd_off(D0, 3, 0)>(vb), h3 = tr_read<v_rd_off(D0, 3, 1)>(vb);
  asm volatile("s_waitcnt lgkmcnt(0)" ::: "memory"); SBAR();
#define PK(L, H) (bf16x8){L[0], L[1], L[2], L[3], H[0], H[1], H[2], H[3]}
  od = __builtin_amdgcn_mfma_f32_32x32x16_bf16(pa0, PK(l0, h0), od, 0, 0, 0);
  od = __builtin_amdgcn_mfma_f32_32x32x16_bf16(pa1, PK(l1, h1), od, 0, 0, 0);
  od = __builtin_amdgcn_mfma_f32_32x32x16_bf16(pa2, PK(l2, h2), od, 0, 0, 0);
  od = __builtin_amdgcn_mfma_f32_32x32x16_bf16(pa3, PK(l3, h3), od, 0, 0, 0);
#undef PK
}
__device__ __forceinline__ void pv_d0(f32x16* o, int vb, bf16x8 pa0, bf16x8 pa1, bf16x8 pa2, bf16x8 pa3) {
  pv_one<0>(o[0], vb, pa0, pa1, pa2, pa3); pv_one<1>(o[1], vb, pa0, pa1, pa2, pa3); pv_one<2>(o[2], vb, pa0, pa1, pa2, pa3); pv_one<3>(o[3], vb, pa0, pa1, pa2, pa3);
}
__device__ __forceinline__ void attn_dense_body(const unsigned short* __restrict__ Qraw, const float* __restrict__ qgain, const float* __restrict__ rope, int t0,
                                                const bf16* __restrict__ Kh, const bf16* __restrict__ Vh, unsigned short* __restrict__ Ob, int seq, char* lds) {
  using St = Stage<bf16>;
  const int tid = threadIdx.x, wid = tid >> 6, lane = tid & 63, r32 = lane & 31, hi = lane >> 5;
  bf16* V_lds = (bf16*)lds; bf16* K_lds = (bf16*)(lds + 2 * SHM_V);
  float* ws = (float*)(lds + 2 * SHM_V + 2 * SHM_K) + wid * 64; float* li_l = ws; float* al_l = ws + 32;
  float m_reg = -1e30f, l_reg = 0; f32x16 o[4] = {}; bf16x8 qr[8];
  { const unsigned short* Qw = Qraw + (long)(wid * QBLK + r32) * LDQ + hi * 8;
    float xf[8][8]; float ss = 0.f;
#pragma unroll
    for (int d0 = 0; d0 < 8; ++d0) { const u32x4 w = *reinterpret_cast<const u32x4*>(Qw + d0 * 16);
#pragma unroll
      for (int j = 0; j < 4; ++j) { xf[d0][2 * j] = __uint_as_float(w[j] << 16); xf[d0][2 * j + 1] = __uint_as_float(w[j] & 0xffff0000u); }
#pragma unroll
      for (int j = 0; j < 8; ++j) ss += xf[d0][j] * xf[d0][j]; }
    { auto rr = __builtin_amdgcn_permlane32_swap(__float_as_uint(ss), __float_as_uint(ss), false, false); ss = __uint_as_float(rr[0]) + __uint_as_float(rr[1]); }
    const float rn = 1.f / sqrtf(ss * (1.f / 128.f) + 1e-6f);
#pragma unroll
    for (int d0 = 0; d0 < 8; ++d0) { const float4 g0 = *reinterpret_cast<const float4*>(qgain + d0 * 16 + hi * 8), g1 = *reinterpret_cast<const float4*>(qgain + d0 * 16 + hi * 8 + 4);
      xf[d0][0] *= rn * g0.x; xf[d0][1] *= rn * g0.y; xf[d0][2] *= rn * g0.z; xf[d0][3] *= rn * g0.w; xf[d0][4] *= rn * g1.x; xf[d0][5] *= rn * g1.y; xf[d0][6] *= rn * g1.z; xf[d0][7] *= rn * g1.w; }
    if (t0 >= 0) { const int t = t0 + wid * QBLK + r32;
#pragma unroll
      for (int a = 0; a < 2; ++a) { const int pos = a ? (t & 63) : (t >> 6);
#pragma unroll
        for (int hh = 0; hh < 2; ++hh) { const int d1 = 4 * a + hh, d2 = d1 + 2; const float* rp = rope + (long)(pos * 32 + hh * 16 + hi * 8) * 2;
#pragma unroll
          for (int jj = 0; jj < 4; ++jj) { const float4 cs = *reinterpret_cast<const float4*>(rp + 4 * jj);
            { const float y1 = xf[d1][2 * jj], y2 = xf[d2][2 * jj]; xf[d1][2 * jj] = y1 * cs.x - y2 * cs.y; xf[d2][2 * jj] = y1 * cs.y + y2 * cs.x; }
            { const float y1 = xf[d1][2 * jj + 1], y2 = xf[d2][2 * jj + 1]; xf[d1][2 * jj + 1] = y1 * cs.z - y2 * cs.w; xf[d2][2 * jj + 1] = y1 * cs.w + y2 * cs.z; } } } } }
#pragma unroll
    for (int d0 = 0; d0 < 8; ++d0) { u32x4 w = {cvtpk(xf[d0][0], xf[d0][1]), cvtpk(xf[d0][2], xf[d0][3]), cvtpk(xf[d0][4], xf[d0][5]), cvtpk(xf[d0][6], xf[d0][7])}; qr[d0] = *reinterpret_cast<bf16x8*>(&w); } }
  const int sr = tid >> 4, sc = (tid & 15) * 8, vst0 = v_st(sr, sc), vst1 = v_st(32 + sr, sc);
  const int vb0 = (int)(uintptr_t)V_lds + v_rd_base(lane);
  struct { typename St::T vs0, vs1, ks0, ks1; } sr_[SDEPTH];
#define SLOAD(i, k0) do { sr_[i].vs0 = St::ld8(&Vh[(long)((k0) + sr) * LDK + sc]); sr_[i].vs1 = St::ld8(&Vh[(long)((k0) + 32 + sr) * LDK + sc]); \
    sr_[i].ks0 = St::ld8(&Kh[(long)((k0) + sr) * LDK + sc]); sr_[i].ks1 = St::ld8(&Kh[(long)((k0) + 32 + sr) * LDK + sc]); } while (0)
#define SWRITE(b, i) do { *(bf16x8*)((char*)V_lds + (b) * SHM_V + vst0) = St::tobf(sr_[i].vs0);          \
    *(bf16x8*)((char*)V_lds + (b) * SHM_V + vst1) = St::tobf(sr_[i].vs1); int kc = sc * 2;               \
    *(bf16x8*)((char*)K_lds + (b) * SHM_K + KSWZ(sr, kc)) = St::tobf(sr_[i].ks0);                       \
    *(bf16x8*)((char*)K_lds + (b) * SHM_K + KSWZ(32 + sr, kc)) = St::tobf(sr_[i].ks1); } while (0)
#define SWAIT() do { if constexpr (SDEPTH == 2) asm volatile("s_waitcnt vmcnt(4)" ::: "memory"); else asm volatile("s_waitcnt vmcnt(0)" ::: "memory"); } while (0)
#define RESC(a) do { if (__any((a) < 1.f)) { if (hi == 0) al_l[r32] = (a); asm volatile("s_waitcnt lgkmcnt(0)" ::: "memory"); \
    for (int d = 0; d < 4; ++d) for (int r = 0; r < 16; ++r) o[d][r] *= al_l[crow(r, hi)]; } } while (0)
  f32x16 pA0, pA1, pB0, pB1; float mnA, mnB, alA, alB; bf16x8 pa0, pa1, pa2, pa3; const int NT = seq / KVBLK;
  constexpr int SE = 0, SO = SDEPTH - 1;
  SLOAD(SE, 0); asm volatile("s_waitcnt vmcnt(0)" ::: "memory"); SWRITE(0, SE); __syncthreads();
  qkt(pA0, pA1, K_lds, qr, r32, hi); partialSM(pA0, pA1, m_reg, mnA, alA);
  SLOAD(SO, KVBLK); if constexpr (SDEPTH == 2) { if (2 < NT) SLOAD(SE, 2 * KVBLK); }
  SWAIT(); SWRITE(1, SO); __syncthreads();
  for (int j = 1; j + 1 < NT; j += 2) {
    SBAR(); qkt(pB0, pB1, (bf16*)((char*)K_lds + SHM_K), qr, r32, hi);
    finishSM(pA0, pA1, alA, l_reg, pa0, pa1, pa2, pa3); SBAR();
    SLOAD(SO, (j + SDEPTH) * KVBLK); SBAR();
    pv_d0(o, vb0, pa0, pa1, pa2, pa3); partialSM(pB0, pB1, m_reg, mnB, alB);
    __syncthreads(); SWAIT(); SWRITE(0, SE);
    RESC(alB); __syncthreads();
    SBAR(); qkt(pA0, pA1, K_lds, qr, r32, hi);
    finishSM(pB0, pB1, alB, l_reg, pa0, pa1, pa2, pa3); SBAR();
    if (SDEPTH == 1 || j + 3 < NT) SLOAD(SE, (j + 1 + SDEPTH) * KVBLK); SBAR();
    pv_d0(o, vb0 + (int)SHM_V, pa0, pa1, pa2, pa3); partialSM(pA0, pA1, m_reg, mnA, alA);
    __syncthreads(); SWAIT(); SWRITE(1, SO);
    RESC(alA); __syncthreads();
  }
  SBAR(); qkt(pB0, pB1, (bf16*)((char*)K_lds + SHM_K), qr, r32, hi);
  finishSM(pA0, pA1, alA, l_reg, pa0, pa1, pa2, pa3); SBAR();
  pv_d0(o, vb0, pa0, pa1, pa2, pa3); partialSM(pB0, pB1, m_reg, mnB, alB);
  __syncthreads(); RESC(alB);
  finishSM(pB0, pB1, alB, l_reg, pa0, pa1, pa2, pa3); SBAR();
  pv_d0(o, vb0 + (int)SHM_V, pa0, pa1, pa2, pa3);
  if (hi == 0) li_l[r32] = l_reg; asm volatile("s_waitcnt lgkmcnt(0)" ::: "memory");
  float rli[16];
#pragma unroll
  for (int r = 0; r < 16; ++r) rli[r] = __builtin_amdgcn_rcpf(li_l[crow(r, hi)]);
  unsigned short* Ow = Ob + (long)(wid * QBLK) * LDO;
#pragma unroll
  for (int r = 0; r < 16; ++r) { int orow = crow(r, hi);
    for (int d0 = 0; d0 < 4; ++d0) Ow[(long)orow * LDO + d0 * 32 + r32] = f2bf16(o[d0][r] * rli[r]); }
#undef SLOAD
#undef SWRITE
#undef SWAIT
#undef RESC
}
}
#define GAS __attribute__((address_space(1)))
#define LAS __attribute__((address_space(3)))
typedef unsigned short bf16r;
typedef float f32x4 __attribute__((ext_vector_type(4)));
typedef unsigned u32x4 __attribute__((ext_vector_type(4)));
typedef unsigned u32x2 __attribute__((ext_vector_type(2)));
typedef short bf16x8 __attribute__((ext_vector_type(8)));

constexpr int DM = 2048, NB = 4, SEQ = 4096, CTX = 256, NLAT = NB * SEQ, NCTX = NB * CTX, NROW = NLAT + NCTX;
constexpr int INC = 3584, DFF = 8192, NMODC = 6 * DM, KVLEN = CTX + SEQ;
constexpr int NLAYER = 2;
constexpr float LN_EPS = 1e-6f, RMS_EPS = 1e-6f, DN_ALPHA = 1.4142135623730951f;
constexpr size_t MiB = 1u << 20;
constexpr size_t WS_ROPE = 0, WS_BAR = 768 * 1024, WS_BAR_BYTES = 16384, WS_STAT = 576 * 1024, WS_MOD = 64 * 1024, WS_WIN = 1 * MiB, WS_WOUT = 29 * MiB, WS_WFF1 = 45 * MiB, WS_WFF2 = 109 * MiB;
constexpr size_t WS_X = 173 * MiB, WS_H = 309 * MiB, WS_S = 377 * MiB;
constexpr size_t WS_P = WS_S, WS_Q = 496 * MiB, WS_K = 530 * MiB, WS_V = 539 * MiB, WS_MIX = 548 * MiB, WS_ACT = WS_S, WS_PART = 649 * MiB, WS_END = 713 * MiB;
static_assert(WS_WIN + 2ull * INC * DM * 2 <= WS_WOUT && WS_WOUT + 2ull * DM * DM * 2 <= WS_WFF1 && WS_WFF1 + 2ull * DFF * DM * 2 <= WS_WFF2 && WS_WFF2 + 2ull * DFF * DM * 2 <= WS_X, "ws weights");
static_assert(WS_X + (size_t)NROW * DM * 4 <= WS_H && WS_H + (size_t)NROW * DM * 2 <= WS_S && WS_P + (size_t)NROW * INC * 2 <= WS_Q && WS_Q + (size_t)NROW * 1024 * 2 <= WS_K, "ws act 1");
static_assert(WS_K + (size_t)NB * 2 * KVLEN * 128 * 2 <= WS_V && WS_V + (size_t)NB * 2 * KVLEN * 128 * 2 <= WS_MIX && WS_MIX + (size_t)NROW * DM * 2 <= WS_PART && WS_ACT + (size_t)NROW * DFF * 2 <= WS_PART && WS_PART + 8ull * NCTX * DM * 4 <= WS_END, "ws act 2");
static_assert(WS_MOD + 2ull * 5 * NMODC * 4 <= WS_STAT && WS_STAT + (size_t)NROW * 8 <= WS_BAR && WS_BAR + WS_BAR_BYTES <= WS_WIN, "ws mod");
constexpr int LDS_BYTES = 147456;

__device__ __forceinline__ unsigned f2bf(float f) { unsigned u = __builtin_bit_cast(unsigned, f); return (u + 0x7fffu + ((u >> 16) & 1u)) >> 16; }
__device__ __forceinline__ unsigned pk2(float lo, float hi) { return f2bf(lo) | (f2bf(hi) << 16); }
__device__ __forceinline__ float bflo(unsigned w) { return __builtin_bit_cast(float, w << 16); }
__device__ __forceinline__ float bfhi(unsigned w) { return __builtin_bit_cast(float, w & 0xffff0000u); }
__device__ __forceinline__ void unpack8(const u32x4 w, float (&x)[8]) { x[0] = bflo(w.x); x[1] = bfhi(w.x); x[2] = bflo(w.y); x[3] = bfhi(w.y); x[4] = bflo(w.z); x[5] = bfhi(w.z); x[6] = bflo(w.w); x[7] = bfhi(w.w); }
__device__ __forceinline__ u32x4 pack8(const float (&x)[8]) { u32x4 w; w.x = pk2(x[0], x[1]); w.y = pk2(x[2], x[3]); w.z = pk2(x[4], x[5]); w.w = pk2(x[6], x[7]); return w; }
__device__ __forceinline__ float wave_sum(float v) {
#pragma unroll
    for (int o = 1; o < 64; o <<= 1) v += __shfl_xor(v, o);
    return v;
}
__device__ __forceinline__ float gelu_tanh(float x) {
    const float u = 0.7978845608028654f * (x + 0.044715f * x * x * x);
    const float e = __expf(2.f * u);
    const float t = 1.f - 2.f * __builtin_amdgcn_rcpf(e + 1.f);
    return 0.5f * x * (1.f + t);
}
__device__ __forceinline__ float sigmoidf_(float x) { return __builtin_amdgcn_rcpf(1.f + __expf(-x)); }
#define LDS_WAIT() asm volatile("s_waitcnt lgkmcnt(0)" ::: "memory")

static __device__ const double ROPE_FREQ[32] = {1.0, 0.7498942093324559, 0.5623413251903491, 0.4216965034285822, 0.31622776601683794, 0.23713737056616552, 0.1778279410038923, 0.1333521432163324, 0.1, 0.07498942093324558, 0.05623413251903491, 0.042169650342858224, 0.03162277660168379, 0.023713737056616554, 0.01778279410038923, 0.01333521432163324, 0.01, 0.007498942093324558, 0.005623413251903491, 0.004216965034285823, 0.0031622776601683794, 0.0023713737056616554, 0.0017782794100389228, 0.001333521432163324, 0.001, 0.0007498942093324559, 0.0005623413251903491, 0.00042169650342858224, 0.00031622776601683794, 0.00023713737056616554, 0.00017782794100389227, 0.0001333521432163324};

__device__ __forceinline__ void p0_rope(float* rope, int gtid, int gthreads) {
    for (int idx = gtid; idx < 64 * 32; idx += gthreads) {
        const int p = idx >> 5, f = idx & 31;
        const double ang = (double)p * ROPE_FREQ[f];
        const double k = __builtin_rint(ang * 0.15915494309189535);
        const double r = ang - k * 6.283185307179586;
        const double r2 = r * r; double tc = 1.0, ts = 1.0, cc = 1.0, ss = 1.0;
#pragma unroll
        for (int n = 1; n <= 14; ++n) { tc *= -r2 * (1.0 / (double)((2 * n - 1) * (2 * n))); cc += tc; ts *= -r2 * (1.0 / (double)((2 * n) * (2 * n + 1))); ss += ts; }
        rope[2 * idx] = (float)cc; rope[2 * idx + 1] = (float)(r * ss);
    }
}
__device__ __forceinline__ void p0_mod(LAS unsigned char* lds, const float* c, const float* c_ctx, const float* w_mod, const float* b_mod, float* MOD, int item0, int nitem, int bid, int G, int tid) {
    const int NITEM = item0 + nitem;
    if (bid < 0 || bid >= nitem) return;
    LAS float* condS = (LAS float*)lds;
    LAS float* red = (LAS float*)(lds + 5 * 2048 * 4);
    for (int i = tid; i < 5 * 2048; i += 512) { const int r = i >> 11, k = i & 2047; const float cv = (r < 4) ? c[r * 2048 + k] : c_ctx[k]; condS[i] = cv / (1.f + __expf(-cv)); }
    __syncthreads();
    const int kr = tid >> 5, cl = tid & 31;
    for (int item = item0 + bid; item < NITEM; item += G) {
        const int l = item / (NMODC / 128), n0 = (item % (NMODC / 128)) * 128;
        const float* wp = w_mod + ((size_t)l * 2048 + kr) * NMODC + n0 + 4 * cl;
        float acc[5][4];
#pragma unroll
        for (int r = 0; r < 5; ++r)
#pragma unroll
            for (int j = 0; j < 4; ++j) acc[r][j] = 0.f;
#pragma unroll 4
        for (int ks = 0; ks < 128; ++ks) {
            const f32x4 w = *(const f32x4*)(wp + (size_t)ks * 16 * NMODC); const int k = ks * 16 + kr;
#pragma unroll
            for (int r = 0; r < 5; ++r) { const float s = condS[r * 2048 + k];
#pragma unroll
                for (int j = 0; j < 4; ++j) acc[r][j] += s * w[j]; }
        }
#pragma unroll
        for (int r = 0; r < 5; ++r)
#pragma unroll
            for (int j = 0; j < 4; ++j) red[(kr * 32 + cl) * 20 + r * 4 + j] = acc[r][j];
        __syncthreads();
        for (int o = tid; o < 5 * 128; o += 512) { const int r = o >> 7, col = o & 127; float s = 0.f;
#pragma unroll
            for (int k2 = 0; k2 < 16; ++k2) s += red[(k2 * 32 + (col >> 2)) * 20 + r * 4 + (col & 3)];
            MOD[((size_t)l * 5 + r) * NMODC + n0 + col] = s + b_mod[(size_t)l * NMODC + n0 + col]; }
        __syncthreads();
    }
}
__device__ __forceinline__ void p0_transpose_item(const float* W, int K, int N, bf16r* WT, LAS float* scr, int item, int lane) {
    const int nblk = N / 64, kb = item / nblk, nb = item % nblk, k0 = 64 * kb, n0 = 64 * nb;
    const int r4 = lane >> 4, c4 = (lane & 15) * 4;
    f32x4 v[16];
#pragma unroll
    for (int i = 0; i < 16; ++i) v[i] = *(const f32x4*)(W + (size_t)(k0 + 4 * i + r4) * N + n0 + c4);
#pragma unroll
    for (int i = 0; i < 16; ++i) { LAS float* d = scr + (4 * i + r4) * 65 + c4; d[0] = v[i].x; d[1] = v[i].y; d[2] = v[i].z; d[3] = v[i].w; }
    LDS_WAIT(); asm volatile("" ::: "memory");
    const int c = lane & 7;
#pragma unroll
    for (int j = 0; j < 8; ++j) { const int n = (lane >> 3) + 8 * j; const LAS float* s = scr + (8 * c) * 65 + n;
        u32x4 o; o.x = pk2(s[0 * 65], s[1 * 65]); o.y = pk2(s[2 * 65], s[3 * 65]); o.z = pk2(s[4 * 65], s[5 * 65]); o.w = pk2(s[6 * 65], s[7 * 65]);
        *(u32x4*)(WT + (size_t)(n0 + n) * K + k0 + 8 * c) = o; }
    LDS_WAIT(); asm volatile("" ::: "memory");
}

__device__ __forceinline__ void row_stats(const f32x4 (&v)[8], float& mean, float& rstd) {
    float s = 0.f;
#pragma unroll
    for (int j = 0; j < 8; ++j) s += (v[j].x + v[j].y) + (v[j].z + v[j].w);
    mean = wave_sum(s) * (1.f / DM); float q = 0.f;
#pragma unroll
    for (int j = 0; j < 8; ++j) { const f32x4 d = v[j] - mean; q += (d.x * d.x + d.y * d.y) + (d.z * d.z + d.w * d.w); }
    rstd = 1.f / sqrtf(wave_sum(q) * (1.f / DM) + LN_EPS);
}
__device__ __forceinline__ void row_pass(const float* src_lat, const float* src_ctx, int nrows, const float* lng, const float* lnb, float* dst_lat, float* dst_ctx, float* stat,
                                         const float* modl  , int shift_off, int scale_off, bf16r* H, int gw, int NGW, int lane) {
    f32x4 v[8], vn[8];
    if (gw < nrows) { const float* sp = gw < NLAT ? src_lat + (size_t)gw * DM : src_ctx + (size_t)(gw - NLAT) * DM;
#pragma unroll
        for (int j = 0; j < 8; ++j) v[j] = *((const f32x4*)sp + 64 * j + lane); }
    for (int row = gw; row < nrows; row += NGW) {
        const bool lat = row < NLAT;
        const int rown = row + NGW;
        if (rown < nrows) { const float* sp = rown < NLAT ? src_lat + (size_t)rown * DM : src_ctx + (size_t)(rown - NLAT) * DM;
#pragma unroll
            for (int j = 0; j < 8; ++j) vn[j] = *((const f32x4*)sp + 64 * j + lane); }
        float mean, rstd;
        if (lng) {
            row_stats(v, mean, rstd);
            if (stat && lane == 0) { stat[2 * (size_t)row] = mean; stat[2 * (size_t)row + 1] = rstd; }
            float* dp = lat ? (dst_lat ? dst_lat + (size_t)row * DM : nullptr) : (dst_ctx ? dst_ctx + (size_t)(row - NLAT) * DM : nullptr);
#pragma unroll
            for (int j = 0; j < 8; ++j) { const f32x4 g = *((const f32x4*)lng + 64 * j + lane), b = *((const f32x4*)lnb + 64 * j + lane);
                v[j] = (v[j] - mean) * rstd * g + b; if (dp) *((f32x4*)dp + 64 * j + lane) = v[j]; }
        }
        if (modl) {
            row_stats(v, mean, rstd);
            const float* mr = modl + (size_t)(lat ? (row >> 12) : 4) * NMODC;
            bf16r* hp = H + (size_t)row * DM;
#pragma unroll
            for (int j = 0; j < 8; ++j) { const f32x4 sh = *((const f32x4*)(mr + shift_off) + 64 * j + lane), sc = *((const f32x4*)(mr + scale_off) + 64 * j + lane);
                const f32x4 o = (v[j] - mean) * rstd * (sc + 1.f) + sh; u32x2 w; w.x = pk2(o.x, o.y); w.y = pk2(o.z, o.w);
                *((u32x2*)hp + 64 * j + lane) = w; }
        }
#pragma unroll
        for (int j = 0; j < 8; ++j) v[j] = vn[j];
    }
}
__device__ __forceinline__ void row_pass_ctx(const float* src, const float* bstat, const float* bg, const float* bb, const float* part, const float* gate  , float* xdst,
                                             const float* lng, const float* lnb, float* stat, const float* modl, int shift_off, int scale_off, bf16r* H, int gw, int NGW, int lane) {
    for (int r = gw; r < NCTX; r += NGW) {
        const int row = NLAT + r;
        f32x4 v[8];
        float bm = 0.f, brs = 1.f; if (bstat) { bm = bstat[2 * (size_t)row]; brs = bstat[2 * (size_t)row + 1]; }
#pragma unroll
        for (int j = 0; j < 8; ++j) { f32x4 x = *((const f32x4*)(src + (size_t)r * DM) + 64 * j + lane);
            if (bstat) x = (x - bm) * brs * *((const f32x4*)bg + 64 * j + lane) + *((const f32x4*)bb + 64 * j + lane);
            f32x4 s = *((const f32x4*)(part + (size_t)r * DM) + 64 * j + lane);
#pragma unroll
            for (int k = 1; k < 8; ++k) s += *((const f32x4*)(part + ((size_t)k * NCTX + r) * DM) + 64 * j + lane);
            v[j] = x * DN_ALPHA + *((const f32x4*)gate + 64 * j + lane) * s;
            if (xdst) *((f32x4*)(xdst + (size_t)r * DM) + 64 * j + lane) = v[j]; }
        float mean, rstd;
        row_stats(v, mean, rstd);
        if (lane == 0) { stat[2 * (size_t)row] = mean; stat[2 * (size_t)row + 1] = rstd; }
#pragma unroll
        for (int j = 0; j < 8; ++j) v[j] = (v[j] - mean) * rstd * *((const f32x4*)lng + 64 * j + lane) + *((const f32x4*)lnb + 64 * j + lane);
        row_stats(v, mean, rstd);
        const float* mr = modl + (size_t)4 * NMODC;
        bf16r* hp = H + (size_t)row * DM;
#pragma unroll
        for (int j = 0; j < 8; ++j) { const f32x4 sh = *((const f32x4*)(mr + shift_off) + 64 * j + lane), sc = *((const f32x4*)(mr + scale_off) + 64 * j + lane);
            const f32x4 o = (v[j] - mean) * rstd * (sc + 1.f) + sh; u32x2 w; w.x = pk2(o.x, o.y); w.y = pk2(o.z, o.w);
            *((u32x2*)hp + 64 * j + lane) = w; }
    }
}

__device__ __forceinline__ f32x4 ld4_bf(const bf16r* p) { const u32x2 w = *(const u32x2*)p; return (f32x4){bflo(w.x), bfhi(w.x), bflo(w.y), bfhi(w.y)}; }
__device__ __forceinline__ void st4_bf(bf16r* p, const f32x4 o) { u32x2 w; w.x = pk2(o.x, o.y); w.y = pk2(o.z, o.w); *(u32x2*)p = w; }
typedef _Float16 h16x4 __attribute__((ext_vector_type(4)));
__device__ __forceinline__ f32x4 ld4_h(const bf16r* p) { const h16x4 h = *(const h16x4*)p; return __builtin_convertvector(h, f32x4); }
__device__ __forceinline__ void st4_h(bf16r* p, const f32x4 o) { *(h16x4*)p = __builtin_convertvector(o, h16x4); }
typedef _Float16 h16x8 __attribute__((ext_vector_type(8)));
typedef float f32x8v __attribute__((ext_vector_type(8)));
__device__ __forceinline__ void ld8_h(const bf16r* p, f32x4& a, f32x4& b) { const h16x8 h = *(const h16x8*)p; const f32x8v f = __builtin_convertvector(h, f32x8v); a = (f32x4){f[0], f[1], f[2], f[3]}; b = (f32x4){f[4], f[5], f[6], f[7]}; }
__device__ __forceinline__ void st8_h(bf16r* p, const f32x4 a, const f32x4 b) { const f32x8v f = {a.x, a.y, a.z, a.w, b.x, b.y, b.z, b.w}; *(h16x8*)p = __builtin_convertvector(f, h16x8); }
__device__ __forceinline__ void ld8_bf(const bf16r* p, f32x4& a, f32x4& b) { const u32x4 w = *(const u32x4*)p; a = (f32x4){bflo(w.x), bfhi(w.x), bflo(w.y), bfhi(w.y)}; b = (f32x4){bflo(w.z), bfhi(w.z), bflo(w.w), bfhi(w.w)}; }
__device__ __forceinline__ void st8_bf(bf16r* p, const f32x4 a, const f32x4 b) { u32x4 w; w.x = pk2(a.x, a.y); w.y = pk2(a.z, a.w); w.z = pk2(b.x, b.y); w.w = pk2(b.z, b.w); *(u32x4*)p = w; }
template <bool SRC_F32, bool OUT_F32>
__device__ __forceinline__ void row_pass_res(LAS unsigned char* lds, const float* srcf, const bf16r* XSi, const bf16r* Y, int nrows, const float* modl_cur, int gate_off, const float* lng, const float* lnb,
                                             bf16r* XSo, float* outf, const float* modl_next, int shift_off, int scale_off, bf16r* H, int gw, int NGW, int lane) {
    constexpr int wpb = 512;
    if (NGW != wpb * NB || nrows != NLAT) return;
    const int b = gw >> 9, w0 = gw & 511;
    LAS f32x4* V = (LAS f32x4*)lds;
    { const float* gp = modl_cur + (size_t)b * NMODC + gate_off; const float* mr = modl_next ? modl_next + (size_t)b * NMODC : modl_cur;
      const int t = threadIdx.x;
      V[t] = *(const f32x4*)(gp + 4 * t); V[512 + t] = *(const f32x4*)(lng + 4 * t); V[1024 + t] = *(const f32x4*)(lnb + 4 * t);
      if (modl_next) { V[1536 + t] = *(const f32x4*)(mr + scale_off + 4 * t) + 1.f; V[2048 + t] = *(const f32x4*)(mr + shift_off + 4 * t); } }
    __syncthreads();
#pragma unroll 1
    for (int rr = w0; rr < SEQ; rr += wpb) {
        const int row = b * SEQ + rr;
        f32x4 v[8];
#pragma unroll
        for (int j = 0; j < 4; ++j) { const int q = 2 * (64 * j + lane), e = 4 * q;
            f32x4 x0, x1, y0, y1;
            if (SRC_F32) { x0 = *(const f32x4*)(srcf + (size_t)row * DM + e); x1 = *(const f32x4*)(srcf + (size_t)row * DM + e + 4); } else ld8_h(XSi + (size_t)row * DM + e, x0, x1);
            ld8_bf(Y + (size_t)row * DM + e, y0, y1);
            v[2 * j] = x0 * DN_ALPHA + V[q] * y0; v[2 * j + 1] = x1 * DN_ALPHA + V[q + 1] * y1; }
        float mean, rstd; row_stats(v, mean, rstd);
#pragma unroll
        for (int j = 0; j < 4; ++j) { const int q = 2 * (64 * j + lane), e = 4 * q;
            v[2 * j] = (v[2 * j] - mean) * rstd * V[512 + q] + V[1024 + q]; v[2 * j + 1] = (v[2 * j + 1] - mean) * rstd * V[512 + q + 1] + V[1024 + q + 1];
            if (OUT_F32) { *(f32x4*)(outf + (size_t)row * DM + e) = v[2 * j]; *(f32x4*)(outf + (size_t)row * DM + e + 4) = v[2 * j + 1]; } else st8_h(XSo + (size_t)row * DM + e, v[2 * j], v[2 * j + 1]); }
        if (modl_next) { row_stats(v, mean, rstd);
#pragma unroll
            for (int j = 0; j < 4; ++j) { const int q = 2 * (64 * j + lane), e = 4 * q;
                const f32x4 o0 = (v[2 * j] - mean) * rstd * V[1536 + q] + V[2048 + q], o1 = (v[2 * j + 1] - mean) * rstd * V[1536 + q + 1] + V[2048 + q + 1];
                st8_bf(H + (size_t)row * DM + e, o0, o1); } }
    }
    __syncthreads();
}
template <bool SRC_F32>
__device__ __forceinline__ void row_pass_ctx_res(const float* srcf, bf16r* XS, const float* part, const float* gate, const float* lng, const float* lnb, bool write_xs,
                                                 const float* modl_next, int shift_off, int scale_off, bf16r* H, int gw, int NGW, int lane) {
    for (int r = gw; r < NCTX; r += NGW) {
        const int row = NLAT + r; f32x4 v[8];
#pragma unroll
        for (int j = 0; j < 8; ++j) { const int e = 4 * (64 * j + lane);
            f32x4 xp; if (SRC_F32) xp = *(const f32x4*)(srcf + (size_t)r * DM + e); else xp = ld4_h(XS + (size_t)row * DM + e);
            f32x4 s = *(const f32x4*)(part + (size_t)r * DM + e);
#pragma unroll
            for (int k = 1; k < 8; ++k) s += *(const f32x4*)(part + ((size_t)k * NCTX + r) * DM + e);
            v[j] = xp * DN_ALPHA + *(const f32x4*)(gate + e) * s; }
        float mean, rstd; row_stats(v, mean, rstd);
#pragma unroll
        for (int j = 0; j < 8; ++j) { const int e = 4 * (64 * j + lane);
            v[j] = (v[j] - mean) * rstd * *(const f32x4*)(lng + e) + *(const f32x4*)(lnb + e);
            if (write_xs) st4_h(XS + (size_t)row * DM + e, v[j]); }
        row_stats(v, mean, rstd); const float* mr = modl_next + (size_t)4 * NMODC;
#pragma unroll
        for (int j = 0; j < 8; ++j) { const int e = 4 * (64 * j + lane);
            const f32x4 o = (v[j] - mean) * rstd * (*(const f32x4*)(mr + scale_off + e) + 1.f) + *(const f32x4*)(mr + shift_off + e);
            st4_bf(H + (size_t)row * DM + e, o); }
    }
}

__device__ __forceinline__ void row_pass0(LAS unsigned char* lds, const float* x_in, const float* ctx_in, const float* mod0  , bf16r* H, int gw, int NGW, int lane) {
    constexpr int wpb = 512;
    if (NGW != wpb * NB) { row_pass(x_in, ctx_in, NROW, nullptr, nullptr, nullptr, nullptr, nullptr, mod0, 0 * DM, 1 * DM, H, gw, NGW, lane); return; }
    const int b = gw >> 9, w0 = gw & 511;
    LAS f32x4* V = (LAS f32x4*)lds;
    { const float* mr = mod0 + (size_t)b * NMODC; const int t = threadIdx.x;
      V[t] = *(const f32x4*)(mr + 1 * DM + 4 * t) + 1.f; V[512 + t] = *(const f32x4*)(mr + 0 * DM + 4 * t); }
    __syncthreads();
#pragma unroll 1
    for (int rr = w0; rr < SEQ; rr += wpb) {
        const int row = b * SEQ + rr; f32x4 v[8];
#pragma unroll
        for (int j = 0; j < 8; ++j) v[j] = *(const f32x4*)(x_in + (size_t)row * DM + 4 * (64 * j + lane));
        float mean, rstd; row_stats(v, mean, rstd);
#pragma unroll
        for (int j = 0; j < 8; ++j) { const f32x4 o = (v[j] - mean) * rstd * V[64 * j + lane] + V[512 + 64 * j + lane]; st4_bf(H + (size_t)row * DM + 4 * (64 * j + lane), o); }
    }
    __syncthreads();
    const float* mr = mod0 + (size_t)4 * NMODC;
    for (int r = gw; r < NCTX; r += NGW) {
        const int row = NLAT + r; f32x4 v[8];
#pragma unroll
        for (int j = 0; j < 8; ++j) v[j] = *(const f32x4*)(ctx_in + (size_t)r * DM + 4 * (64 * j + lane));
        float mean, rstd; row_stats(v, mean, rstd);
#pragma unroll
        for (int j = 0; j < 8; ++j) { const int e = 4 * (64 * j + lane);
            const f32x4 o = (v[j] - mean) * rstd * (*(const f32x4*)(mr + 1 * DM + e) + 1.f) + *(const f32x4*)(mr + 0 * DM + e); st4_bf(H + (size_t)row * DM + e, o); }
    }
}

__device__ __forceinline__ void rms_rope_apply(const u32x4 w1, const u32x4 w2, const float (&g1)[8], const float (&g2)[8], const f32x4 (&rp)[4], bool rope_on, u32x4& o1w, u32x4& o2w) {
    float x1[8], x2[8]; unpack8(w1, x1); unpack8(w2, x2);
    float ss = 0.f;
#pragma unroll
    for (int j = 0; j < 8; ++j) ss += x1[j] * x1[j] + x2[j] * x2[j];
    ss += __shfl_xor(ss, 1); ss += __shfl_xor(ss, 2); ss += __shfl_xor(ss, 4);
    const float rn = 1.f / sqrtf(ss * (1.f / 128.f) + RMS_EPS);
    float o1[8], o2[8];
#pragma unroll
    for (int j = 0; j < 8; ++j) { const float y1 = x1[j] * rn * g1[j], y2 = x2[j] * rn * g2[j];
        float c = 1.f, s = 0.f; if (rope_on) { c = rp[j >> 1][(j & 1) * 2]; s = rp[j >> 1][(j & 1) * 2 + 1]; }
        o1[j] = y1 * c - y2 * s; o2[j] = y1 * s + y2 * c; }
    o1w = pack8(o1); o2w = pack8(o2);
}
__device__ __forceinline__ void prep_qkv(const bf16r* __restrict__ P, bf16r* __restrict__ Qb, bf16r* __restrict__ Kb, bf16r* __restrict__ Vb, const float* __restrict__ qg, const float* __restrict__ kg,
                                         const float* __restrict__ rope, int nrows, bool ctx_q, int gw, int NGW, int lane) {
    const int i = lane & 7, a = i >> 2, f0 = (i & 3) * 8, head = lane >> 3, kvh = (lane & 15) >> 3, vj = lane & 31;
    float gq1[8], gq2[8], gk1[8], gk2[8];
#pragma unroll
    for (int j = 0; j < 8; ++j) { gq1[j] = qg[a * 64 + f0 + j]; gq2[j] = qg[a * 64 + 32 + f0 + j]; gk1[j] = kg[a * 64 + f0 + j]; gk2[j] = kg[a * 64 + 32 + f0 + j]; }
    for (int row0 = gw * 2; row0 < nrows; row0 += NGW * 2) {
        u32x4 k1[2], k2[2], vv[2]; f32x4 rp[2][4];
#pragma unroll
        for (int r = 0; r < 2; ++r) { const int row = row0 + r; const bf16r* prow = P + (size_t)row * INC;
            const bool lat = row < NLAT; const int t = lat ? (row & 4095) : ((row - NLAT) & 255);
            const bf16r* ks = prow + 3072 + kvh * 128 + a * 64 + f0;
            k1[r] = *(const u32x4*)ks; k2[r] = *(const u32x4*)(ks + 32); vv[r] = *(const u32x4*)(prow + 3328 + vj * 8);
            const int pos = (a == 0) ? (t >> 6) : (t & 63); const float* rpp = rope + (size_t)(pos * 32 + f0) * 2;
#pragma unroll
            for (int jj = 0; jj < 4; ++jj) rp[r][jj] = *(const f32x4*)(rpp + 4 * jj); }
#pragma unroll
        for (int r = 0; r < 2; ++r) { const int row = row0 + r;
            const bool lat = row < NLAT; const int b = lat ? (row >> 12) : ((row - NLAT) >> 8), t = lat ? (row & 4095) : ((row - NLAT) & 255);
            const int posk = lat ? CTX + t : t;
            u32x4 o1, o2;
            rms_rope_apply(k1[r], k2[r], gk1, gk2, rp[r], lat, o1, o2);
            if (lane < 16) { bf16r* dst = Kb + ((size_t)(b * 2 + kvh) * KVLEN + posk) * 128 + a * 64 + f0; *(u32x4*)dst = o1; *(u32x4*)(dst + 32) = o2; }
            if (lane < 32) *(u32x4*)(Vb + ((size_t)(b * 2 + (vj >> 4)) * KVLEN + posk) * 128 + (vj & 15) * 8) = vv[r]; }
    }
}

__device__ __forceinline__ void gmlp_ldw(const float* __restrict__ Wh, int wave, int lane, f32x4 (&w)[8]) {
    const float* p = Wh + (size_t)(16 * wave + (lane & 15)) * 128 + 8 * (lane >> 4);
#pragma unroll
    for (int ks = 0; ks < 4; ++ks) { w[2 * ks] = *(const f32x4*)(p + ks * 32); w[2 * ks + 1] = *(const f32x4*)(p + ks * 32 + 4); }
}
__device__ __forceinline__ void gmlp_item(LAS unsigned char* lds, const bf16r* __restrict__ P, bf16r* __restrict__ MIX, const float* __restrict__ lng, const float* __restrict__ lnb,
                                          const float* __restrict__ Ws  , const float* __restrict__ bs  , int ch, int tid, int wave, int lane) {
    constexpr int LDT = 136;
    LAS bf16r* vT = (LAS bf16r*)lds;
    const int r0 = ch * 128;
    f32x4 wreg[8]; gmlp_ldw(Ws, wave, lane, wreg);
    { float gl[8], bl[8];
#pragma unroll
      for (int j = 0; j < 8; ++j) { gl[j] = lng[lane * 8 + j]; bl[j] = lnb[lane * 8 + j]; }
#pragma unroll
      for (int hb = 0; hb < 2; ++hb) {
        u32x4 raw[8];
#pragma unroll
        for (int i = 0; i < 8; ++i) raw[i] = *(const u32x4*)(P + (size_t)(r0 + wave + 8 * (hb * 8 + i)) * INC + 512 + lane * 8);
#pragma unroll
        for (int i = 0; i < 8; ++i) { const int q = wave + 8 * (hb * 8 + i);
            float x[8]; unpack8(raw[i], x);
            float s = 0.f;
#pragma unroll
            for (int j = 0; j < 8; ++j) { x[j] = gelu_tanh(x[j]); s += x[j]; }
            const float mean = wave_sum(s) * (1.f / 512.f); float qq = 0.f;
#pragma unroll
            for (int j = 0; j < 8; ++j) { const float d = x[j] - mean; qq += d * d; }
            const float rstd = __builtin_amdgcn_rsqf(wave_sum(qq) * (1.f / 512.f) + LN_EPS);
#pragma unroll
            for (int j = 0; j < 8; ++j) { const float v = (x[j] - mean) * rstd * gl[j] + bl[j]; vT[(lane * 8 + j) * LDT + (((q >> 3) ^ (lane & 15)) << 3) + (q & 7)] = (bf16r)f2bf(v); } }
      } }
    __syncthreads();
    const int p = 16 * wave + (lane & 15); const size_t row = (size_t)(r0 + p);
#pragma unroll 1
    for (int h = 0; h < 4; ++h) {
        bf16x8 bfr[4];
#pragma unroll
        for (int ks = 0; ks < 4; ++ks) { u32x4 t; t.x = pk2(wreg[2 * ks].x, wreg[2 * ks].y); t.y = pk2(wreg[2 * ks].z, wreg[2 * ks].w); t.z = pk2(wreg[2 * ks + 1].x, wreg[2 * ks + 1].y); t.w = pk2(wreg[2 * ks + 1].z, wreg[2 * ks + 1].w);
            bfr[ks] = __builtin_bit_cast(bf16x8, t); }
        if (h < 3) gmlp_ldw(Ws + (size_t)(h + 1) * 128 * 128, wave, lane, wreg);
        const float bsv = bs[h * 128 + p];
        u32x2 uw[8];
#pragma unroll
        for (int dt = 0; dt < 8; ++dt) uw[dt] = *(const u32x2*)(P + row * INC + h * 128 + 16 * dt + 4 * (lane >> 4));
#pragma unroll
        for (int dt = 0; dt < 8; ++dt) {
            pg8::f32x4 acc = {0.f, 0.f, 0.f, 0.f};
#pragma unroll
            for (int ks = 0; ks < 4; ++ks) { const int c = h * 128 + 16 * dt + (lane & 15); const bf16x8 af = *(const LAS bf16x8*)(vT + c * LDT + (((ks * 4 + (lane >> 4)) ^ ((c >> 3) & 15)) << 3));
                acc = __builtin_amdgcn_mfma_f32_16x16x32_bf16(af, bfr[ks], acc, 0, 0, 0); }
            const float u0 = gelu_tanh(bflo(uw[dt].x)), u1 = gelu_tanh(bfhi(uw[dt].x)), u2 = gelu_tanh(bflo(uw[dt].y)), u3 = gelu_tanh(bfhi(uw[dt].y));
            u32x2 o; o.x = pk2(u0 * (acc[0] + bsv), u1 * (acc[1] + bsv)); o.y = pk2(u2 * (acc[2] + bsv), u3 * (acc[3] + bsv));
            *(u32x2*)(MIX + row * DM + h * 128 + 16 * dt + 4 * (lane >> 4)) = o;
        }
    }
    __syncthreads();
}

__device__ __forceinline__ void conv_item(LAS unsigned char* lds, const bf16r* __restrict__ P, bf16r* __restrict__ MIX, const float* __restrict__ wdw  , const float* __restrict__ bdw,
                                          const float* __restrict__ lng, const float* __restrict__ lnb, int item, int tid, int wave, int lane) {
    LAS float* z = (LAS float*)lds;
    const int row0 = item * 32;
    const int seq0 = row0 < NLAT ? (row0 & ~4095) : (NLAT + ((row0 - NLAT) & ~255)), seq1 = seq0 + (row0 < NLAT ? SEQ : CTX);
    float acc[32]; float w[31];
    { const float bv = bdw[tid];
#pragma unroll
      for (int t = 0; t < 32; ++t) acc[t] = bv;
#pragma unroll
      for (int j = 0; j < 31; ++j) w[j] = wdw[j * 512 + tid]; }
    { u32x4 ra[8], rb[8];
#pragma unroll
      for (int i = 0; i < 8; ++i) { const int rr = wave + 8 * i; int g = row0 - 15 + rr; const bool ok = rr < 62 && g >= seq0 && g < seq1; if (!ok) g = row0;
          ra[i] = *(const u32x4*)(P + (size_t)g * INC + 1024 + lane * 8); rb[i] = *(const u32x4*)(P + (size_t)g * INC + 1536 + lane * 8); }
#pragma unroll
      for (int i = 0; i < 8; ++i) { const int rr = wave + 8 * i; const int g = row0 - 15 + rr; const bool ok = g >= seq0 && g < seq1;
          if (rr < 62) { float a[8], b[8], zv[8]; unpack8(ra[i], a); unpack8(rb[i], b);
#pragma unroll
              for (int j = 0; j < 8; ++j) zv[j] = ok ? a[j] * sigmoidf_(b[j]) : 0.f;
              *(LAS f32x4*)(z + rr * 512 + lane * 8) = (f32x4){zv[0], zv[1], zv[2], zv[3]}; *(LAS f32x4*)(z + rr * 512 + lane * 8 + 4) = (f32x4){zv[4], zv[5], zv[6], zv[7]}; } } }
    __syncthreads();
#pragma unroll
    for (int rr = 0; rr < 62; ++rr) { const float zv = z[rr * 512 + tid];
#pragma unroll
        for (int t = 0; t < 32; ++t) { if (rr - t >= 0 && rr - t <= 30) acc[t] += w[rr - t] * zv; } }
    __syncthreads();
#pragma unroll
    for (int t = 0; t < 32; ++t) z[t * 512 + tid] = acc[t];
    __syncthreads();
    float gl[8], bl[8];
#pragma unroll
    for (int j = 0; j < 8; ++j) { gl[j] = lng[lane * 8 + j]; bl[j] = lnb[lane * 8 + j]; }
#pragma unroll
    for (int i = 0; i < 4; ++i) { const int t = wave * 4 + i;
        const f32x4 y0 = *(const LAS f32x4*)(z + t * 512 + lane * 8), y1 = *(const LAS f32x4*)(z + t * 512 + lane * 8 + 4);
        float x[8] = {y0.x, y0.y, y0.z, y0.w, y1.x, y1.y, y1.z, y1.w};
        float s = 0.f;
#pragma unroll
        for (int j = 0; j < 8; ++j) s += x[j];
        const float mean = wave_sum(s) * (1.f / 512.f); float qq = 0.f;
#pragma unroll
        for (int j = 0; j < 8; ++j) { const float d = x[j] - mean; qq += d * d; }
        const float rstd = __builtin_amdgcn_rsqf(wave_sum(qq) * (1.f / 512.f) + LN_EPS);
        float o[8];
#pragma unroll
        for (int j = 0; j < 8; ++j) { const float v = (x[j] - mean) * rstd * gl[j] + bl[j]; o[j] = v * sigmoidf_(v); }
        *(u32x4*)(MIX + (size_t)(row0 + t) * DM + 512 + lane * 8) = pack8(o);
    }
    __syncthreads();
}

#define XB_TMO      128
#define XB_XCNT(j)  (256  + 64 * (j))
#define XB_XSUB(j)  (1280 + 64 * (j))
#define XB_XGEN(j)  (2304 + 64 * (j))
#define XB_TOP      3328
#define XB_TOPGEN   3392
#define XCD_BAR_WORDS 3456
#define XB_SPIN_CAP (1u << 18)

__device__ __forceinline__ unsigned xb_ld(unsigned* p)              { return __hip_atomic_load(p, __ATOMIC_RELAXED, __HIP_MEMORY_SCOPE_AGENT); }
__device__ __forceinline__ unsigned xb_add(unsigned* p, unsigned v) { return __hip_atomic_fetch_add(p, v, __ATOMIC_RELAXED, __HIP_MEMORY_SCOPE_AGENT); }
__device__ __forceinline__ unsigned xb_xcc_id() { return (unsigned)__builtin_amdgcn_s_getreg((3 << 11) | 20) & 0xFu; }
#define XB_SPIN(cond, bar) do { unsigned _sp = 0; while (cond) { __builtin_amdgcn_s_sleep(6); \
    if ((++_sp & 255u) == 0u) { if (xb_ld(&(bar)[XB_TMO])) break; if (_sp > XB_SPIN_CAP) { atomicAdd(&(bar)[XB_TMO], 1u); break; } } } } while (0)

struct XcdBarrier {
    unsigned* bar; unsigned x;
    volatile LAS unsigned* st;
};

__device__ __forceinline__ XcdBarrier xcd_barrier_post(unsigned* bar, volatile LAS unsigned* st) {
    XcdBarrier b; b.bar = bar; b.x = xb_xcc_id(); b.st = st;
    if (threadIdx.x == 0) (void)xb_add(&bar[XB_XCNT(b.x)], 1u);
    return b;
}
__device__ __forceinline__ void xcd_barrier_complete(unsigned* bar, unsigned x, unsigned& nloc, unsigned& nx) {
    const unsigned G = gridDim.x * gridDim.y * gridDim.z;
    unsigned sum, cnt, mine, sp = 0u;
    for (;;) {
        sum = 0u; cnt = 0u; mine = 0u;
#pragma unroll
        for (unsigned j = 0; j < 16; ++j) { const unsigned c = xb_ld(&bar[XB_XCNT(j)]); sum += c; cnt += (c > 0u) ? 1u : 0u; mine = (j == x) ? c : mine; }
        if (sum == G) break;
        __builtin_amdgcn_s_sleep(1);
        if ((++sp & 255u) == 0u) { if (xb_ld(&bar[XB_TMO])) break; if (sp > XB_SPIN_CAP) { atomicAdd(&bar[XB_TMO], 1u); break; } }
    }
    nloc = mine > 0u ? mine : 1u; nx = cnt > 0u ? cnt : 1u;
}

__device__ __forceinline__ void xcd_barrier(const XcdBarrier& b) {
    asm volatile("s_waitcnt vmcnt(0)" ::: "memory");
    __syncthreads();
    if (threadIdx.x == 0) {
        unsigned* bar = b.bar;
        __builtin_amdgcn_s_waitcnt(0);
        unsigned nloc = b.st[0], nx = b.st[1];
        if (nloc == 0u) { xcd_barrier_complete(bar, b.x, nloc, nx); b.st[0] = nloc; b.st[1] = nx; }
        const unsigned old = xb_add(&bar[XB_XSUB(b.x)], 1u);
        const unsigned gen = old / nloc;
        if (old + 1u == (gen + 1u) * nloc) {
            __builtin_amdgcn_fence(__ATOMIC_RELEASE, "agent");
            asm volatile("s_waitcnt vmcnt(0)" ::: "memory");
            const unsigned og = xb_add(&bar[XB_TOP], 1u);
            const unsigned tg = og / nx;
            if (og + 1u == (tg + 1u) * nx) xb_add(&bar[XB_TOPGEN], 1u);
            else XB_SPIN(xb_ld(&bar[XB_TOPGEN]) == tg, bar);
            __builtin_amdgcn_fence(__ATOMIC_ACQUIRE, "agent");
            xb_add(&bar[XB_XGEN(b.x)], 1u);
            asm volatile("s_waitcnt vmcnt(0)" ::: "memory");
        } else {
            XB_SPIN(xb_ld(&bar[XB_XGEN(b.x)]) == gen, bar);
            __builtin_amdgcn_fence(__ATOMIC_ACQUIRE, "agent");
            asm volatile("s_waitcnt vmcnt(0)" ::: "memory");
        }
    }
    __syncthreads();
}

#ifndef REP_P0
#define REP_P0 0
#endif
#ifndef REP_RP
#define REP_RP 0
#endif
#ifndef REP_ATTN
#define REP_ATTN 0
#endif
#ifndef REP_PREP
#define REP_PREP 0
#endif
#ifndef REP_QKV
#define REP_QKV 0
#endif
#ifndef REP_GMLP
#define REP_GMLP 0
#endif
#ifndef REP_CONV
#define REP_CONV 0
#endif
#ifndef REP_G1
#define REP_G1 0
#endif
#ifndef REP_G3
#define REP_G3 0
#endif
#ifndef REP_G4
#define REP_G4 0
#endif
#ifndef REP_G2
#define REP_G2 0
#endif
#ifndef ALIGN_RG
#define ALIGN_RG true
#endif
#ifndef FF2_KREV
#define FF2_KREV 1
#endif
#define REPEAT(n) for (int rep_ = 0; rep_ < 1 + (n); ++rep_)
struct Args { const float* in[24]; float* out; unsigned char* ws; int ph_lo, ph_hi; };
constexpr int N_PHASES = 2 + 8 * NLAYER;
struct Ctx {
    LAS unsigned char* lds; unsigned char* lds_raw; int tid, lane, wave, G, bx, vcu, gw, NGW, lo, hi;
    const float *w_in, *w_out, *w_ff1, *w_ff2;
    const float *x_in, *ctx_in, *a_ln_g, *a_ln_b, *a_ws, *a_bs, *b_dw, *b_dwb, *b_ln_g, *b_ln_b, *q_gain, *k_gain, *ln1_g, *ln1_b, *ln2_g, *ln2_b;
    float *rope, *MOD, *X, *out, *STAT, *PART; bf16r *Wt_in, *Wt_out, *Wt_ff1, *Wt_ff2, *H, *P, *Qb, *Kb, *Vb, *MIX, *ACT;
};
#define RUN (pid >= C.lo && pid < C.hi)
#define SEAM() do { if (pid >= C.lo && pid + 1 < C.hi) xcd_barrier(bar); ++pid; } while (0)

__device__ __forceinline__ void tail_transposes(const Ctx& C, int nwg, const float* Wa, int Ka, int Na, bf16r* Ta, const float* Wb2, int Kb, int Nb, bf16r* Tb) {
    const int first = nwg % C.G;
    if (C.bx < first) return;
    LAS float* scr = (LAS float*)(C.lds + C.wave * 16640);
    const int ia = (Ka / 64) * (Na / 64), ib = Wb2 ? (Kb / 64) * (Nb / 64) : 0, stride = (C.G - first) * 8;
    for (int it = (C.bx - first) * 8 + C.wave; it < ia + ib; it += stride) {
        if (it < ia) p0_transpose_item(Wa, Ka, Na, Ta, scr, it, C.lane); else p0_transpose_item(Wb2, Kb, Nb, Tb, scr, it - ia, C.lane);
    }
}

#ifndef STG_OUT
#define STG_OUT 0
#endif
#ifndef STG_FF2
#define STG_FF2 0
#endif
#ifndef STG_FF1
#define STG_FF1 0
#endif
#ifndef STG_IN
#define STG_IN 0
#endif
__device__ __forceinline__ void stagger(int k, unsigned ticks) {
    if (ticks == 0u) return;
    const unsigned long long t0 = __builtin_amdgcn_s_memrealtime(), w = (unsigned long long)k * ticks;
    while (__builtin_amdgcn_s_memrealtime() - t0 < w) __builtin_amdgcn_s_sleep(4);
}

template <int l> __device__ __forceinline__ void layer_body(const Ctx& C, int& pid, const XcdBarrier& bar) {
    constexpr bool last = (l == NLAYER - 1);
    constexpr int Mrows = last ? NLAT : NROW;
    const float* modl = C.MOD + (size_t)l * 5 * NMODC;
    float* Xc = C.X + (size_t)NLAT * DM;
    if (RUN) {
#if !defined(DIS_GEMM) && !defined(DIS_G1)
        stagger((C.bx >> 3) & 7, STG_IN);
        pg8::Gemm g{C.H, C.Wt_in + (size_t)l * INC * DM, Mrows, INC, DM, DM / 64}; pg8::OrderX S; S.init(Mrows, INC, C.G, C.bx, 64, last ? 4 : 0, 12, 2);
        pg8::EpiBf16<0> E{C.P, INC};
        REPEAT(REP_G1) pg8::gemm_phase<pg8::EpiBf16<0>, pg8::OrderX, true, true>(C.lds, g, S, E);
        if (l == 0) tail_transposes(C, (Mrows / 256) * (INC / 256), C.w_in + (size_t)DM * INC, DM, INC, C.Wt_in + (size_t)INC * DM, nullptr, 0, 0, nullptr);
        else tail_transposes(C, (Mrows / 256) * (INC / 256) + 8, C.w_out + (size_t)DM * DM, DM, DM, C.Wt_out + (size_t)DM * DM, C.w_ff1 + (size_t)DM * DFF, DM, DFF, C.Wt_ff1 + (size_t)DFF * DM);
#endif
    }
    SEAM();
    if (RUN) {
        REPEAT(REP_PREP) {
#ifndef DIS_PREP
        REPEAT(REP_QKV) prep_qkv(C.P, C.Qb, C.Kb, C.Vb, C.q_gain + l * 128, C.k_gain + l * 128, C.rope, NROW, !last, C.gw, C.NGW, C.lane);
#endif
#ifndef DIS_GMLP
        constexpr int nch = Mrows / 128;
        REPEAT(REP_GMLP) for (int it = C.vcu; it < nch; it += C.G) gmlp_item(C.lds, C.P, C.MIX, C.a_ln_g + l * 512, C.a_ln_b + l * 512, C.a_ws + (size_t)l * 4 * 128 * 128, C.a_bs + l * 512, it, C.tid, C.wave, C.lane);
#endif
#ifndef DIS_CONV
        {
            constexpr int nconv = Mrows / 32, ngm = Mrows / 128;
            const bool split = C.G > ngm && ngm <= nconv;
            const int c0 = split ? (C.vcu < ngm ? C.vcu : ngm + (C.vcu - ngm)) : C.vcu;
            const int cs = split ? (C.vcu < ngm ? nconv : C.G - ngm) : C.G;
            REPEAT(REP_CONV) for (int it = c0; it < nconv; it += cs) conv_item(C.lds, C.P, C.MIX, C.b_dw + (size_t)l * 31 * 512, C.b_dwb + l * 512, C.b_ln_g + l * 512, C.b_ln_b + l * 512, it, C.tid, C.wave, C.lane);
        }
#endif
        }
    }
    SEAM();
    if (RUN) {
        constexpr int nunits = 512 + (last ? 0 : 32);
        REPEAT(REP_ATTN) for (int u = C.vcu; u < nunits; u += C.G) {
            int b, h, row0, seq;
            if (u < 512) { b = u >> 7; h = (u >> 4) & 7; row0 = b * SEQ + (u & 15) * 256; seq = KVLEN; }
            else { const int u2 = u - 512; b = u2 >> 3; h = u2 & 7; row0 = NLAT + b * CTX; seq = CTX; }
            const size_t kvoff = (size_t)(b * 2 + (h >> 2)) * KVLEN * 128;
#ifndef DIS_ATTN
            attn::attn_dense_body(C.P + (size_t)row0 * INC + 2048 + h * 128, C.q_gain + l * 128, C.rope, u < 512 ? (row0 & 4095) : -1, (const attn::bf16*)(C.Kb + kvoff), (const attn::bf16*)(C.Vb + kvoff),
                                  C.MIX + (size_t)row0 * DM + 1024 + h * 128, seq, (char*)C.lds_raw);
#endif
            __syncthreads();
        }
    }
    SEAM();
    if (RUN) {
#if !defined(DIS_GEMM) && !defined(DIS_G2)
        stagger((C.bx >> 3) & 7, STG_OUT);
        pg8::Gemm g{C.MIX, C.Wt_out + (size_t)l * DM * DM, NLAT, DM, DM, DM / 64}; pg8::OrderX S; S.init(NLAT, DM, C.G, C.bx, 0, 0, 0, 0);
        pg8::EpiBf16<0> E{C.H, DM};
        pg8::gemm_phase<pg8::EpiBf16<0>, pg8::OrderX, true, true>(C.lds, g, S, E);
        if (!last) {
            pg8::Gemm g2{C.MIX, C.Wt_out + (size_t)l * DM * DM, NROW, DM, DM, 4}; pg8::OrderSplit S2; S2.init(C.G, C.bx, 8, 4);
            pg8::EpiPart E2{C.PART, 4 * 128};
            pg8::gemm_phase<pg8::EpiPart, pg8::OrderSplit, true, true>(C.lds, g2, S2, E2);
        }
#endif
    }
    SEAM();
    if (RUN) {
        bf16r* XS = (bf16r*)C.X;
        if (l == 0) row_pass_res<true, false>(C.lds, C.x_in, nullptr, C.H, NLAT, modl, 2 * DM, C.ln1_g + l * DM, C.ln1_b + l * DM, XS, nullptr, modl, 3 * DM, 4 * DM, C.H, C.gw, C.NGW, C.lane);
        else row_pass_res<false, false>(C.lds, nullptr, XS, C.H, NLAT, modl, 2 * DM, C.ln1_g + l * DM, C.ln1_b + l * DM, XS, nullptr, modl, 3 * DM, 4 * DM, C.H, C.gw, C.NGW, C.lane);
        if (!last) row_pass_ctx_res<true>(C.ctx_in, XS, C.PART, modl + 4 * (size_t)NMODC + 2 * DM, C.ln1_g + l * DM, C.ln1_b + l * DM, true, modl, 3 * DM, 4 * DM, C.H, C.gw, C.NGW, C.lane);
    }
    SEAM();
    if (RUN) {
#if !defined(DIS_GEMM) && !defined(DIS_G3)
        stagger((C.bx >> 3) & 7, STG_FF1);
        pg8::Gemm g{C.H, C.Wt_ff1 + (size_t)l * DFF * DM, Mrows, DFF, DM, DM / 64}; pg8::OrderX S; S.init(Mrows, DFF, C.G, C.bx, 0, 0, 0, 0);
        pg8::EpiBf16<2> E{C.ACT, DFF};
        pg8::gemm_phase<pg8::EpiBf16<2>, pg8::OrderX, true, true>(C.lds, g, S, E);
        if (REP_G3) { pg8::gemm_phase<pg8::EpiBf16<2>, pg8::OrderX, true, true>(C.lds, g, S, E); }
        if (l == 0) tail_transposes(C, (Mrows / 256) * (DFF / 256), C.w_ff2 + (size_t)DFF * DM, DFF, DM, C.Wt_ff2 + (size_t)DM * DFF, nullptr, 0, 0, nullptr);
#endif
    }
    SEAM();
    if (RUN) {
#if !defined(DIS_GEMM) && !defined(DIS_G4)
        stagger((C.bx >> 3) & 7, STG_FF2);
        pg8::Gemm g{C.ACT, C.Wt_ff2 + (size_t)l * DM * DFF, NLAT, DM, DFF, DFF / 64, FF2_KREV  }; pg8::OrderX S; S.init(NLAT, DM, C.G, C.bx, 0, 0, 0, 0);
        pg8::EpiBf16<0> E{C.H, DM};
        pg8::gemm_phase<pg8::EpiBf16<0>, pg8::OrderX, true, true>(C.lds, g, S, E);
        if (!last) {
            pg8::Gemm g2{C.ACT, C.Wt_ff2 + (size_t)l * DM * DFF, NROW, DM, DFF, 16}; pg8::OrderSplit S2; S2.init(C.G, C.bx, 8, 16);
            pg8::EpiPart E2{C.PART, 16 * 128};
            pg8::gemm_phase<pg8::EpiPart, pg8::OrderSplit, true, true>(C.lds, g2, S2, E2);
        }
#endif
    }
    SEAM();
    if (RUN) {
        bf16r* XS = (bf16r*)C.X;
        if (last) row_pass_res<false, true>(C.lds, nullptr, XS, C.H, NLAT, modl, 5 * DM, C.ln2_g + l * DM, C.ln2_b + l * DM, nullptr, C.out, nullptr, 0, 0, nullptr, C.gw, C.NGW, C.lane);
        else {
            row_pass_res<false, false>(C.lds, nullptr, XS, C.H, NLAT, modl, 5 * DM, C.ln2_g + l * DM, C.ln2_b + l * DM, XS, nullptr, modl + 5 * NMODC, 0 * DM, 1 * DM, C.H, C.gw, C.NGW, C.lane);
            row_pass_ctx_res<false>(nullptr, XS, C.PART, modl + 4 * (size_t)NMODC + 5 * DM, C.ln2_g + l * DM, C.ln2_b + l * DM, false, modl + 5 * NMODC, 0 * DM, 1 * DM, C.H, C.gw, C.NGW, C.lane);
        }
    }
    SEAM();
}

__global__ void __launch_bounds__(512, 2) fwd_megakernel(Args args) {
    extern __shared__ __attribute__((aligned(16))) unsigned char lds_raw[];
    cg::grid_group grid = cg::this_grid();
    Ctx C;
    C.lds = (LAS unsigned char*)lds_raw; C.lds_raw = lds_raw;
    C.tid = threadIdx.x; C.lane = C.tid & 63; C.wave = __builtin_amdgcn_readfirstlane(C.tid >> 6);
    C.G = gridDim.x; C.bx = blockIdx.x; C.vcu = (C.G % 8 == 0) ? (C.bx % 8) * (C.G / 8) + C.bx / 8 : C.bx;
    C.gw = C.vcu * 8 + C.wave; C.NGW = C.G * 8; C.lo = args.ph_lo; C.hi = args.ph_hi;
    unsigned char* ws = args.ws;
    C.x_in = args.in[0]; C.ctx_in = args.in[2]; C.w_in = args.in[6]; C.w_out = args.in[17]; C.w_ff1 = args.in[20]; C.w_ff2 = args.in[21];
    C.a_ln_g = args.in[7]; C.a_ln_b = args.in[8]; C.a_ws = args.in[9]; C.a_bs = args.in[10];
    C.b_dw = args.in[11]; C.b_dwb = args.in[12]; C.b_ln_g = args.in[13]; C.b_ln_b = args.in[14];
    C.q_gain = args.in[15]; C.k_gain = args.in[16]; C.ln1_g = args.in[18]; C.ln1_b = args.in[19]; C.ln2_g = args.in[22]; C.ln2_b = args.in[23];
    C.STAT = (float*)(ws + WS_STAT); C.PART = (float*)(ws + WS_PART); C.rope = (float*)(ws + WS_ROPE); C.MOD = (float*)(ws + WS_MOD); C.X = (float*)(ws + WS_X); C.out = args.out;
    C.Wt_in = (bf16r*)(ws + WS_WIN); C.Wt_out = (bf16r*)(ws + WS_WOUT); C.Wt_ff1 = (bf16r*)(ws + WS_WFF1); C.Wt_ff2 = (bf16r*)(ws + WS_WFF2);
    C.H = (bf16r*)(ws + WS_H); C.P = (bf16r*)(ws + WS_P); C.Qb = (bf16r*)(ws + WS_Q);
    C.Kb = (bf16r*)(ws + WS_K); C.Vb = (bf16r*)(ws + WS_V); C.MIX = (bf16r*)(ws + WS_MIX); C.ACT = (bf16r*)(ws + WS_ACT);
    int pid = 0;
    volatile LAS unsigned* bst = (volatile LAS unsigned*)(C.lds + LDS_BYTES - 64);
    if (C.tid < 2) bst[C.tid] = 0u;
    __syncthreads();
    const XcdBarrier bar = xcd_barrier_post((unsigned*)(ws + WS_BAR), bst);
    if (C.hi < 0) grid.sync();

    if (RUN) REPEAT(REP_P0) {
        const float* c_in = args.in[1]; const float* cctx_in = args.in[3]; const float* w_mod = args.in[4]; const float* b_mod = args.in[5];
        const float* w_in = args.in[6]; const float* w_out = args.in[17]; const float* w_ff1 = args.in[20]; const float* w_ff2 = args.in[21];
        p0_rope(C.rope, C.bx * 512 + C.tid, C.G * 512);
        p0_mod(C.lds, c_in, cctx_in, w_mod, b_mod, C.MOD, 0, NLAYER * (NMODC / 128), C.bx, C.G, C.tid);
        __syncthreads();
        LAS float* scr = (LAS float*)(C.lds + C.wave * 16640);
        constexpr int I_IN = (DM / 64) * (INC / 64), I_OUT = (DM / 64) * (DM / 64), I_F1 = (DM / 64) * (DFF / 64), I_F2 = (DFF / 64) * (DM / 64), I_L = I_IN + I_OUT + I_F1 + I_F2;
        for (int it = C.gw; it < I_L; it += C.NGW) {
            const int l = 0; int r = it;
            if (r < I_IN) { p0_transpose_item(w_in + (size_t)l * DM * INC, DM, INC, C.Wt_in + (size_t)l * INC * DM, scr, r, C.lane); continue; } r -= I_IN;
            if (r < I_OUT) { p0_transpose_item(w_out + (size_t)l * DM * DM, DM, DM, C.Wt_out + (size_t)l * DM * DM, scr, r, C.lane); continue; } r -= I_OUT;
            if (r < I_F1) { p0_transpose_item(w_ff1 + (size_t)l * DM * DFF, DM, DFF, C.Wt_ff1 + (size_t)l * DFF * DM, scr, r, C.lane); continue; } r -= I_F1;
            p0_transpose_item(w_ff2 + (size_t)l * DFF * DM, DFF, DM, C.Wt_ff2 + (size_t)l * DM * DFF, scr, r, C.lane);
        }
        if (REP_P0) __syncthreads();
    }
    SEAM();
    if (RUN) row_pass0(C.lds, C.x_in, C.ctx_in, C.MOD, C.H, C.gw, C.NGW, C.lane);
    SEAM();
    layer_body<0>(C, pid, bar);
    layer_body<1>(C, pid, bar);
#ifdef EXTRA_SYNCS
    if (C.hi - C.lo > 1) { for (int i = 0; i < EXTRA_SYNCS; ++i) {
#ifdef EXTRA_DIRTY
        { f32x4* sp = (f32x4*)(ws + WS_PART) + (size_t)C.bx * 512 * EXTRA_DIRTY + C.tid;
          for (int k = 0; k < EXTRA_DIRTY; ++k) sp[k * 512] = (f32x4){(float)i, 1.f, 2.f, 3.f}; }
#endif
        xcd_barrier(bar); } }
#endif
}
#undef RUN
#undef SEAM

#ifndef MK_PER_PHASE
#define MK_PER_PHASE 0
#endif
extern "C" void kernel_launch(void* const* d_in, const int* in_sizes, int n_in, void* d_out, int out_size, void* d_ws, size_t ws_size, hipStream_t stream) {
    static int grid = 0;
    if (grid == 0) {
        if (n_in != 24 || out_size != NLAT * DM || ws_size < WS_END) { fprintf(stderr, "kernel_launch: unexpected shapes (n_in %d out %d ws %zu, need ws >= %zu)\n", n_in, out_size, ws_size, (size_t)WS_END); grid = -1; return; }
        int dev = 0, cus = 0, per_cu = 0;
        (void)hipGetDevice(&dev); (void)hipDeviceGetAttribute(&cus, hipDeviceAttributeMultiprocessorCount, dev);
        if (hipFuncSetAttribute((const void*)fwd_megakernel, hipFuncAttributeMaxDynamicSharedMemorySize, LDS_BYTES) != hipSuccess) { fprintf(stderr, "kernel_launch: hipFuncSetAttribute failed\n"); grid = -1; return; }
        if (hipOccupancyMaxActiveBlocksPerMultiprocessor(&per_cu, (const void*)fwd_megakernel, 512, LDS_BYTES) != hipSuccess || per_cu < 1) { fprintf(stderr, "kernel_launch: occupancy query says %d\n", per_cu); per_cu = 1; }
        (void)hipGetLastError();
        grid = cus;
    }
    if (grid < 0) return;
#ifndef PROBE_TWICE
#define PROBE_TWICE 0
#endif
    for (int rep_launch = 0; rep_launch <= PROBE_TWICE; ++rep_launch) {
    if (hipMemsetAsync((char*)d_ws + WS_BAR, 0, WS_BAR_BYTES, stream) != hipSuccess) { fprintf(stderr, "kernel_launch: memset failed\n"); return; }
    Args a{};
    for (int i = 0; i < 24; ++i) a.in[i] = (const float*)d_in[i];
    a.out = (float*)d_out; a.ws = (unsigned char*)d_ws;
#if MK_PER_PHASE
    for (int p = 0; p < N_PHASES; ++p) { a.ph_lo = p; a.ph_hi = p + 1; hipLaunchKernelGGL(fwd_megakernel, dim3(grid), dim3(512), LDS_BYTES, stream, a); }
#else
    a.ph_lo = 0; a.ph_hi = N_PHASES;
    void* kargs[] = {&a};
    hipError_t e = hipLaunchCooperativeKernel((const void*)fwd_megakernel, dim3(grid), dim3(512), kargs, LDS_BYTES, stream);
    if (e != hipSuccess) fprintf(stderr, "kernel_launch: cooperative launch failed: %s (grid %d)\n", hipGetErrorString(e), grid);
#endif
    }
}
```
